# Optimizing an MI355X kernel written in HIP

```python
import jax, jax.numpy as jnp
from jax import lax
import numpy as np

D_MODEL = 1024
BATCH = 8
SEQ = 2048
DEPTH = 2

N_META = 16
GRID_W = 64
NORM_EPS = 1e-6
SC_WIDTH = D_MODEL // 2
SC_KERNEL = 3
GLA_HEADS = 4
GLA_DV = (D_MODEL // 2) // GLA_HEADS
GLA_DK = GLA_DV // 2
GLA_GATE_RANK = 16
GLA_GATE_TAU = 16.0
GLA_CHUNK = 64
MIX_SPLIT_SIZES = [SC_WIDTH] * 3 + [GLA_HEADS * GLA_DK] * 2 + [GLA_HEADS * GLA_DV] * 2 + [GLA_GATE_RANK] * 2
MIX_IN = sum(MIX_SPLIT_SIZES)
ATT_HEAD_DIM = 64
ATT_HEADS = D_MODEL // ATT_HEAD_DIM
ATT_KV_HEADS = 4
ATT_GROUP = ATT_HEADS // ATT_KV_HEADS
ATT_BLOCK = 128
ROPE_THETA = 10000.0
ATT_IN = ATT_HEADS * ATT_HEAD_DIM + 2 * ATT_KV_HEADS * ATT_HEAD_DIM
MOE_GROUPS = 4
MOE_EXPERTS_PER_GROUP = 8
N_EXPERTS = MOE_GROUPS * MOE_EXPERTS_PER_GROUP
MOE_TOP_K = 2
MOE_D_FF = 256
N_EVEN = (DEPTH + 1) // 2
N_ODD = DEPTH // 2

kernel_name = "hybrid_conv_gla_axialgqa_hmoe_encoder"


def rms_norm(x, g):
    xf = x.astype(jnp.float32)
    y = xf * lax.rsqrt(jnp.mean(xf * xf, axis=-1, keepdims=True) + NORM_EPS)
    return (y * g.astype(jnp.float32)).astype(x.dtype)


def centred_depthwise_conv3(z, w):
    zp = jnp.pad(z, ((0, 0), (1, 1), (0, 0)))
    return w[0] * zp[:, :-2] + w[1] * zp[:, 1:-1] + w[2] * zp[:, 2:]


def gla_chunked(q, k, v, log_a, inclusive):
    b_, L, H, DK = q.shape
    DV = v.shape[-1]
    n = L // GLA_CHUNK

    def chunks(t):
        return t.astype(jnp.float32).reshape(b_, n, GLA_CHUNK, H, t.shape[-1]).transpose(1, 0, 3, 2, 4)

    qc, kc, vc, gc = chunks(q), chunks(k), chunks(v), chunks(log_a)
    cum = jnp.cumsum(gc, axis=3)
    cum_last = cum[:, :, :, -1:, :]
    q_dec = qc * jnp.exp(cum)
    k_inv = kc * jnp.exp(-cum)
    k_end = kc * jnp.exp(cum_last - cum)
    scores = jnp.einsum('nbhcd,nbhsd->nbhcs', q_dec, k_inv)
    mask = jnp.tril(jnp.ones((GLA_CHUNK, GLA_CHUNK), dtype=bool), 0 if inclusive else -1)
    o_intra = jnp.einsum('nbhcs,nbhsv->nbhcv', jnp.where(mask, scores, 0.0), vc)
    kv_chunk = jnp.einsum('nbhcd,nbhcv->nbhdv', k_end, vc)
    chunk_decay = jnp.exp(cum_last[:, :, :, 0, :])

    def step(state, inp):
        q_n, kv_n, dec_n = inp
        o_n = jnp.einsum('bhcd,bhdv->bhcv', q_n, state)
        return dec_n[..., None] * state + kv_n, o_n

    s0 = jnp.zeros((b_, H, DK, DV), jnp.float32)
    _, o_inter = lax.scan(step, s0, (q_dec, kv_chunk, chunk_decay))
    o = o_intra + o_inter
    return o.transpose(1, 0, 3, 2, 4).reshape(b_, L, H, DV)


def pad_meta_chunk(t):
    pad = jnp.zeros((t.shape[0], GLA_CHUNK - N_META) + t.shape[2:], t.dtype)
    return jnp.concatenate([t[:, :N_META], pad, t[:, N_META:]], axis=1)


def conv_gla_mixer(h, w_in, conv_w, wg_f, bg_f, wg_b, bg_b, gla_norm_w, w_out):
    bsz, T, _ = h.shape
    u = h @ w_in
    splits = np.cumsum(MIX_SPLIT_SIZES)[:-1].tolist()
    a_b, a_c, a_x, q, k, v, r, g_f, g_b = jnp.split(u, splits, axis=-1)
    y_a = a_b * centred_depthwise_conv3(a_c * a_x, conv_w)
    log_a_f = jax.nn.log_sigmoid((g_f @ wg_f + bg_f).astype(jnp.float32)) / GLA_GATE_TAU
    log_a_b = jax.nn.log_sigmoid((g_b @ wg_b + bg_b).astype(jnp.float32)) / GLA_GATE_TAU
    heads = lambda t, d: t.reshape(bsz, T, GLA_HEADS, d)
    qh = pad_meta_chunk(heads(q, GLA_DK) * (GLA_DK ** -0.5))
    kh = pad_meta_chunk(heads(k, GLA_DK))
    vh = pad_meta_chunk(heads(v, GLA_DV))
    laf = pad_meta_chunk(heads(log_a_f, GLA_DK))
    lab = pad_meta_chunk(heads(log_a_b, GLA_DK))
    o_fwd = gla_chunked(qh, kh, vh, laf, True)
    flip = lambda t: jnp.flip(t, axis=1)
    o_bwd = flip(gla_chunked(flip(qh), flip(kh), flip(vh), flip(lab), False))
    o = o_fwd + o_bwd
    o = jnp.concatenate([o[:, :N_META], o[:, GLA_CHUNK:]], axis=1)
    o = o * lax.rsqrt(jnp.mean(o * o, axis=-1, keepdims=True) + NORM_EPS) * gla_norm_w.astype(jnp.float32)
    y_b = (o * jax.nn.silu(heads(r, GLA_DV).astype(jnp.float32))).reshape(bsz, T, GLA_HEADS * GLA_DV)
    return jnp.concatenate([y_a, y_b.astype(h.dtype)], axis=-1) @ w_out


def axial_rope_tables(n_tokens):
    rows_n = n_tokens // GRID_W
    rows = jnp.repeat(jnp.arange(rows_n), GRID_W).astype(jnp.float32)
    cols = jnp.tile(jnp.arange(GRID_W), rows_n).astype(jnp.float32)
    axis_dims = ATT_HEAD_DIM // 2
    freqs = ROPE_THETA ** (-jnp.arange(0, axis_dims, 2, dtype=jnp.float32) / axis_dims)
    ang = jnp.concatenate([rows[:, None] * freqs, cols[:, None] * freqs], axis=-1)
    ang = jnp.concatenate([jnp.zeros((N_META, ang.shape[1]), jnp.float32), ang], axis=0)
    return jnp.cos(ang), jnp.sin(ang)


def apply_rope(x, cos, sin):
    xr = x.reshape(x.shape[:-1] + (ATT_HEAD_DIM // 2, 2))
    x0, x1 = xr[..., 0], xr[..., 1]
    c, s = cos[None, :, None, :], sin[None, :, None, :]
    return jnp.stack([x0 * c - x1 * s, x0 * s + x1 * c], axis=-1).reshape(x.shape)


def attend_block(q_blk, k, v):
    s = jnp.einsum('bqhgd,bkhd->bhgqk', q_blk, k) * (ATT_HEAD_DIM ** -0.5)
    p = jax.nn.softmax(s, axis=-1)
    return jnp.einsum('bhgqk,bkhd->bqhgd', p, v)


def gqa_axial_mixer(h, w_in, q_norm, k_norm, w_out, cos, sin, with_meta_queries):
    bsz, T, _ = h.shape
    u = h @ w_in
    nq = ATT_HEADS * ATT_HEAD_DIM
    nkv = ATT_KV_HEADS * ATT_HEAD_DIM
    q = u[..., :nq].reshape(bsz, T, ATT_HEADS, ATT_HEAD_DIM)
    k = u[..., nq:nq + nkv].reshape(bsz, T, ATT_KV_HEADS, ATT_HEAD_DIM)
    v = u[..., nq + nkv:].reshape(bsz, T, ATT_KV_HEADS, ATT_HEAD_DIM).astype(jnp.float32)
    q = apply_rope(rms_norm(q, q_norm).astype(jnp.float32), cos, sin)
    k = apply_rope(rms_norm(k, k_norm).astype(jnp.float32), cos, sin)
    q = q.reshape(bsz, T, ATT_KV_HEADS, ATT_GROUP, ATT_HEAD_DIM)
    n_real = T - N_META
    nb = n_real // ATT_BLOCK
    q_blocks = jnp.moveaxis(q[:, N_META:].reshape(bsz, nb, ATT_BLOCK, ATT_KV_HEADS, ATT_GROUP, ATT_HEAD_DIM), 1, 0)
    o = lax.map(lambda qb: attend_block(qb, k, v), q_blocks)
    o = jnp.moveaxis(o, 0, 1).reshape(bsz, n_real, nq)
    if with_meta_queries:
        o_meta = attend_block(q[:, :N_META], k, v).reshape(bsz, N_META, nq)
        o = jnp.concatenate([o_meta, o], axis=1)
    return o.astype(h.dtype) @ w_out


def hierarchical_moe(h, w_group, b_group, w_expert, b_expert, w_gate, w_up, w_down):
    bsz, T, D = h.shape
    xt = h.reshape(-1, D)
    g_logits = (xt @ w_group + b_group).astype(jnp.float32)
    g_prob = jax.nn.softmax(g_logits, axis=-1)
    g_idx = jnp.argmax(g_logits, axis=-1)
    g_p = jnp.take_along_axis(g_prob, g_idx[:, None], axis=-1)
    e_logits = (xt @ w_expert + b_expert).astype(jnp.float32).reshape(-1, MOE_GROUPS, MOE_EXPERTS_PER_GROUP)
    e_sel = jnp.take_along_axis(e_logits, g_idx[:, None, None], axis=1)[:, 0]
    top_v, top_i = lax.top_k(e_sel, MOE_TOP_K)
    top_w = jax.nn.softmax(top_v, axis=-1) * g_p
    expert_id = g_idx[:, None] * MOE_EXPERTS_PER_GROUP + top_i
    gates = jnp.sum(jax.nn.one_hot(expert_id, N_EXPERTS, dtype=jnp.float32) * top_w[..., None], axis=1)
    out = jnp.zeros(xt.shape, jnp.float32)
    for e in range(N_EXPERTS):
        he = jax.nn.silu(xt @ w_gate[e]) * (xt @ w_up[e])
        out = out + gates[:, e:e + 1] * (he @ w_down[e]).astype(jnp.float32)
    return out.astype(h.dtype).reshape(bsz, T, D)


def setup_inputs(seed: int = 0) -> dict:
    key = jax.random.key(seed)
    ks = jax.random.split(key, 24)
    nrm = lambda k, shape, scale: jax.random.normal(k, shape, jnp.float32) * scale
    gain = lambda k, shape: 1.0 + 0.02 * jax.random.normal(k, shape, jnp.float32)
    D = D_MODEL
    return {
        "x": nrm(ks[0], (BATCH, SEQ, D), 1.0),
        "meta_tokens": nrm(ks[1], (N_META, D), 1.0),
        "norm_mix": gain(ks[2], (DEPTH, D)),
        "norm_ffn": gain(ks[3], (DEPTH, D)),
        "norm_final": gain(ks[4], (D,)),
        "sc_w_in": nrm(ks[5], (N_EVEN, D, MIX_IN), D ** -0.5),
        "sc_conv_w": nrm(ks[6], (N_EVEN, SC_KERNEL, SC_WIDTH), SC_KERNEL ** -0.5),
        "gla_w_gate_fwd": nrm(ks[7], (N_EVEN, GLA_GATE_RANK, GLA_HEADS * GLA_DK), GLA_GATE_RANK ** -0.5),
        "gla_b_gate_fwd": nrm(ks[8], (N_EVEN, GLA_HEADS * GLA_DK), 0.1),
        "gla_w_gate_bwd": nrm(ks[9], (N_EVEN, GLA_GATE_RANK, GLA_HEADS * GLA_DK), GLA_GATE_RANK ** -0.5),
        "gla_b_gate_bwd": nrm(ks[10], (N_EVEN, GLA_HEADS * GLA_DK), 0.1),
        "gla_norm_w": gain(ks[11], (N_EVEN, GLA_DV)),
        "sc_w_out": nrm(ks[12], (N_EVEN, SC_WIDTH + GLA_HEADS * GLA_DV, D), (SC_WIDTH + GLA_HEADS * GLA_DV) ** -0.5),
        "att_w_in": nrm(ks[13], (N_ODD, D, ATT_IN), D ** -0.5),
        "att_q_norm": gain(ks[14], (N_ODD, ATT_HEAD_DIM)),
        "att_k_norm": gain(ks[15], (N_ODD, ATT_HEAD_DIM)),
        "att_w_out": nrm(ks[16], (N_ODD, ATT_HEADS * ATT_HEAD_DIM, D), (ATT_HEADS * ATT_HEAD_DIM) ** -0.5),
        "moe_w_group": nrm(ks[17], (DEPTH, D, MOE_GROUPS), D ** -0.5),
        "moe_b_group": nrm(ks[18], (DEPTH, MOE_GROUPS), 0.01),
        "moe_w_expert": nrm(ks[19], (DEPTH, D, N_EXPERTS), D ** -0.5),
        "moe_b_expert": nrm(ks[20], (DEPTH, N_EXPERTS), 0.01),
        "moe_w_gate": nrm(ks[21], (DEPTH, N_EXPERTS, D, MOE_D_FF), D ** -0.5),
        "moe_w_up": nrm(ks[22], (DEPTH, N_EXPERTS, D, MOE_D_FF), D ** -0.5),
        "moe_w_down": nrm(ks[23], (DEPTH, N_EXPERTS, MOE_D_FF, D), MOE_D_FF ** -0.5),
    }


def reference(x, meta_tokens, norm_mix, norm_ffn, norm_final, sc_w_in, sc_conv_w, gla_w_gate_fwd, gla_b_gate_fwd, gla_w_gate_bwd, gla_b_gate_bwd, gla_norm_w, sc_w_out, att_w_in, att_q_norm, att_k_norm, att_w_out, moe_w_group, moe_b_group, moe_w_expert, moe_b_expert, moe_w_gate, moe_w_up, moe_w_down):
    bsz, n_tokens, D = x.shape
    meta = jnp.broadcast_to(meta_tokens.astype(x.dtype)[None], (bsz, N_META, D))
    h = jnp.concatenate([meta, x], axis=1)
    cos, sin = axial_rope_tables(n_tokens)
    for i in range(DEPTH):
        last = i == DEPTH - 1
        j = i // 2
        hn = rms_norm(h, norm_mix[i])
        if i % 2 == 0:
            h = h + conv_gla_mixer(hn, sc_w_in[j], sc_conv_w[j], gla_w_gate_fwd[j], gla_b_gate_fwd[j],
                                   gla_w_gate_bwd[j], gla_b_gate_bwd[j], gla_norm_w[j], sc_w_out[j])
            if last:
                h = h[:, N_META:]
        else:
            mix = gqa_axial_mixer(hn, att_w_in[j], att_q_norm[j], att_k_norm[j], att_w_out[j], cos, sin,
                                  not last)
            h = (h[:, N_META:] if last else h) + mix
        h = h + hierarchical_moe(rms_norm(h, norm_ffn[i]), moe_w_group[i], moe_b_group[i], moe_w_expert[i],
                                 moe_b_expert[i], moe_w_gate[i], moe_w_up[i], moe_w_down[i])
    return rms_norm(h, norm_final)
```

```cpp
#include <hip/hip_runtime.h>
#include <cstdint>
#include <cstdio>
#include <cmath>

constexpr int Bz = 8, S = 2048, D = 1024, NM = 16, T = S + NM, NT = Bz * T;
constexpr int NR = Bz * S;
constexpr int LDA1 = 1536;
constexpr int LDB1 = 1568;
constexpr int UB_Q = 0, UB_K = 256, UB_V = 512, UB_R = 1024, UB_GF = 1536, UB_GB = 1552;
constexpr int MIXIN = 3104, ATTIN = 1536;
constexpr float EPS = 1e-6f;

__device__ __forceinline__ float wave_sum(float v) {
#pragma unroll
    for (int o = 1; o < 64; o <<= 1) v += __shfl_xor(v, o);
    return v;
}

__global__ void __launch_bounds__(256) k_rmsnorm(const float* __restrict__ in, const float* __restrict__ x, const float* __restrict__ meta,
                                                  const float* __restrict__ g, float* __restrict__ out, int mode) {
    __shared__ float red[4];
    const int row = blockIdx.x, tid = threadIdx.x;
    const float* src;
    if (mode == 1) { const int b = row / T, t = row % T; src = (t < NM) ? meta + (size_t)t * D : x + ((size_t)b * S + (t - NM)) * D; }
    else src = in + (size_t)row * D;
    const float4 v = ((const float4*)src)[tid];
    float ss = v.x * v.x + v.y * v.y + v.z * v.z + v.w * v.w;
    ss = wave_sum(ss);
    if ((tid & 63) == 0) red[tid >> 6] = ss;
    __syncthreads();
    const float tot = red[0] + red[1] + red[2] + red[3];
    const float r = rsqrtf(tot * (1.0f / D) + EPS);
    const float4 gg = ((const float4*)g)[tid];
    float4 o; o.x = v.x * r * gg.x; o.y = v.y * r * gg.y; o.z = v.z * r * gg.z; o.w = v.w * r * gg.w;
    ((float4*)(out + (size_t)row * D))[tid] = o;
}

__global__ void __launch_bounds__(256) k_gemm(const float* __restrict__ A, int lda, const float* __restrict__ W, int ldw, float* __restrict__ C, int ldc,
                                               int M, int N, int K, int rmode, const float* __restrict__ Rbuf, const float* __restrict__ x, const float* __restrict__ meta) {
    const int n = blockIdx.x * 256 + threadIdx.x, m0 = blockIdx.y * 8;
    if (n >= N) return;
    float acc[8];
#pragma unroll
    for (int r = 0; r < 8; ++r) acc[r] = 0.f;
    const float* a = A + (size_t)m0 * lda;
    for (int k = 0; k < K; k += 4) {
        float w[4];
#pragma unroll
        for (int i = 0; i < 4; ++i) w[i] = W[(size_t)(k + i) * ldw + n];
#pragma unroll
        for (int r = 0; r < 8; ++r)
#pragma unroll
            for (int i = 0; i < 4; ++i) acc[r] += a[(size_t)r * lda + k + i] * w[i];
    }
#pragma unroll
    for (int r = 0; r < 8; ++r) {
        const int m = m0 + r; float res = 0.f;
        if (rmode == 1) { const int b = m / T, t = m % T; res = (t < NM) ? meta[(size_t)t * D + n] : x[((size_t)b * S + (t - NM)) * D + n]; }
        else if (rmode == 2) { const int b = m / S, s = m % S; res = Rbuf[((size_t)b * T + NM + s) * D + n]; }
        C[(size_t)m * ldc + n] = acc[r] + res;
    }
}

__device__ __forceinline__ float log_sigmoid(float z) { return fminf(z, 0.f) - log1pf(expf(-fabsf(z))); }

__global__ void __launch_bounds__(256) k_gates(const float* __restrict__ UB, const float* __restrict__ wgf, const float* __restrict__ bgf,
                                                const float* __restrict__ wgb, const float* __restrict__ bgb, float* __restrict__ LAF, float* __restrict__ LAB) {
    const int row = blockIdx.x, c = threadIdx.x;
    const float* u = UB + (size_t)row * LDB1;
    float zf = bgf[c], zb = bgb[c];
#pragma unroll
    for (int j = 0; j < 16; ++j) { zf += u[UB_GF + j] * wgf[j * 256 + c]; zb += u[UB_GB + j] * wgb[j * 256 + c]; }
    LAF[(size_t)row * 256 + c] = log_sigmoid(zf) * (1.0f / 16.0f);
    LAB[(size_t)row * 256 + c] = log_sigmoid(zb) * (1.0f / 16.0f);
}

__global__ void __launch_bounds__(256) k_conv(const float* __restrict__ UA, const float* __restrict__ cw, float* __restrict__ YM) {
    const int row = blockIdx.x, t = row % T;
    for (int c = threadIdx.x; c < 512; c += 256) {
        const float* u = UA + (size_t)row * LDA1;
        const float z0 = (t > 0) ? u[-LDA1 + 512 + c] * u[-LDA1 + 1024 + c] : 0.f;
        const float z1 = u[512 + c] * u[1024 + c];
        const float z2 = (t < T - 1) ? u[LDA1 + 512 + c] * u[LDA1 + 1024 + c] : 0.f;
        YM[(size_t)row * D + c] = u[c] * (cw[c] * z0 + cw[512 + c] * z1 + cw[1024 + c] * z2);
    }
}

__global__ void __launch_bounds__(128) k_gla(const float* __restrict__ UB, const float* __restrict__ LAF, const float* __restrict__ LAB,
                                              float* __restrict__ OGF, float* __restrict__ OGB) {
    const int b = blockIdx.x >> 2, h = blockIdx.x & 3, dir = blockIdx.y, v = threadIdx.x;
    const float* LA = dir ? LAB : LAF; float* OG = dir ? OGB : OGF;
    float Sx[64];
#pragma unroll
    for (int d = 0; d < 64; ++d) Sx[d] = 0.f;
    for (int step = 0; step < T; ++step) {
        const int t = dir ? (T - 1 - step) : step; const size_t row = (size_t)b * T + t;
        const float* q = UB + row * LDB1 + UB_Q + h * 64; const float* k = UB + row * LDB1 + UB_K + h * 64;
        const float vv = UB[row * LDB1 + UB_V + h * 128 + v]; const float* la = LA + row * 256 + h * 64;
        float o = 0.f;
        if (dir == 0) {
#pragma unroll
            for (int d = 0; d < 64; ++d) { const float a = expf(la[d]); Sx[d] = a * Sx[d] + k[d] * vv; o += q[d] * Sx[d]; }
        } else {
#pragma unroll
            for (int d = 0; d < 64; ++d) { const float a = expf(la[d]); const float as = a * Sx[d]; o += q[d] * as; Sx[d] = as + k[d] * vv; }
        }
        OG[row * 512 + h * 128 + v] = o * 0.125f;
    }
}

__global__ void __launch_bounds__(128) k_gla_out(const float* __restrict__ UB, const float* __restrict__ OGF, const float* __restrict__ OGB,
                                                  const float* __restrict__ gnw, float* __restrict__ YM) {
    __shared__ float red[2];
    const int row = blockIdx.x >> 2, h = blockIdx.x & 3, v = threadIdx.x;
    const float o = OGF[(size_t)row * 512 + h * 128 + v] + OGB[(size_t)row * 512 + h * 128 + v];
    float ss = wave_sum(o * o);
    if ((v & 63) == 0) red[v >> 6] = ss;
    __syncthreads();
    const float r = rsqrtf((red[0] + red[1]) * (1.0f / 128.0f) + EPS);
    const float rr = UB[(size_t)row * LDB1 + UB_R + h * 128 + v];
    YM[(size_t)row * D + 512 + h * 128 + v] = o * r * gnw[v] * (rr / (1.0f + expf(-rr)));
}

__global__ void __launch_bounds__(64) k_router(const float* __restrict__ XN, const float* __restrict__ wg, const float* __restrict__ bg,
                                                const float* __restrict__ we, const float* __restrict__ be, int* __restrict__ ridx, float* __restrict__ rw, int ntok) {
    const int tok = blockIdx.x * 64 + threadIdx.x;
    if (tok >= ntok) return;
    float lg[4], le[32];
#pragma unroll
    for (int j = 0; j < 4; ++j) lg[j] = 0.f;
#pragma unroll
    for (int j = 0; j < 32; ++j) le[j] = 0.f;
    const float* xr = XN + (size_t)tok * D;
    for (int k = 0; k < D; ++k) {
        const float xv = xr[k];
#pragma unroll
        for (int j = 0; j < 4; ++j) lg[j] += xv * wg[k * 4 + j];
#pragma unroll
        for (int j = 0; j < 32; ++j) le[j] += xv * we[k * 32 + j];
    }
#pragma unroll
    for (int j = 0; j < 4; ++j) lg[j] += bg[j];
#pragma unroll
    for (int j = 0; j < 32; ++j) le[j] += be[j];
    int gi = 0; float gm = lg[0];
#pragma unroll
    for (int j = 1; j < 4; ++j) if (lg[j] > gm) { gm = lg[j]; gi = j; }
    float gs = 0.f;
#pragma unroll
    for (int j = 0; j < 4; ++j) gs += expf(lg[j] - gm);
    const float gp = 1.0f / gs;
    float es[8];
#pragma unroll
    for (int j = 0; j < 8; ++j) es[j] = gi == 0 ? le[j] : gi == 1 ? le[8 + j] : gi == 2 ? le[16 + j] : le[24 + j];
    int i0 = 0; float v0 = es[0];
#pragma unroll
    for (int j = 1; j < 8; ++j) if (es[j] > v0) { v0 = es[j]; i0 = j; }
    int i1 = -1; float v1 = -INFINITY;
#pragma unroll
    for (int j = 0; j < 8; ++j) if (j != i0 && es[j] > v1) { v1 = es[j]; i1 = j; }
    const float e1 = expf(v1 - v0), w0 = gp / (1.0f + e1), w1 = gp * e1 / (1.0f + e1);
    ridx[tok * 2] = gi * 8 + i0; ridx[tok * 2 + 1] = gi * 8 + i1; rw[tok * 2] = w0; rw[tok * 2 + 1] = w1;
}

__global__ void __launch_bounds__(256) k_moe(const float* __restrict__ XN, const int* __restrict__ ridx, const float* __restrict__ rw,
                                              const float* __restrict__ Wg, const float* __restrict__ Wu, const float* __restrict__ Wd, float* __restrict__ H) {
    __shared__ float xs[D]; __shared__ float he[2][256];
    const int tok = blockIdx.x, tid = threadIdx.x;
    ((float4*)xs)[tid] = ((const float4*)(XN + (size_t)tok * D))[tid];
    __syncthreads();
    const int e0 = ridx[tok * 2], e1 = ridx[tok * 2 + 1];
#pragma unroll
    for (int s = 0; s < 2; ++s) {
        const int e = s ? e1 : e0;
        const float* wg = Wg + (size_t)e * D * 256 + tid; const float* wu = Wu + (size_t)e * D * 256 + tid;
        float g = 0.f, u = 0.f;
#pragma unroll 8
        for (int k = 0; k < D; ++k) { g += xs[k] * wg[(size_t)k * 256]; u += xs[k] * wu[(size_t)k * 256]; }
        he[s][tid] = g / (1.0f + expf(-g)) * u * rw[tok * 2 + s];
    }
    __syncthreads();
    for (int c = 0; c < 4; ++c) {
        const int n = c * 256 + tid; float acc = 0.f;
#pragma unroll
        for (int s = 0; s < 2; ++s) {
            const int e = s ? e1 : e0; const float* wd = Wd + (size_t)e * 256 * D + n;
#pragma unroll 8
            for (int k = 0; k < 256; ++k) acc += he[s][k] * wd[(size_t)k * D];
        }
        H[(size_t)tok * D + n] += acc;
    }
}

__global__ void __launch_bounds__(64) k_qkrope(float* __restrict__ U2, const float* __restrict__ qn, const float* __restrict__ kn) {
    const int row = blockIdx.x, head = blockIdx.y, d = threadIdx.x, t = row % T;
    float* p = U2 + (size_t)row * ATTIN + head * 64 + d;
    const float xv = *p;
    const float ss = wave_sum(xv * xv);
    const float xn = xv * rsqrtf(ss * (1.0f / 64.0f) + EPS) * (head < 16 ? qn[d] : kn[d]);
    const float pr = __shfl_xor(xn, 1);
    float cs = 1.f, sn = 0.f;
    if (t >= NM) {
        const int s = t - NM, r = s / 64, c = s % 64, i = d >> 1;
        const int f = (i < 16) ? i : i - 16; const float pos = (float)((i < 16) ? r : c);
        const float freq = powf(10000.0f, -(float)(2 * f) / 32.0f);
        const float ang = pos * freq; cs = cosf(ang); sn = sinf(ang);
    }
    *p = (d & 1) ? (pr * sn + xn * cs) : (xn * cs - pr * sn);
}

__global__ void __launch_bounds__(256) k_attn(const float* __restrict__ U2, float* __restrict__ AO) {
    const int qb = blockIdx.x & 7, hq = (blockIdx.x >> 3) & 15, b = blockIdx.x >> 7, kvh = hq >> 2;
    const int s = qb * 256 + threadIdx.x;
    const float* qp = U2 + ((size_t)b * T + NM + s) * ATTIN + hq * 64;
    float q[64], o[64];
#pragma unroll
    for (int d = 0; d < 64; ++d) { q[d] = qp[d] * 0.125f; o[d] = 0.f; }
    float m = -INFINITY, l = 0.f;
    for (int j = 0; j < T; ++j) {
        const float* kp = U2 + ((size_t)b * T + j) * ATTIN + 1024 + kvh * 64; const float* vp = kp + 256;
        float sc = 0.f;
#pragma unroll
        for (int d = 0; d < 64; ++d) sc += q[d] * kp[d];
        if (sc > m) { const float f = expf(m - sc); l *= f;
#pragma unroll
            for (int d = 0; d < 64; ++d) o[d] *= f;
            m = sc; }
        const float pe = expf(sc - m); l += pe;
#pragma unroll
        for (int d = 0; d < 64; ++d) o[d] += pe * vp[d];
    }
    const float il = 1.0f / l;
    float* op = AO + ((size_t)b * S + s) * D + hq * 64;
#pragma unroll
    for (int d = 0; d < 64; ++d) op[d] = o[d] * il;
}

extern "C" void kernel_launch(void* const* d_in, const int* in_sizes, int n_in, void* d_out, int out_size, void* d_ws, size_t ws_size, hipStream_t stream) {
    const float* x = (const float*)d_in[0]; const float* meta = (const float*)d_in[1]; const float* norm_mix = (const float*)d_in[2];
    const float* norm_ffn = (const float*)d_in[3]; const float* norm_final = (const float*)d_in[4]; const float* sc_w_in = (const float*)d_in[5];
    const float* conv_w = (const float*)d_in[6]; const float* wgf = (const float*)d_in[7]; const float* bgf = (const float*)d_in[8];
    const float* wgb = (const float*)d_in[9]; const float* bgb = (const float*)d_in[10]; const float* gnw = (const float*)d_in[11];
    const float* sc_w_out = (const float*)d_in[12]; const float* att_w_in = (const float*)d_in[13]; const float* qn = (const float*)d_in[14];
    const float* kn = (const float*)d_in[15]; const float* att_w_out = (const float*)d_in[16]; const float* mwg = (const float*)d_in[17];
    const float* mbg = (const float*)d_in[18]; const float* mwe = (const float*)d_in[19]; const float* mbe = (const float*)d_in[20];
    const float* Wg = (const float*)d_in[21]; const float* Wu = (const float*)d_in[22]; const float* Wd = (const float*)d_in[23];
    float* out = (float*)d_out;
    char* ws = (char*)d_ws;
    constexpr size_t SZ_R0 = (size_t)NT * LDB1 * 4;
    constexpr size_t SZ_R1 = (size_t)NT * D * 4;
    constexpr size_t SZ_R2 = (size_t)NT * ATTIN * 4;
    constexpr size_t OFF_R0 = 0, OFF_R1 = OFF_R0 + SZ_R0, OFF_R2 = OFF_R1 + SZ_R1, OFF_RT = OFF_R2 + SZ_R2, WS_NEED = OFF_RT + (size_t)NT * 16;
    if (ws_size < WS_NEED) { fprintf(stderr, "ws too small: %zu < %zu\n", ws_size, WS_NEED); return; }
    float* U = (float*)(ws + OFF_R0); float* H1 = U;
    float* XN = (float*)(ws + OFF_R1); float* OGF = XN; float* OGB = XN + (size_t)NT * 512; float* AO = XN;
    float* YM = (float*)(ws + OFF_R2); float* LAF = YM + (size_t)NT * D; float* LAB = LAF + (size_t)NT * 256; float* U2 = YM; float* H2 = YM;
    int* ridx = (int*)(ws + OFF_RT); float* rw = (float*)(ws + OFF_RT + (size_t)NT * 8);

    k_rmsnorm<<<NT, 256, 0, stream>>>(nullptr, x, meta, norm_mix, XN, 1);
    k_gemm<<<dim3(LDA1 / 256, NT / 8), 256, 0, stream>>>(XN, D, sc_w_in, MIXIN, U, LDA1, NT, LDA1, D, 0, nullptr, nullptr, nullptr);
    k_conv<<<NT, 256, 0, stream>>>(U, conv_w, YM);
    k_gemm<<<dim3((LDB1 + 255) / 256, NT / 8), 256, 0, stream>>>(XN, D, sc_w_in + LDA1, MIXIN, U, LDB1, NT, LDB1, D, 0, nullptr, nullptr, nullptr);
    k_gates<<<NT, 256, 0, stream>>>(U, wgf, bgf, wgb, bgb, LAF, LAB);
    k_gla<<<dim3(Bz * 4, 2), 128, 0, stream>>>(U, LAF, LAB, OGF, OGB);
    k_gla_out<<<NT * 4, 128, 0, stream>>>(U, OGF, OGB, gnw, YM);
    k_gemm<<<dim3(D / 256, NT / 8), 256, 0, stream>>>(YM, D, sc_w_out, D, H1, D, NT, D, D, 1, nullptr, x, meta);
    k_rmsnorm<<<NT, 256, 0, stream>>>(H1, nullptr, nullptr, norm_ffn, XN, 0);
    k_router<<<(NT + 63) / 64, 64, 0, stream>>>(XN, mwg, mbg, mwe, mbe, ridx, rw, NT);
    k_moe<<<NT, 256, 0, stream>>>(XN, ridx, rw, Wg, Wu, Wd, H1);
    k_rmsnorm<<<NT, 256, 0, stream>>>(H1, nullptr, nullptr, norm_mix + D, XN, 0);
    k_gemm<<<dim3(ATTIN / 256, NT / 8), 256, 0, stream>>>(XN, D, att_w_in, ATTIN, U2, ATTIN, NT, ATTIN, D, 0, nullptr, nullptr, nullptr);
    k_qkrope<<<dim3(NT, 20), 64, 0, stream>>>(U2, qn, kn);
    k_attn<<<Bz * 16 * 8, 256, 0, stream>>>(U2, AO);
    k_gemm<<<dim3(D / 256, NR / 8), 256, 0, stream>>>(AO, D, att_w_out, D, H2, D, NR, D, D, 2, H1, nullptr, nullptr);
    k_rmsnorm<<<NR, 256, 0, stream>>>(H2, nullptr, nullptr, norm_ffn + D, XN, 0);
    k_router<<<(NR + 63) / 64, 64, 0, stream>>>(XN, mwg + D * 4, mbg + 4, mwe + D * 32, mbe + 32, ridx, rw, NR);
    k_moe<<<NR, 256, 0, stream>>>(XN, ridx, rw, Wg + (size_t)32 * D * 256, Wu + (size_t)32 * D * 256, Wd + (size_t)32 * 256 * D, H2);
    k_rmsnorm<<<NR, 256, 0, stream>>>(H2, nullptr, nullptr, norm_final, out, 0);
}
```

```cpp
#include <hip/hip_runtime.h>
#include <hip/hip_bf16.h>
#include <cstdint>
#include <cstdio>
#include <cmath>

#ifndef SELFCHECK
#define SELFCHECK 0
#endif
#ifndef N_LAUNCH_MODE
#define N_LAUNCH_MODE 1
#endif

constexpr int Bz = 8, S = 2048, D = 1024, NM = 16, T = S + NM;
constexpr int MR = Bz * S;
constexpr int MA = MR + Bz * NM;
constexpr int MP = 16640;
constexpr int NU = 3072;
constexpr int NG1 = 3584;
constexpr int U_AB = 0, U_Z = 512, U_Q = 1024, U_K = 1280, U_V = 1536, U_R = 2048, U_LA = 2560;
constexpr int W_LA = 3072;
constexpr int NA = 1536;
constexpr int NCH = 33;
constexpr int YROWS = 41216;
constexpr int NEXP = 32;
constexpr float EPS = 1e-6f;

typedef unsigned short bf16_t;

constexpr size_t MiB = 1u << 20;
constexpr size_t WS_CTL = 0, CTL_ZERO_BYTES = 1 * MiB;
constexpr size_t WS_ROPE = 1 * MiB;
constexpr size_t WS_WR = WS_ROPE + 512 * 1024;
constexpr size_t WS_SS = WS_WR + 384 * 1024;
constexpr size_t WS_RI = WS_SS + 256 * 1024;
constexpr size_t WS_DEC = WS_RI + 1 * MiB;
constexpr size_t WS_LIST = WS_DEC + 1 * MiB;
constexpr size_t WS_SMALLW = 6 * MiB + 256 * 1024;
constexpr size_t SZ_WIN = (size_t)NG1 * D * 2, SZ_WSQ = (size_t)D * D * 2, SZ_WAI = (size_t)NA * D * 2;
constexpr size_t WS_WIN = WS_SMALLW, WS_WO0 = WS_WIN + SZ_WIN, WS_WAI = WS_WO0 + SZ_WSQ, WS_WAO = WS_WAI + SZ_WAI;
constexpr size_t WS_MOEGU = WS_WAO + SZ_WSQ;
constexpr size_t WS_MOED = WS_MOEGU + (size_t)NEXP * 512 * D * 2;
constexpr size_t WS_H = WS_MOED + (size_t)NEXP * D * 256 * 2;
constexpr size_t WS_HB = WS_H + (size_t)MP * D * 4;
constexpr size_t WS_BIG = WS_HB + (size_t)MP * D * 2;
constexpr size_t SZ_BIG = (size_t)MP * 3328 * 2;
constexpr size_t WS_Y = WS_BIG, WS_HH = WS_Y + (size_t)YROWS * D * 2, WS_U2 = WS_BIG, WS_AO = WS_U2 + (size_t)MP * NA * 2;
constexpr size_t WS_RSL = WS_HH + (size_t)YROWS * 256 * 2;
constexpr size_t WS_END = WS_BIG + SZ_BIG;
static_assert(WS_RSL + (size_t)NEXP * MA * 4 <= WS_BIG + SZ_BIG, "RSL fits behind HH");
constexpr size_t WS_MOEGU1 = WS_H + 33 * MiB, WS_MOED1 = WS_HB;
constexpr size_t WS_HB0 = WS_H + 33 * MiB;
static_assert(WS_HB0 + (size_t)MR * D * 2 == WS_HB, "HB0 real rows end where the HB region starts");
static_assert(WS_MOEGU1 + (size_t)NEXP * 512 * D * 2 <= WS_HB && (size_t)MP * D * 2 <= 33 * MiB && (size_t)NEXP * D * 256 * 2 <= (size_t)MP * D * 2, "layer-1 MoE weight buffers");
static_assert(WS_HH + (size_t)YROWS * 256 * 2 <= WS_END && WS_AO + (size_t)MR * D * 2 <= WS_END, "BIG overlays");
static_assert(WS_LIST + (size_t)NEXP * MA * 4 <= WS_SMALLW, "small area");
static_assert((size_t)Bz * 4 * 2 * NCH * 128 * 64 * 2 <= (size_t)MP * D * 4, "KVSB fits in H");
constexpr int CW_FLAG = 8;
constexpr int CW_CNT0 = 64, CW_CNT1 = 128;
constexpr int CW_CONV0 = 192, CW_CONV1 = 256;
constexpr int CW_BAR = 4096;
namespace pg8 {
#define PG8_LAS __attribute__((address_space(3)))
typedef short bf16x8 __attribute__((ext_vector_type(8)));
typedef float f32x4 __attribute__((ext_vector_type(4)));
typedef unsigned u32x4 __attribute__((ext_vector_type(4)));
constexpr int BM = 256, BK = 64, HALF = 128, HTB = HALF * BK * 2  , STAGE_BYTES = 8 * HTB, NXCD = 8, WGM = 8;

__host__ __device__ __forceinline__ int lds_byte(int r, int c) { const int st = (r >> 4) * 2 + (c >> 5), rr = r & 15, cc = c & 31, ob = rr * 64 + cc * 2; return st * 1024 + (ob ^ (((ob >> 9) & 1) << 5)); }
__host__ __device__ __forceinline__ void stage_rc(int b, int& R, int& C) { const int st = b / 1024, sb = b % 1024, swz = sb ^ (((sb >> 9) & 1) << 5); R = (st >> 1) * 16 + swz / 64; C = (st & 1) * 32 + (swz % 64) / 2; }
__host__ __device__ __forceinline__ int perm32(int rho) { const int n = rho >> 4, i = rho & 15; return 8 * (i >> 2) + 4 * n + (i & 3); }

struct Unit { int pm, pn, e, mt; };
struct Gemm { const bf16_t* A; const bf16_t* Bt; int M, N, K; };

struct StaticOrder {
    static constexpr bool GATHER = false;
    int nM, nN, nwg, G, c, rep, off = 0, lim = 1 << 30;
    __host__ __device__ void init(int M, int N, int G_, int c_, int rep_ = 1) { nM = M / BM; nN = N / BM; nwg = nM * nN; G = G_; c = c_; rep = rep_; }
    __host__ __device__ bool next(int i, Unit& u) const {
        long L = (long)i * G + c + off; if (L >= (long)nwg * rep || L >= lim) return false; L %= nwg;
        int wgid = (int)L; { const int q = nwg / NXCD, r = nwg % NXCD, xcd = wgid % NXCD, off = wgid / NXCD; wgid = (xcd < r ? xcd * (q + 1) : r * (q + 1) + (xcd - r) * q) + off; }
        const int nig = WGM * nN, gid = wgid / nig, fm = gid * WGM, gsz = (nM - fm) < WGM ? (nM - fm) : WGM;
        u.pm = fm + ((wgid % nig) % gsz); u.pn = (wgid % nig) / gsz; u.e = 0; u.mt = 0; return true;
    }
    PG8_LAS unsigned char* van = nullptr;
    __device__ __forceinline__ unsigned arow(const Unit&, int) const { return 0u; }
    __device__ __forceinline__ void a_ready(const Unit&) const {}
    __device__ __forceinline__ void done(const Unit&) const {}
};

__device__ __forceinline__ unsigned cvt_pk_bf16(float lo, float hi) { unsigned r; asm volatile("v_cvt_pk_bf16_f32 %0, %1, %2" : "=v"(r) : "v"(lo), "v"(hi)); return r; }

template <class Epi, class Sched, bool ALIGN_EPI = false>
__device__ __forceinline__ void gemm_phase(PG8_LAS unsigned char* lds, const Gemm g, const Sched& S, const Epi& E) {
    const int tid = threadIdx.x, wid = __builtin_amdgcn_readfirstlane(tid >> 6), lane = tid & 63, wr = wid >> 2, wc = wid & 3, fr = lane & 15, fq = lane >> 4;
    const int K = g.K, nt = K / BK;
    constexpr bool GA = Sched::GATHER;
    unsigned voffB[2];
#pragma unroll
    for (int i = 0; i < 2; ++i) { int R, C; stage_rc(tid * 16 + i * 8192, R, C); const int Rb = Epi::PERM ? ((R & ~31) + perm32(R & 31)) : R;
        voffB[i] = (unsigned)(Rb * K + C) * 2u; }
    const size_t kstep = (size_t)(BK * 2);
    const size_t hstep = (size_t)HALF * K * 2;
    const size_t tstep = 2 * hstep;
    const unsigned ldsw = (unsigned)wid * 1024u;
    const int aoff = lds_byte(wr * 64 + fr, fq * 8), boff = lds_byte(wc * 32 + fr, fq * 8);
#define PG8_SA(b, h) (((b) * 2 + (h)) * HTB)
#define PG8_SB(b, h) ((4 + (b) * 2 + (h)) * HTB)
#define PG8_STAGE2(bufoff, gbase, v0, v1) do { \
        __builtin_amdgcn_global_load_lds((const unsigned*)((const char*)(gbase) + (v0)), (PG8_LAS unsigned*)(lds + (bufoff) + ldsw), 16, 0, 0); \
        __builtin_amdgcn_global_load_lds((const unsigned*)((const char*)(gbase) + (v1)), (PG8_LAS unsigned*)(lds + (bufoff) + ldsw + 8192), 16, 0, 0); } while (0)
#define PG8_STAGEB(bufoff, gbase) PG8_STAGE2(bufoff, gbase, voffB[0], voffB[1])
#define PG8_LDA(dst, b, h) do { _Pragma("unroll") for (int m = 0; m < 4; ++m) _Pragma("unroll") for (int k = 0; k < 2; ++k) dst[m][k] = *(const PG8_LAS bf16x8*)(lds + PG8_SA(b, h) + aoff + m * 2048 + k * 1024); } while (0)
#define PG8_LDB(dst, b, h) do { _Pragma("unroll") for (int n = 0; n < 2; ++n) _Pragma("unroll") for (int k = 0; k < 2; ++k) dst[n][k] = *(const PG8_LAS bf16x8*)(lds + PG8_SB(b, h) + boff + n * 2048 + k * 1024); } while (0)
#define PG8_MMA(ai, bj, At, Bt) do { __builtin_amdgcn_s_setprio(1); _Pragma("unroll") for (int m = 0; m < 4; ++m) _Pragma("unroll") for (int n = 0; n < 2; ++n) _Pragma("unroll") for (int k = 0; k < 2; ++k) \
        acc[ai][bj][m][n] = __builtin_amdgcn_mfma_f32_16x16x32_bf16(Bt[n][k], At[m][k], acc[ai][bj][m][n], 0, 0, 0); __builtin_amdgcn_s_setprio(0); } while (0)
#define PG8_WAIT_V(n) asm volatile("s_waitcnt vmcnt(" #n ")" ::: "memory")
#define PG8_WAIT_L(n) asm volatile("s_waitcnt lgkmcnt(" #n ")" ::: "memory")
#define PG8_BAR __builtin_amdgcn_s_barrier()
#define PG8_SCHED __builtin_amdgcn_sched_barrier(0)
#define PG8_SETVA(dst, U) do { _Pragma("unroll") for (int i_ = 0; i_ < 2; ++i_) { int R_, C_; stage_rc(tid * 16 + i_ * 8192, R_, C_); _Pragma("unroll") for (int h_ = 0; h_ < 2; ++h_) \
        dst[h_][i_] = GA ? (unsigned)(S.arow(U, h_ * HALF + R_) * (unsigned)K + (unsigned)C_) * 2u : (unsigned)((h_ * HALF + R_) * K + C_) * 2u; } } while (0)
    Unit cur, nxt; int ui = 0;
    if (!S.next(0, cur)) return;
    f32x4 acc[2][2][4][2];
#pragma unroll
    for (int a = 0; a < 2; ++a)
#pragma unroll
        for (int b = 0; b < 2; ++b)
#pragma unroll
            for (int m = 0; m < 4; ++m)
#pragma unroll
                for (int n = 0; n < 2; ++n) acc[a][b][m][n] = (f32x4){0.f, 0.f, 0.f, 0.f};
    bf16x8 At[4][2], B0[2][2], B1[2][2];
    unsigned vAc[2][2];
    PG8_SETVA(vAc, cur);
    if (GA) { *(PG8_LAS u32x4*)(S.van + tid * 32) = (u32x4){vAc[0][0], vAc[0][1], vAc[1][0], vAc[1][1]}; }
#define PG8_VA(h_, sl_) (GA ? *(const PG8_LAS unsigned long long*)(S.van + tid * 32 + (sl_) * 16 + (h_) * 8) : ((unsigned long long)vAc[h_][0] | ((unsigned long long)vAc[h_][1] << 32)))
#define PG8_STAGEA(bufoff, gbase, h_, sl_) do { const unsigned long long va_ = PG8_VA(h_, sl_); PG8_STAGE2(bufoff, gbase, (unsigned)va_, (unsigned)(va_ >> 32)); } while (0)
    const char* cA = GA ? (const char*)g.A : (const char*)g.A + (size_t)cur.pm * tstep; const char* cB = (const char*)g.Bt + (size_t)cur.pn * tstep;
    S.a_ready(cur);
    PG8_STAGEB(PG8_SB(0, 0), cB); PG8_STAGEB(PG8_SB(0, 1), cB + hstep); PG8_STAGEA(PG8_SA(0, 0), cA, 0, 0); PG8_STAGEA(PG8_SA(0, 1), cA, 1, 0);
    if (wr == 1) PG8_BAR;
    PG8_WAIT_V(2); PG8_BAR;
    PG8_STAGEB(PG8_SB(1, 0), cB + kstep); PG8_STAGEA(PG8_SA(1, 0), cA + kstep, 0, 0); PG8_STAGEB(PG8_SB(1, 1), cB + hstep + kstep);
    PG8_WAIT_V(6); PG8_BAR;
    for (;;) {
        const bool has_next = S.next(ui + 1, nxt);
        const char* nA = GA ? (const char*)g.A : (has_next ? (const char*)g.A + (size_t)nxt.pm * tstep : cA); const char* nB = has_next ? (const char*)g.Bt + (size_t)nxt.pn * tstep : cB;
        if (GA && has_next) { unsigned tmp_[2][2]; PG8_SETVA(tmp_, nxt);
            *(PG8_LAS u32x4*)(S.van + tid * 32 + 16) = (u32x4){tmp_[0][0], tmp_[0][1], tmp_[1][0], tmp_[1][1]}; }
#pragma unroll 1
        for (int t = 0; t < nt; t += 2) {
            const bool last = (t == nt - 2);
            const char* a1 = cA + (size_t)(t + 1) * kstep;
            const char* a2 = last ? nA : cA + (size_t)(t + 2) * kstep; const char* b2 = last ? nB : cB + (size_t)(t + 2) * kstep;
            const char* a3 = a2 + kstep; const char* b3 = b2 + kstep;
            if (last && has_next) S.a_ready(nxt);
            PG8_LDB(B0, 0, 0); PG8_LDB(B1, 0, 1); PG8_SCHED; PG8_LDA(At, 0, 0); PG8_STAGEA(PG8_SA(1, 1), a1, 1, 0);
            const int sl = (GA && last && has_next) ? 1 : 0;
            PG8_WAIT_V(8); PG8_WAIT_L(0); PG8_BAR; PG8_MMA(0, 0, At, B0); PG8_MMA(0, 1, At, B1); PG8_BAR; PG8_SCHED;
            PG8_LDA(At, 0, 1); PG8_STAGEB(PG8_SB(0, 0), b2); PG8_STAGEB(PG8_SB(0, 1), b2 + hstep); PG8_STAGEA(PG8_SA(0, 0), a2, 0, sl);
            PG8_WAIT_V(8); PG8_WAIT_L(0); PG8_BAR; PG8_MMA(1, 0, At, B0); PG8_MMA(1, 1, At, B1); PG8_BAR; PG8_SCHED;
            PG8_LDB(B0, 1, 0); PG8_LDB(B1, 1, 1); PG8_SCHED; PG8_LDA(At, 1, 0); PG8_STAGEA(PG8_SA(0, 1), a2, 1, sl);
            PG8_WAIT_V(8); PG8_WAIT_L(0); PG8_BAR; PG8_MMA(0, 0, At, B0); PG8_MMA(0, 1, At, B1); PG8_BAR; PG8_SCHED;
            PG8_LDA(At, 1, 1); PG8_STAGEB(PG8_SB(1, 0), b3); PG8_STAGEB(PG8_SB(1, 1), b3 + hstep); PG8_STAGEA(PG8_SA(1, 0), a3, 0, sl);
            PG8_WAIT_V(8); PG8_WAIT_L(0); PG8_BAR; PG8_MMA(1, 0, At, B0); PG8_MMA(1, 1, At, B1); PG8_BAR; PG8_SCHED;
        }
        if constexpr (ALIGN_EPI) { if (wr == 0) PG8_BAR; }
        E(acc, cur, wr, wc, fr, fq); S.done(cur);
        if (!has_next) break;
#pragma unroll
        for (int a = 0; a < 2; ++a)
#pragma unroll
            for (int b = 0; b < 2; ++b)
#pragma unroll
                for (int m = 0; m < 4; ++m)
#pragma unroll
                    for (int n = 0; n < 2; ++n) acc[a][b][m][n] = (f32x4){0.f, 0.f, 0.f, 0.f};
        cur = nxt; cA = nA; cB = nB; ++ui;
        if (GA) { *(PG8_LAS u32x4*)(S.van + tid * 32) = *(const PG8_LAS u32x4*)(S.van + tid * 32 + 16); }
        if constexpr (ALIGN_EPI) { if (wr == 1) PG8_BAR; }
    }
    PG8_WAIT_V(0);
    if constexpr (!ALIGN_EPI) { if (wr == 0) PG8_BAR; }
    PG8_BAR;
#undef PG8_SA
#undef PG8_SB
#undef PG8_STAGE2
#undef PG8_STAGEB
#undef PG8_LDA
#undef PG8_LDB
#undef PG8_MMA
#undef PG8_WAIT_V
#undef PG8_WAIT_L
#undef PG8_BAR
#undef PG8_SCHED
#undef PG8_SETVA
#undef PG8_VA
#undef PG8_STAGEA
}

__device__ __forceinline__ float rs_of(float ss) { return rsqrtf(ss * (1.0f / 1024.0f) + 1e-6f); }
struct EpiScaleBf16 {
    static constexpr bool PERM = true;
    bf16_t* O; int ldc; const float* ss; int npn; const float* lsb0; const float* lsb1; int ls_col0; const PG8_LAS unsigned* cntp = nullptr;
    __device__ __forceinline__ void operator()(const f32x4 (&acc)[2][2][4][2], const Unit& u, int wr, int wc, int fr, int fq) const {
        const int row0 = u.pm * BM + wr * 64 + fr; const int colt = (u.pn % npn) * BM, col0 = colt + wc * 32 + 8 * fq;
        const bool ls = lsb0 != nullptr && colt >= ls_col0;
        const int vrows = cntp ? (int)cntp[u.e] - u.mt * BM : BM;
        f32x4 bv[2][2];
#pragma unroll
        for (int bj = 0; bj < 2; ++bj)
#pragma unroll
            for (int n = 0; n < 2; ++n) bv[bj][n] = ls ? *(const f32x4*)((colt >= ls_col0 + 256 ? lsb1 : lsb0) + wc * 32 + 8 * fq + bj * HALF + 4 * n) : (f32x4){0.f, 0.f, 0.f, 0.f};
#pragma unroll
        for (int ai = 0; ai < 2; ++ai)
#pragma unroll
            for (int m = 0; m < 4; ++m) { const int row = row0 + ai * HALF + m * 16; const float sc = ss ? rs_of(ss[row]) : 1.0f; bf16_t* rowp = O + (size_t)row * ldc + col0;
#pragma unroll
                for (int bj = 0; bj < 2; ++bj) { f32x4 v0 = acc[ai][bj][m][0] * sc, v1 = acc[ai][bj][m][1] * sc;
                    if (ls) {
#pragma unroll
                        for (int i = 0; i < 4; ++i) { const float z0 = v0[i] + bv[bj][0][i], z1 = v1[i] + bv[bj][1][i];
                            v0[i] = (fminf(z0, 0.f) - __logf(1.0f + __expf(-fabsf(z0)))) * 0.0625f; v1[i] = (fminf(z1, 0.f) - __logf(1.0f + __expf(-fabsf(z1)))) * 0.0625f; } }
                    u32x4 w; w.x = cvt_pk_bf16(v0[0], v0[1]); w.y = cvt_pk_bf16(v0[2], v0[3]); w.z = cvt_pk_bf16(v1[0], v1[1]); w.w = cvt_pk_bf16(v1[2], v1[3]);
                    if (row - u.pm * BM < vrows) *(u32x4*)(rowp + bj * HALF) = w; } }
    }
};
struct EpiInProj0 {
    static constexpr bool PERM = true;
    bf16_t* O; const float* ss; const float* lsb0; const float* lsb1;
    __device__ __forceinline__ void operator()(const f32x4 (&acc)[2][2][4][2], const Unit& u, int wr, int wc, int fr, int fq) const {
        const int row0 = u.pm * BM + wr * 64 + fr, tile = u.pn;
        if (tile >= 2 && tile < 6) { const int col0 = 512 + (tile - 2) * 128 + wc * 32 + 8 * fq;
#pragma unroll
            for (int ai = 0; ai < 2; ++ai)
#pragma unroll
                for (int m = 0; m < 4; ++m) { const int row = row0 + ai * HALF + m * 16; const float sc = rs_of(ss[row]), s2 = sc * sc;
                    const f32x4 v0 = acc[ai][0][m][0] * acc[ai][1][m][0] * s2, v1 = acc[ai][0][m][1] * acc[ai][1][m][1] * s2;
                    u32x4 w; w.x = cvt_pk_bf16(v0[0], v0[1]); w.y = cvt_pk_bf16(v0[2], v0[3]); w.z = cvt_pk_bf16(v1[0], v1[1]); w.w = cvt_pk_bf16(v1[2], v1[3]);
                    *(u32x4*)(O + (size_t)row * 3072 + col0) = w; }
            return; }
        const int colt = tile < 2 ? tile * BM : (tile - 2) * BM, col0 = colt + wc * 32 + 8 * fq; const bool ls = tile >= 12;
        f32x4 bv[2][2];
#pragma unroll
        for (int bj = 0; bj < 2; ++bj)
#pragma unroll
            for (int n = 0; n < 2; ++n) bv[bj][n] = ls ? *(const f32x4*)((tile == 13 ? lsb1 : lsb0) + wc * 32 + 8 * fq + bj * HALF + 4 * n) : (f32x4){0.f, 0.f, 0.f, 0.f};
#pragma unroll
        for (int ai = 0; ai < 2; ++ai)
#pragma unroll
            for (int m = 0; m < 4; ++m) { const int row = row0 + ai * HALF + m * 16; const float sc = rs_of(ss[row]); bf16_t* rowp = O + (size_t)row * 3072 + col0;
#pragma unroll
                for (int bj = 0; bj < 2; ++bj) { f32x4 v0 = acc[ai][bj][m][0] * sc, v1 = acc[ai][bj][m][1] * sc;
                    if (ls) {
#pragma unroll
                        for (int i = 0; i < 4; ++i) { const float z0 = v0[i] + bv[bj][0][i], z1 = v1[i] + bv[bj][1][i];
                            v0[i] = (fminf(z0, 0.f) - __logf(1.0f + __expf(-fabsf(z0)))) * 0.0625f; v1[i] = (fminf(z1, 0.f) - __logf(1.0f + __expf(-fabsf(z1)))) * 0.0625f; } }
                    u32x4 w; w.x = cvt_pk_bf16(v0[0], v0[1]); w.y = cvt_pk_bf16(v0[2], v0[3]); w.z = cvt_pk_bf16(v1[0], v1[1]); w.w = cvt_pk_bf16(v1[2], v1[3]);
                    *(u32x4*)(rowp + bj * HALF) = w; } }
    }
};
template <bool RESBF> struct EpiResBf16 {
    static constexpr bool PERM = true;
    const float* resA; const float* resB; int rmask; bf16_t* out; const bf16_t* resb;
    __device__ __forceinline__ void operator()(const f32x4 (&acc)[2][2][4][2], const Unit& u, int wr, int wc, int fr, int fq) const {
        const int row0 = u.pm * BM + wr * 64 + fr, col0 = u.pn * BM + wc * 32 + 8 * fq;
#pragma unroll
        for (int ai = 0; ai < 2; ++ai)
#pragma unroll
            for (int m = 0; m < 4; ++m) { const int row = row0 + ai * HALF + m * 16; bf16_t* op = out + (size_t)row * D + col0;
#pragma unroll
                for (int bj = 0; bj < 2; ++bj) { f32x4 r0, r1;
                    if (RESBF) { const u32x4 rw = *(const u32x4*)(resb + (size_t)row * D + col0 + bj * HALF);
                        r0 = (f32x4){__uint_as_float(rw.x << 16), __uint_as_float(rw.x & 0xffff0000u), __uint_as_float(rw.y << 16), __uint_as_float(rw.y & 0xffff0000u)};
                        r1 = (f32x4){__uint_as_float(rw.z << 16), __uint_as_float(rw.z & 0xffff0000u), __uint_as_float(rw.w << 16), __uint_as_float(rw.w & 0xffff0000u)};
                    } else { const float* rp = (row < MR ? resA + (size_t)row * D : resB + (size_t)((row - MR) & rmask) * D) + col0 + bj * HALF; r0 = *(const f32x4*)rp; r1 = *(const f32x4*)(rp + 4); }
                    const f32x4 v0 = acc[ai][bj][m][0] + r0, v1 = acc[ai][bj][m][1] + r1;
                    u32x4 w; w.x = cvt_pk_bf16(v0[0], v0[1]); w.y = cvt_pk_bf16(v0[2], v0[3]); w.z = cvt_pk_bf16(v1[0], v1[1]); w.w = cvt_pk_bf16(v1[2], v1[3]);
                    *(u32x4*)(op + bj * HALF) = w; } }
    }
};
struct EpiQKV {
    static constexpr bool PERM = true;
    bf16_t* O; const float* ss; const float* qn; const float* kn; const PG8_LAS float* rope; float c2;
    __device__ __forceinline__ void operator()(const f32x4 (&acc)[2][2][4][2], const Unit& u, int wr, int wc, int fr, int fq) const {
        const int row0 = u.pm * BM + wr * 64 + fr, tile = u.pn;
        if (tile == 5) { const int col0 = tile * BM + wc * 32 + 8 * fq;
#pragma unroll
            for (int ai = 0; ai < 2; ++ai)
#pragma unroll
                for (int m = 0; m < 4; ++m) { const int row = row0 + ai * HALF + m * 16; const float sc = rs_of(ss[row]); bf16_t* rowp = O + (size_t)row * 1536 + col0;
#pragma unroll
                    for (int bj = 0; bj < 2; ++bj) { const f32x4 v0 = acc[ai][bj][m][0] * sc, v1 = acc[ai][bj][m][1] * sc;
                        u32x4 w; w.x = cvt_pk_bf16(v0[0], v0[1]); w.y = cvt_pk_bf16(v0[2], v0[3]); w.z = cvt_pk_bf16(v1[0], v1[1]); w.w = cvt_pk_bf16(v1[2], v1[3]);
                        *(u32x4*)(rowp + bj * HALF) = w; } }
            return; }
        const float* nw = (tile < 4 ? qn : kn) + 8 * fq; const float hs = tile < 4 ? c2 : 1.0f;
        f32x4 g[2][2];
#pragma unroll
        for (int bj = 0; bj < 2; ++bj)
#pragma unroll
            for (int n = 0; n < 2; ++n) g[bj][n] = *(const f32x4*)(nw + bj * 32 + 4 * n);
#pragma unroll
        for (int ai = 0; ai < 2; ++ai)
#pragma unroll
            for (int m = 0; m < 4; ++m) { const int row = row0 + ai * HALF + m * 16; const float sc = rs_of(ss[row]);
                f32x4 v[2][2]; float s2 = 0.f;
#pragma unroll
                for (int bj = 0; bj < 2; ++bj)
#pragma unroll
                    for (int n = 0; n < 2; ++n) { v[bj][n] = acc[ai][bj][m][n] * sc; s2 += (v[bj][n][0] * v[bj][n][0] + v[bj][n][1] * v[bj][n][1]) + (v[bj][n][2] * v[bj][n][2] + v[bj][n][3] * v[bj][n][3]); }
                s2 += __shfl_xor(s2, 16); s2 += __shfl_xor(s2, 32);
                const float rs = rsqrtf(s2 * (1.0f / 64.0f) + 1e-6f) * hs; const bool rot = row < MR; const int sp = row & 2047;
                bf16_t* rowp = O + (size_t)row * 1536 + tile * BM + wc * 64 + 8 * fq;
#pragma unroll
                for (int bj = 0; bj < 2; ++bj) { const int pos = bj ? (sp & 63) : (sp >> 6); unsigned ow[4];
#pragma unroll
                    for (int n = 0; n < 2; ++n) { f32x4 cs = (f32x4){1.f, 0.f, 1.f, 0.f}; if (rot) cs = *(const PG8_LAS f32x4*)(rope + (pos * 16 + 4 * fq + 2 * n) * 2);
                        const f32x4 a = v[bj][n] * rs * g[bj][n];
                        ow[2 * n] = cvt_pk_bf16(a[0] * cs[0] - a[1] * cs[1], a[0] * cs[1] + a[1] * cs[0]); ow[2 * n + 1] = cvt_pk_bf16(a[2] * cs[2] - a[3] * cs[3], a[2] * cs[3] + a[3] * cs[2]); }
                    *(u32x4*)(rowp + bj * 32) = (u32x4){ow[0], ow[1], ow[2], ow[3]}; } }
    }
};
}
namespace attn_body {
using bf16=__hip_bfloat16;
using bf16x8=__attribute__((ext_vector_type(8)))short;
using s16x4=__attribute__((ext_vector_type(4)))short;
using f32x16=__attribute__((ext_vector_type(16)))float;
using u32x4=__attribute__((ext_vector_type(4)))unsigned;
constexpr int BATCH=8,NHEAD=16,SEQ=2048,D=64,DM=1536,DMO=1024;
constexpr int KCOL=1024,VCOL=1280,META0=BATCH*SEQ;
constexpr int NW=8,QBLK=32,QB=QBLK*NW,KVBLK=64,NQB=SEQ/QB;
constexpr int ATTN_UNIT_ROWS=QB; constexpr int NTILES=33;
__device__ __forceinline__ int crow(int r,int hi){return (r&3)+8*(r>>2)+4*hi;}
#define SBAR() __builtin_amdgcn_sched_barrier(0)
__device__ __forceinline__ void cmask(f32x16&p0,f32x16&p1,int jb,int qrel,int hi){
  const float NEG=-INFINITY; int kb=64*jb+4*hi;
  #pragma unroll
  for(int r=0;r<16;++r){int kv=kb+(r&3)+8*(r>>2); if(kv>qrel)p0[r]=NEG; if(kv+32>qrel)p1[r]=NEG;}
}

__device__ __forceinline__ void kvmask(f32x16&p0,f32x16&p1,int limit,int hi){
  const float NEG=-INFINITY; const int kb=4*hi;
  #pragma unroll
  for(int r=0;r<16;++r){int kv=kb+(r&3)+8*(r>>2); if(kv>=limit)p0[r]=NEG; if(kv+32>=limit)p1[r]=NEG;}
}
constexpr int NSLOT=3, SLOTB=8192;
constexpr int LDS_K=0, LDS_V=NSLOT*SLOTB, LDS_WS=2*NSLOT*SLOTB, LDS_OST=LDS_WS+NW*64*4, LDS_BYTES=LDS_OST+NW*4096;
constexpr float C2=0.125f*1.4426950408889634f;
__device__ __forceinline__ void glds16(const void*gsrc,unsigned lds_dst){unsigned keep;
  asm volatile("s_mov_b32 %0, m0\n\ts_mov_b32 m0, %2\n\ts_nop 0\n\tglobal_load_lds_dwordx4 %1, off\n\ts_mov_b32 m0, %0":"=&s"(keep):"v"(gsrc),"s"(lds_dst):"memory");}
__device__ __forceinline__ float max3f(float a,float b,float c){float r;asm("v_max3_f32 %0, %1, %2, %3":"=v"(r):"v"(a),"v"(b),"v"(c));return r;}
__device__ __forceinline__ float max2f(float a,float b){float r;asm("v_max_f32_e32 %0, %1, %2":"=v"(r):"v"(a),"v"(b));return r;}
__device__ __forceinline__ float fadd_s(float a,float b){float r;asm("v_add_f32_e32 %0, %1, %2":"=v"(r):"v"(a),"v"(b));return r;}
__device__ __forceinline__ float fsub_s(float a,float b){float r;asm("v_sub_f32_e32 %0, %1, %2":"=v"(r):"v"(a),"v"(b));return r;}
typedef float f32x2_t __attribute__((ext_vector_type(2))); typedef __bf16 bf16x2_t __attribute__((ext_vector_type(2)));
__device__ __forceinline__ unsigned cvtpk_s(float lo,float hi){f32x2_t v={lo,hi};bf16x2_t b=__builtin_convertvector(v,bf16x2_t);return __builtin_bit_cast(unsigned,b);}
#define WAIT_BAR(N) asm volatile("s_waitcnt vmcnt(" #N ") lgkmcnt(0)\n\ts_barrier":::"memory")

__device__ __forceinline__ void qkt(f32x16&p0,f32x16&p1,const char*Kslot,const bf16x8*qr,const f32x16&negm,int r32,int hi){
  const char*kb=Kslot+hi*1024+r32*16;
  #pragma unroll
  for(int d0=0;d0<4;++d0){
    const bf16x8 b0=*reinterpret_cast<const bf16x8*>(kb+d0*2048);
    const bf16x8 b1=*reinterpret_cast<const bf16x8*>(kb+d0*2048+512);
    if(d0==0){p0=__builtin_amdgcn_mfma_f32_32x32x16_bf16(b0,qr[0],negm,0,0,0);p1=__builtin_amdgcn_mfma_f32_32x32x16_bf16(b1,qr[0],negm,0,0,0);}
    else{p0=__builtin_amdgcn_mfma_f32_32x32x16_bf16(b0,qr[d0],p0,0,0,0);p1=__builtin_amdgcn_mfma_f32_32x32x16_bf16(b1,qr[d0],p1,0,0,0);}}
}
typedef __attribute__((address_space(3))) const char* lds_cptr;
typedef short v4i16_t __attribute__((ext_vector_type(4)));
__device__ __forceinline__ void kload8(bf16x8*kf,lds_cptr kp){
  kf[0]=*(const __attribute__((address_space(3))) bf16x8*)(kp);      kf[1]=*(const __attribute__((address_space(3))) bf16x8*)(kp+512);
  kf[2]=*(const __attribute__((address_space(3))) bf16x8*)(kp+2048); kf[3]=*(const __attribute__((address_space(3))) bf16x8*)(kp+2560);
  kf[4]=*(const __attribute__((address_space(3))) bf16x8*)(kp+4096); kf[5]=*(const __attribute__((address_space(3))) bf16x8*)(kp+4608);
  kf[6]=*(const __attribute__((address_space(3))) bf16x8*)(kp+6144); kf[7]=*(const __attribute__((address_space(3))) bf16x8*)(kp+6656);
}
__device__ __forceinline__ void kload2(bf16x8*kf,lds_cptr kp,int j){ kf[2*j]=*(const __attribute__((address_space(3))) bf16x8*)(kp+j*2048); kf[2*j+1]=*(const __attribute__((address_space(3))) bf16x8*)(kp+j*2048+512); }
__device__ __forceinline__ s16x4 vtr(lds_cptr p){ return __builtin_bit_cast(s16x4,__builtin_amdgcn_ds_read_tr16_b64_v4i16((__attribute__((address_space(3))) v4i16_t*)p)); }
__device__ __forceinline__ float rowmax(const f32x16&p0,const f32x16&p1){
  float a=max3f(p0[0],p0[1],p1[0]),b=max3f(p0[2],p0[3],p1[1]);a=max3f(a,p1[2],p1[3]);
  #pragma unroll
  for(int r=4;r<16;r+=4){a=max3f(a,p0[r],p0[r+1]);b=max3f(b,p0[r+2],p0[r+3]);a=max3f(a,p1[r],p1[r+1]);b=max3f(b,p1[r+2],p1[r+3]);}
  const float m=max2f(a,b);
  auto rr=__builtin_amdgcn_permlane32_swap(__float_as_uint(m),__float_as_uint(m),false,false);
  return max2f(__uint_as_float(rr[0]),__uint_as_float(rr[1]));
}
__device__ __forceinline__ void pv(f32x16*o,int vb,bf16x8 pa0,bf16x8 pa1,bf16x8 pa2,bf16x8 pa3){
  #pragma unroll
  for(int d0=0;d0<2;++d0){s16x4 lo[4],hi[4];
    #pragma unroll
    for(int ks=0;ks<4;++ks){
      asm volatile("ds_read_b64_tr_b16 %0,%1 offset:%c2":"=&v"(lo[ks]):"v"(vb),"i"(d0*4096+ks*1024):"memory");
      asm volatile("ds_read_b64_tr_b16 %0,%1 offset:%c2":"=&v"(hi[ks]):"v"(vb),"i"(d0*4096+ks*1024+512):"memory");}
    asm volatile("s_waitcnt lgkmcnt(0)":::"memory");SBAR();
    #define PK(k) (bf16x8){lo[k][0],lo[k][1],lo[k][2],lo[k][3],hi[k][0],hi[k][1],hi[k][2],hi[k][3]}
    o[d0]=__builtin_amdgcn_mfma_f32_32x32x16_bf16(pa0,PK(0),o[d0],0,0,0);
    o[d0]=__builtin_amdgcn_mfma_f32_32x32x16_bf16(pa1,PK(1),o[d0],0,0,0);
    o[d0]=__builtin_amdgcn_mfma_f32_32x32x16_bf16(pa2,PK(2),o[d0],0,0,0);
    o[d0]=__builtin_amdgcn_mfma_f32_32x32x16_bf16(pa3,PK(3),o[d0],0,0,0);
    #undef PK
  }
}

#ifndef ATTN_STORE16
#define ATTN_STORE16(p,v) (*(u32x4*)(p)=(v))
#endif
template<int THRL> __device__ __forceinline__ void attn_unit(int b,int h,int qb,const bf16*Q,const bf16*__restrict__ K,const bf16*__restrict__ V,bf16*O,char*shm){
  const int tid=threadIdx.x,lane=tid&63,r32=lane&31,hi=lane>>5; const int wid=__builtin_amdgcn_readfirstlane(tid>>6);
  const long rowbase=(long)b*SEQ; const int q0=qb*QB; const int kvh=h>>2;
  const bf16*Qw=Q+(rowbase+q0+wid*QBLK)*DM+h*D;
  const bf16*Kh=K+KCOL+kvh*D,*Vh=K+VCOL+kvh*D; (void)V;
  #define TROW(t) ((long)(((t)==0)?(META0+b*16):(rowbase+((t)-1)*KVBLK)))
  const unsigned lds0=(unsigned)(uintptr_t)shm;
  float*wsf=(float*)(shm+LDS_WS)+wid*64;
  const bf16*ksrc=Kh+(long)lane*DM+wid*8;
  const bf16*vsrc=Vh+(long)(16*(wid&3)+(lane>>2))*DM+(wid>>2)*32+(lane&3)*8;
  const unsigned kdst=lds0+LDS_K+wid*1024, vdst=lds0+LDS_V+wid*1024;
  #define DMA_K(t,slot) glds16(ksrc+TROW(t)*DM,(unsigned)__builtin_amdgcn_readfirstlane(kdst+(slot)))
  #define DMA_V(t,slot) glds16(vsrc+TROW(t)*DM,(unsigned)__builtin_amdgcn_readfirstlane(vdst+(slot)))
  const int vb0=(int)(lds0+LDS_V)+((lane>>4)&1)*32+(lane&3)*8+(4*hi+((lane&15)>>2))*64;
  const char*Kbase=shm+LDS_K; bf16x8 kf[8];
  const lds_cptr shm3=(lds_cptr)shm; const lds_cptr kp0=shm3+LDS_K+hi*1024+r32*16; const lds_cptr vp0=shm3+LDS_V+((lane>>4)&1)*32+(lane&3)*8+(4*hi+((lane&15)>>2))*64;
  const int NT=NTILES;
  DMA_K(0,0);DMA_V(0,0);DMA_K(1,SLOTB);
  bf16x8 qr[4];
  #pragma unroll
  for(int d0=0;d0<4;++d0)qr[d0]=*reinterpret_cast<const bf16x8*>(&Qw[(long)r32*DM+d0*16+hi*8]);
  float mhat=0.f,l_reg=0.f;f32x16 o[2];o[0]=f32x16{};o[1]=f32x16{};f32x16 negm=f32x16{};asm volatile("":"+v"(negm));
  #define CMASK(P0,P1,t) do{ if((t)==0)kvmask(P0,P1,16,hi); }while(0)
  bool resc=false;
  #define START(P0,P1) do{ const float rm=rowmax(P0,P1); resc=false; \
    { const float dl=rm; mhat=fadd_s(mhat,dl); \
      _Pragma("unroll") for(int r=0;r<16;++r){P0[r]=fsub_s(P0[r],dl);P1[r]=fsub_s(P1[r],dl);} \
      _Pragma("unroll") for(int r=0;r<16;++r)negm[r]=-mhat; asm volatile("":"+v"(negm)); } \
    _Pragma("unroll") for(int r=0;r<16;++r)P0[r]=__builtin_amdgcn_exp2f(P0[r]); }while(0)
  #define RESC() do{ if(resc){ asm volatile("s_waitcnt lgkmcnt(0)":::"memory"); \
      _Pragma("unroll") for(int d_=0;d_<2;++d_) _Pragma("unroll") for(int r=0;r<16;++r)o[d_][r]*=wsf[crow(r,hi)]; } }while(0)
  f32x16 pA0,pA1,pB0,pB1;
  int sl_prev=0,sl_cur=0,sl_next=SLOTB;
  #define ROT() do{sl_prev=sl_cur;sl_cur=sl_next;sl_next=(sl_next==(NSLOT-1)*SLOTB)?0:sl_next+SLOTB;}while(0)
  DMA_K(2,2*SLOTB);
  WAIT_BAR(3);
  qkt(pA0,pA1,Kbase,qr,negm,r32,hi);asm volatile("s_nop 15\n\ts_nop 7":"+v"(pA0),"+v"(pA1));CMASK(pA0,pA1,0);
  START(pA0,pA1);
  _Pragma("unroll") for(int r=0;r<16;++r)pA1[r]=__builtin_amdgcn_exp2f(pA1[r]);
  WAIT_BAR(0);
  DMA_K(3,0);DMA_V(1,SLOTB);
  ROT();
  kload8(kf,kp0+sl_cur);
  WAIT_BAR(2);
  s16x4 vlo[8],vhi[8]; u32x4 pw0,pw1,pw2,pw3;
  #define PKW(P,B) cvtpk_s(P[B],P[B+1])
  #define PAF(k) __builtin_bit_cast(bf16x8,pw##k)
  #define VFR(i) (bf16x8){vlo[i][0],vlo[i][1],vlo[i][2],vlo[i][3],vhi[i][0],vhi[i][1],vhi[i][2],vhi[i][3]}
  #define PIN(x) asm volatile("":"+v"(x))
  #define MX3(a,b,c) __builtin_fmaxf(__builtin_fmaxf((a),(b)),(c))
  #define GAPA(MF,A0,A1,A2,A3,W0,W1,PW) do{ MF; sacc+=A0; sacc+=A1; sacc+=A2; sacc+=A3; PIN(sacc); W0; W1; PIN(PW); SBAR(); }while(0)
  #define EX(v) __builtin_amdgcn_exp2f(v)
  #define GAPB(MF,X,B) do{ MF; X[B]=EX(X[B]); X[B+1]=EX(X[B+1]); X[B+2]=EX(X[B+2]); X[B+3]=EX(X[B+3]); PIN(X); SBAR(); }while(0)
  #define VRD(i) do{ vlo[i]=vtr(vp_+(((i)>>2)*4096+((i)&3)*1024)); vhi[i]=vtr(vp_+(((i)>>2)*4096+((i)&3)*1024+512)); }while(0)
  #define KRD(G,j) do{ if(G){ kload2(kf,kp0+sl_next,j); SBAR(); } }while(0)
  #define STEP(C0,C1,P0,P1,t,GK,GV,GL) do{ SBAR(); \
    const lds_cptr vp_=vp0+sl_prev; \
    VRD(0); SBAR(); float sacc=(P0[0]+P0[1]); \
    GAPA(C0=__builtin_amdgcn_mfma_f32_32x32x16_bf16(kf[0],qr[0],negm,0,0,0), P0[2],P0[3],P0[4],P0[5],     pw0[0]=PKW(P0,0), pw0[1]=PKW(P0,2), pw0); \
    VRD(4); SBAR(); GAPA(C1=__builtin_amdgcn_mfma_f32_32x32x16_bf16(kf[1],qr[0],negm,0,0,0), P0[6],P0[7],P0[8],P0[9],     pw0[2]=PKW(P0,4), pw0[3]=PKW(P0,6), pw0); \
    VRD(1); SBAR(); GAPA(C0=__builtin_amdgcn_mfma_f32_32x32x16_bf16(kf[2],qr[1],C0,0,0,0),   P0[10],P0[11],P0[12],P0[13], pw1[0]=PKW(P0,8), pw1[1]=PKW(P0,10), pw1); \
    VRD(5); SBAR(); GAPA(C1=__builtin_amdgcn_mfma_f32_32x32x16_bf16(kf[3],qr[1],C1,0,0,0),   P0[14],P0[15],P1[0],P1[1],   pw1[2]=PKW(P0,12),pw1[3]=PKW(P0,14), pw1); \
    VRD(2); SBAR(); GAPA(C0=__builtin_amdgcn_mfma_f32_32x32x16_bf16(kf[4],qr[2],C0,0,0,0),   P1[2],P1[3],P1[4],P1[5],     pw2[0]=PKW(P1,0), pw2[1]=PKW(P1,2), pw2); \
    VRD(6); SBAR(); GAPA(C1=__builtin_amdgcn_mfma_f32_32x32x16_bf16(kf[5],qr[2],C1,0,0,0),   P1[6],P1[7],P1[8],P1[9],     pw2[2]=PKW(P1,4), pw2[3]=PKW(P1,6), pw2); \
    VRD(3); SBAR(); GAPA(C0=__builtin_amdgcn_mfma_f32_32x32x16_bf16(kf[6],qr[3],C0,0,0,0),   P1[10],P1[11],P1[12],P1[13], pw3[0]=PKW(P1,8), pw3[1]=PKW(P1,10), pw3); \
    VRD(7); SBAR(); GAPA(C1=__builtin_amdgcn_mfma_f32_32x32x16_bf16(kf[7],qr[3],C1,0,0,0),   P1[14],P1[15],0.f,0.f,       pw3[2]=PKW(P1,12),pw3[3]=PKW(P1,14), pw3); \
    l_reg+=sacc; \
    if(GK){DMA_K((t)+3,sl_cur);} if(GV){DMA_V((t)+1,sl_next);} \
    CMASK(C0,C1,t); \
    { float a=MX3(C0[0],C0[1],C1[0]),b=MX3(C0[2],C0[3],C1[1]); a=MX3(a,C1[2],C1[3]); \
      _Pragma("unroll") for(int r=4;r<16;r+=4){a=MX3(a,C0[r],C0[r+1]);b=MX3(b,C0[r+2],C0[r+3]);a=MX3(a,C1[r],C1[r+1]);b=MX3(b,C1[r+2],C1[r+3]);} \
      float rm=__builtin_fmaxf(a,b); { auto rr=__builtin_amdgcn_permlane32_swap(__float_as_uint(rm),__float_as_uint(rm),false,false); rm=__builtin_fmaxf(__uint_as_float(rr[0]),__uint_as_float(rr[1])); } \
      resc=false; \
      if(__builtin_expect(__any(rm>(float)THRL),0)){ const float dl=__builtin_fmaxf(rm,0.f); mhat+=dl; \
        _Pragma("unroll") for(int r=0;r<16;++r){C0[r]-=dl;C1[r]-=dl;} \
        _Pragma("unroll") for(int r=0;r<16;++r)negm[r]=-mhat; asm volatile("":"+v"(negm)); \
        const float f=__builtin_amdgcn_exp2f(-dl); l_reg*=f; if(hi==0)wsf[r32]=f; resc=true; } } \
    SBAR(); \
    GAPB(o[0]=__builtin_amdgcn_mfma_f32_32x32x16_bf16(PAF(0),VFR(0),o[0],0,0,0), C0,0); \
    GAPB(o[1]=__builtin_amdgcn_mfma_f32_32x32x16_bf16(PAF(0),VFR(4),o[1],0,0,0), C0,4); \
    KRD(GL,0); GAPB(o[0]=__builtin_amdgcn_mfma_f32_32x32x16_bf16(PAF(1),VFR(1),o[0],0,0,0), C0,8); \
    KRD(GL,1); GAPB(o[1]=__builtin_amdgcn_mfma_f32_32x32x16_bf16(PAF(1),VFR(5),o[1],0,0,0), C0,12); \
    KRD(GL,2); GAPB(o[0]=__builtin_amdgcn_mfma_f32_32x32x16_bf16(PAF(2),VFR(2),o[0],0,0,0), C1,0); \
    KRD(GL,3); GAPB(o[1]=__builtin_amdgcn_mfma_f32_32x32x16_bf16(PAF(2),VFR(6),o[1],0,0,0), C1,4); \
    GAPB(o[0]=__builtin_amdgcn_mfma_f32_32x32x16_bf16(PAF(3),VFR(3),o[0],0,0,0), C1,8); \
    GAPB(o[1]=__builtin_amdgcn_mfma_f32_32x32x16_bf16(PAF(3),VFR(7),o[1],0,0,0), C1,12); \
    }while(0)
  int t=1;
  #undef CMASK
  #define CMASK(P0,P1,t) do{}while(0)
  for(;t+5<NT;t+=2){
    STEP(pB0,pB1,pA0,pA1,t,true,true,true);     WAIT_BAR(2); RESC(); ROT();
    STEP(pA0,pA1,pB0,pB1,t+1,true,true,true);   WAIT_BAR(2); RESC(); ROT();
  }
  #undef CMASK
  #define CMASK(P0,P1,t) do{}while(0)
  #define ENDW(tt) do{ if((tt)+3<NT){WAIT_BAR(2);} else if((tt)+2<NT){WAIT_BAR(1);} else {WAIT_BAR(0);} }while(0)
  for(;t+1<NT;t+=2){
    STEP(pB0,pB1,pA0,pA1,t,(t+3<NT),(t+1<NT),(t+1<NT));       ENDW(t);   RESC(); ROT();
    STEP(pA0,pA1,pB0,pB1,t+1,(t+4<NT),(t+2<NT),(t+2<NT));     ENDW(t+1); RESC(); ROT();
  }
  static_assert(NTILES%2==1,"odd tile count: the last pair of steps ends with tile NT-1 in buffer A");
  { float sacc=pA0[0]+pA0[1]; _Pragma("unroll") for(int r=2;r<16;++r)sacc+=pA0[r]; _Pragma("unroll") for(int r=0;r<16;++r)sacc+=pA1[r]; l_reg+=sacc;
    pw0=(u32x4){PKW(pA0,0),PKW(pA0,2),PKW(pA0,4),PKW(pA0,6)};pw1=(u32x4){PKW(pA0,8),PKW(pA0,10),PKW(pA0,12),PKW(pA0,14)};pw2=(u32x4){PKW(pA1,0),PKW(pA1,2),PKW(pA1,4),PKW(pA1,6)};pw3=(u32x4){PKW(pA1,8),PKW(pA1,10),PKW(pA1,12),PKW(pA1,14)};
    SBAR(); pv(o,vb0+sl_prev,PAF(0),PAF(1),PAF(2),PAF(3)); }
  #undef PKW
  #undef PAF
  #undef VFR
  #undef PIN
  #undef MX3
  #undef GAPA
  #undef GAPB
  #undef EX
  #undef VRD
  #undef KRD
  #undef STEP
  #undef ENDW
  {auto rr=__builtin_amdgcn_permlane32_swap(__float_as_uint(l_reg),__float_as_uint(l_reg),false,false);l_reg=__uint_as_float(rr[0])+__uint_as_float(rr[1]);}
  if(hi==0)wsf[32+r32]=l_reg;asm volatile("s_waitcnt lgkmcnt(0)":::"memory");
  float rli[16];
  #pragma unroll
  for(int r=0;r<16;++r)rli[r]=__builtin_amdgcn_rcpf(wsf[32+crow(r,hi)]);
  bf16*Ow=O+(rowbase+q0+wid*QBLK)*DMO+h*D;
  { bf16*stg=(bf16*)(shm+LDS_OST)+wid*2048;
    #pragma unroll
    for(int r=0;r<16;++r){const int orow=crow(r,hi);
      #pragma unroll
      for(int d0=0;d0<2;++d0)stg[orow*64+d0*32+r32]=__float2bfloat16(o[d0][r]*rli[r]);}
    asm volatile("s_waitcnt lgkmcnt(0)":::"memory");
    #pragma unroll
    for(int i=0;i<4;++i){const int row=i*8+(lane>>3),ch=lane&7; const u32x4 v=*(const u32x4*)(stg+row*64+ch*8); ATTN_STORE16(Ow+(long)row*DMO+ch*8,v);} }
  asm volatile("s_waitcnt lgkmcnt(0)\n\ts_barrier":::"memory");
  #undef DMA_K
  #undef DMA_V
  #undef TROW
  #undef CMASK
  #undef START
  #undef RESC
  #undef ROT
}
constexpr int ATTN_LDS_BYTES=LDS_BYTES;
struct AttnTensors { const bf16* Q; const bf16* K; const bf16* V; bf16* O; };
struct AttnUnit { int bh; int qb; };
struct StaticOrder {
  int vcu,rep,G;
  __device__ __forceinline__ explicit StaticOrder(int v,int r,int g):vcu(v),rep(r),G(g){}
  __device__ __forceinline__ bool next(int i,AttnUnit&u)const{
    if(G==256){ if(i>=4*rep)return false; u.bh=vcu>>1; u.qb=(vcu&1)*4+(i&3); return true; }
    const int L=vcu+i*G; if(L>=BATCH*NHEAD*8)return false; u.bh=L>>3; u.qb=L&7; return true; }
  __device__ __forceinline__ void a_ready(const AttnUnit&)const{}
  __device__ __forceinline__ void done(const AttnUnit&)const{}
};
template<class Sched,int THRL=8> __device__ __forceinline__ void attn_phase(char*lds,const AttnTensors&T,const Sched&S){
  AttnUnit u;
  for(int i=0;S.next(i,u);++i){ S.a_ready(u); attn_unit<THRL>(u.bh/NHEAD,u.bh%NHEAD,u.qb,T.Q,T.K,T.V,T.O,lds); S.done(u); }
}
#undef SBAR
#undef WAIT_BAR
}
#define GAS __attribute__((address_space(1)))
#define LAS __attribute__((address_space(3)))
typedef unsigned v4u __attribute__((ext_vector_type(4)));
typedef float f32x4 __attribute__((ext_vector_type(4)));
typedef short bf16x8 __attribute__((ext_vector_type(8)));
typedef GAS unsigned gu32;
typedef GAS unsigned long long gu64;
#define RLX_AGENT __ATOMIC_RELAXED, __HIP_MEMORY_SCOPE_AGENT
#define LDS_WAIT() asm volatile("s_waitcnt lgkmcnt(0)" ::: "memory")
#define VM_WAIT() asm volatile("s_waitcnt vmcnt(0)" ::: "memory")
__device__ __forceinline__ unsigned long long rt() { return __builtin_amdgcn_s_memrealtime(); }
typedef float f32x2_cv __attribute__((ext_vector_type(2))); typedef __bf16 bf16x2_cv __attribute__((ext_vector_type(2)));
__device__ __forceinline__ unsigned pk2(float lo, float hi) { const f32x2_cv v = {lo, hi}; return __builtin_bit_cast(unsigned, __builtin_convertvector(v, bf16x2_cv)); }
__device__ __forceinline__ unsigned f2bf(float f) { return pk2(f, f) & 0xffffu; }

#define XB_TMO      128
#define XB_XCNT(j)  (256  + 64 * (j))
#define XB_XSUB(j)  (1280 + 64 * (j))
#define XB_XGEN(j)  (2304 + 64 * (j))
#define XB_TOP      3328
#define XB_TOPGEN   3392
#define XCD_BAR_WORDS 3456
#define XB_SPIN_CAP (1u << 18)

__device__ __forceinline__ unsigned xb_ld(unsigned* p)              { return __hip_atomic_load(p, __ATOMIC_RELAXED, __HIP_MEMORY_SCOPE_AGENT); }
__device__ __forceinline__ unsigned xb_add(unsigned* p, unsigned v) { return __hip_atomic_fetch_add(p, v, __ATOMIC_RELAXED, __HIP_MEMORY_SCOPE_AGENT); }
__device__ __forceinline__ unsigned xb_xcc_id() { return (unsigned)__builtin_amdgcn_s_getreg((3 << 11) | 20) & 0xFu; }
#define XB_SPIN(cond, bar) do { unsigned _sp = 0; while (cond) { __builtin_amdgcn_s_sleep(1); \
    if ((++_sp & 255u) == 0u) { if (xb_ld(&(bar)[XB_TMO])) break; if (_sp > XB_SPIN_CAP) { atomicAdd(&(bar)[XB_TMO], 1u); break; } } } } while (0)

struct XcdBarrier {
    unsigned* bar; unsigned x;
    volatile LAS unsigned* st;
};

__device__ __forceinline__ XcdBarrier xcd_barrier_post(unsigned* bar, volatile LAS unsigned* st) {
    XcdBarrier b; b.bar = bar; b.x = xb_xcc_id(); b.st = st;
    if (threadIdx.x == 0) (void)xb_add(&bar[XB_XCNT(b.x)], 1u);
    return b;
}
__device__ __forceinline__ void xcd_barrier_complete(unsigned* bar, unsigned x, unsigned& nloc, unsigned& nx) {
    const unsigned G = gridDim.x * gridDim.y * gridDim.z;
    unsigned sum, cnt, mine, sp = 0u;
    for (;;) {
        sum = 0u; cnt = 0u; mine = 0u;
#pragma unroll
        for (unsigned j = 0; j < 16; ++j) { const unsigned c = xb_ld(&bar[XB_XCNT(j)]); sum += c; cnt += (c > 0u) ? 1u : 0u; mine = (j == x) ? c : mine; }
        if (sum == G) break;
        __builtin_amdgcn_s_sleep(1);
        if ((++sp & 255u) == 0u) { if (xb_ld(&bar[XB_TMO])) break; if (sp > XB_SPIN_CAP) { atomicAdd(&bar[XB_TMO], 1u); break; } }
    }
    nloc = mine > 0u ? mine : 1u; nx = cnt > 0u ? cnt : 1u;
}

__device__ __forceinline__ void xcd_barrier(const XcdBarrier& b) {
    asm volatile("s_waitcnt vmcnt(0)" ::: "memory");
    __syncthreads();
    if (threadIdx.x == 0) {
        unsigned* bar = b.bar;
        __builtin_amdgcn_s_waitcnt(0);
        unsigned nloc = b.st[0], nx = b.st[1];
        if (nloc == 0u) { xcd_barrier_complete(bar, b.x, nloc, nx); b.st[0] = nloc; b.st[1] = nx; }
        const unsigned old = xb_add(&bar[XB_XSUB(b.x)], 1u);
        const unsigned gen = old / nloc;
        if (old + 1u == (gen + 1u) * nloc) {
            __builtin_amdgcn_fence(__ATOMIC_RELEASE, "agent");
            asm volatile("s_waitcnt vmcnt(0)" ::: "memory");
            const unsigned og = xb_add(&bar[XB_TOP], 1u);
            const unsigned tg = og / nx;
            if (og + 1u == (tg + 1u) * nx) xb_add(&bar[XB_TOPGEN], 1u);
            else XB_SPIN(xb_ld(&bar[XB_TOPGEN]) == tg, bar);
            __builtin_amdgcn_fence(__ATOMIC_ACQUIRE, "agent");
            xb_add(&bar[XB_XGEN(b.x)], 1u);
            asm volatile("s_waitcnt vmcnt(0)" ::: "memory");
        } else {
            XB_SPIN(xb_ld(&bar[XB_XGEN(b.x)]) == gen, bar);
            __builtin_amdgcn_fence(__ATOMIC_ACQUIRE, "agent");
            asm volatile("s_waitcnt vmcnt(0)" ::: "memory");
        }
    }
    __syncthreads();
}
#define DEVI __device__ __forceinline__
constexpr int NWAVES = 8;
constexpr int RING_OFF = 0, RING_BYTES = 131072;
constexpr int LDSCTL_OFF = RING_BYTES, MISC_OFF = LDSCTL_OFF + 320;
constexpr int LDS_BYTES = 151552;

typedef unsigned v2u __attribute__((ext_vector_type(2)));
typedef float f32x2 __attribute__((ext_vector_type(2)));
DEVI float bf2f(unsigned v) { return __uint_as_float(v << 16); }
DEVI float wave_sum(float v) {
#pragma unroll
    for (int o = 1; o < 64; o <<= 1) v += __shfl_xor(v, o);
    return v;
}
DEVI int tok_row(int b, int t) { return t < NM ? MR + b * NM + t : b * S + (t - NM); }
DEVI float log_sigmoid(float z) { return fminf(z, 0.f) - log1pf(__expf(-fabsf(z))); }

struct Args { const float* in[24]; float* out; unsigned char* ws; int ph_lo, ph_hi; };
struct Frame {
    const __attribute__((address_space(4))) Args* ka;
    LAS unsigned char* lds;
    volatile LAS unsigned* MISC;
    gu32* ctl;
    int tid, lane, wave, vcu, G;
    unsigned char* ws;
    float* out;
};
#define WSP(T, off) ((T*)(F.ws + (off)))

DEVI f32x4 mma_nt(const LAS bf16_t* A, int lda, const LAS bf16_t* B, int ldb, int K, int lane, f32x4 acc) {
    const LAS bf16_t* ap = A + (lane & 15) * lda + 8 * (lane >> 4); const LAS bf16_t* bp = B + (lane & 15) * ldb + 8 * (lane >> 4);
    for (int k0 = 0; k0 < K; k0 += 32) {
        const bf16x8 a = *(const LAS bf16x8*)(ap + k0), b = *(const LAS bf16x8*)(bp + k0);
        acc = __builtin_amdgcn_mfma_f32_16x16x32_bf16(a, b, acc, 0, 0, 0);
    }
    return acc;
}
constexpr int TLD = 72;
DEVI void tr_item(const float* W, int ldw, int nmax, const float* gain, bf16_t* WT, int ldk, int k0, int n0, int dest_row0, LAS bf16_t* Tt, int lane, int dest_row1 = -1) {
    if (dest_row1 < 0) dest_row1 = dest_row0 + 32;
    const int nq = lane & 15, kq = lane >> 4; const bool okc = (n0 + 4 * nq) < nmax;
    f32x4 v[16];
#pragma unroll
    for (int it = 0; it < 16; ++it) v[it] = okc ? *(const GAS f32x4*)(W + (size_t)(k0 + it * 4 + kq) * ldw + n0 + 4 * nq) : (f32x4){0.f, 0.f, 0.f, 0.f};
#pragma unroll
    for (int it = 0; it < 16; ++it) { const int k = it * 4 + kq; const float gsc = gain ? gain[k0 + k] : 1.0f;
#pragma unroll
        for (int i = 0; i < 4; ++i) Tt[(4 * nq + i) * TLD + (k ^ ((nq & 7) << 3))] = (bf16_t)f2bf(v[it][i] * gsc); }
    LDS_WAIT(); asm volatile("" ::: "memory");
    const int c = lane & 7;
#pragma unroll
    for (int j = 0; j < 8; ++j) { const int n = (lane >> 3) + 8 * j;
        if (n0 + n < nmax) *(GAS v4u*)(WT + (size_t)(n < 32 ? dest_row0 + n : dest_row1 + n - 32) * ldk + k0 + 8 * c) = *(const LAS v4u*)(Tt + n * TLD + ((8 * c) ^ (((n >> 2) & 7) << 3))); }
    LDS_WAIT(); asm volatile("" ::: "memory");
}
DEVI void convert_moe(Frame& F, int layer, int lo, int hi, int gw, int NGW) {
    LAS bf16_t* scr = (LAS bf16_t*)(F.lds + RING_OFF + F.wave * 16384);
    const float* Wg = F.ka->in[21] + (size_t)layer * NEXP * D * 256; const float* Wu = F.ka->in[22] + (size_t)layer * NEXP * D * 256; const float* Wd = F.ka->in[23] + (size_t)layer * NEXP * 256 * D;
    const float* gain = F.ka->in[3] + layer * D;
    bf16_t* GU = WSP(bf16_t, layer ? WS_MOEGU1 : WS_MOEGU); bf16_t* DW = WSP(bf16_t, layer ? WS_MOED1 : WS_MOED);
    for (int it = lo + gw; it < hi; it += NGW) {
        const int kind = it >> 11, r = it & 2047, e = r >> 6, q = r & 63;
        if (kind < 2) { const int kb = q >> 2, nb = q & 3, n0 = nb * 64;
            tr_item((kind ? Wu : Wg) + (size_t)e * D * 256, 256, 256, gain, GU, D, kb * 64, n0, e * 512 + (n0 >> 7) * 256 + (n0 & 127) + kind * 128, scr, F.lane);
        } else { const int kb = q >> 4, nb = q & 15;
            tr_item(Wd + (size_t)e * 256 * D, D, D, nullptr, DW, 256, kb * 64, nb * 64, e * 1024 + nb * 64, scr, F.lane); }
    }
}
constexpr int CONV_ITEMS = 3 * 2048, CONV_PER_WG = 24;
DEVI void convert_small_item(Frame& F, int which, int r) {
    LAS bf16_t* scr = (LAS bf16_t*)(F.lds + RING_OFF + F.wave * 16384);
    if (which == 0) { tr_item(F.ka->in[12], D, D, nullptr, WSP(bf16_t, WS_WO0), D, (r / 16) * 64, (r % 16) * 64, (r % 16) * 64, scr, F.lane); }
    else if (which == 1) { const int n0 = (r % 24) * 64, tl = n0 >> 8, hd = (n0 >> 6) & 3;
        tr_item(F.ka->in[13], NA, NA, F.ka->in[2] + D, WSP(bf16_t, WS_WAI), D, (r / 24) * 64, n0, tl < 5 ? tl * 256 + hd * 32 : n0, scr, F.lane, tl < 5 ? tl * 256 + 128 + hd * 32 : n0 + 32); }
    else { tr_item(F.ka->in[16], D, D, nullptr, WSP(bf16_t, WS_WAO), D, (r / 16) * 64, (r % 16) * 64, (r % 16) * 64, scr, F.lane); }
}
DEVI void router_weights(Frame& F, int gt, int NGT) {
    bf16_t* WR = WSP(bf16_t, WS_WR);
    for (int idx = gt; idx < 2 * 48 * D; idx += NGT) { const int l = idx / (48 * D), j = (idx / D) % 48, k = idx % D;
        float w = (j < 4) ? F.ka->in[17][((size_t)l * D + k) * 4 + j] : (j < 36) ? F.ka->in[19][((size_t)l * D + k) * 32 + (j - 4)] : 0.f; w *= F.ka->in[3][l * D + k];
        const unsigned hi = f2bf(w); const unsigned lo = f2bf(w - bf2f(hi));
        WR[((size_t)(l * 2 + 0) * 48 + j) * D + k] = (bf16_t)hi; WR[((size_t)(l * 2 + 1) * 48 + j) * D + k] = (bf16_t)lo; }
}
constexpr int GLA_SHORT0 = (Bz * 4 * NCH) % 256;
constexpr int CONV_P1_END = 114 * CONV_PER_WG;
DEVI void p0_prologue(Frame& F) {
    LAS bf16_t* scr = (LAS bf16_t*)(F.lds + RING_OFF + F.wave * 16384);
    const int gw = F.vcu * NWAVES + F.wave, NGW = F.G * NWAVES;
    const int gt = F.vcu * 512 + F.tid, NGT = F.G * 512;
    for (int it = gw; it < 16 * 48; it += NGW) { const int n0 = (it % 48) * 64; int dr = n0;
        if (n0 >= 512 && n0 < 1024) { const int c = n0 - 512; dr = (2 + (c >> 7)) * 256 + (c & 127); } else if (n0 >= 1024 && n0 < 1536) { const int c = n0 - 1024; dr = (2 + (c >> 7)) * 256 + 128 + (c & 127); }
        tr_item(F.ka->in[5], 3104, 3072, F.ka->in[2], WSP(bf16_t, WS_WIN), D, (it / 48) * 64, n0, dr, scr, F.lane); }
    if (F.G != 256) { for (int it = gw; it < 256 + 384 + 256; it += NGW) convert_small_item(F, it < 256 ? 0 : it < 640 ? 1 : 2, it < 256 ? it : it < 640 ? it - 256 : it - 640);
        convert_moe(F, 0, 0, CONV_ITEMS, gw, NGW); }
    { bf16_t* WT = WSP(bf16_t, WS_WIN);
      for (int idx = gt; idx < 2 * 256 * (D / 8); idx += NGT) { const int k8 = idx & 127, n = (idx >> 7) & 255, dir = idx >> 15; const float* wg = dir ? F.ka->in[9] : F.ka->in[7]; float wj[16];
#pragma unroll
          for (int j = 0; j < 16; ++j) wj[j] = wg[j * 256 + n];
          unsigned ow[4];
#pragma unroll
          for (int i2 = 0; i2 < 4; ++i2) { float r2[2];
#pragma unroll
              for (int e2 = 0; e2 < 2; ++e2) { const int k = k8 * 8 + i2 * 2 + e2; const f32x4* wp = (const f32x4*)(F.ka->in[5] + (size_t)k * 3104 + 3072 + 16 * dir); float s = 0.f;
#pragma unroll
                  for (int j4 = 0; j4 < 4; ++j4) { const f32x4 w4 = wp[j4]; s += w4[0] * wj[j4 * 4] + w4[1] * wj[j4 * 4 + 1] + w4[2] * wj[j4 * 4 + 2] + w4[3] * wj[j4 * 4 + 3]; }
                  r2[e2] = s * F.ka->in[2][k]; }
              ow[i2] = pk2(r2[0], r2[1]); }
          *(GAS v4u*)(WT + (size_t)(W_LA + dir * 256 + n) * D + k8 * 8) = (v4u){ow[0], ow[1], ow[2], ow[3]}; } }
    if (F.G != 256) router_weights(F, gt, NGT);
    { bf16_t* HB = WSP(bf16_t, WS_HB); float* SS = WSP(float, WS_SS);
      for (int m0 = gw; m0 < MP; m0 += 2 * NGW) { f32x4 v[2][4];
#pragma unroll
          for (int u = 0; u < 2; ++u) { const int m = m0 + u * NGW;
              if (m < MA) { const float* src = (m < MR) ? F.ka->in[0] + (size_t)m * D : F.ka->in[1] + (size_t)((m - MR) & 15) * D; const GAS f32x4* xr = (const GAS f32x4*)src + F.lane;
#pragma unroll
                  for (int j = 0; j < 4; ++j) v[u][j] = xr[64 * j];
              } else {
#pragma unroll
                  for (int j = 0; j < 4; ++j) v[u][j] = (f32x4){0.f, 0.f, 0.f, 0.f}; } }
#pragma unroll
          for (int u = 0; u < 2; ++u) { const int m = m0 + u * NGW; if (m >= MP) continue;
              GAS v2u* o8 = (GAS v2u*)(HB + (size_t)m * D) + F.lane; float s = 0.f;
#pragma unroll
              for (int j = 0; j < 4; ++j) { s += (v[u][j].x * v[u][j].x + v[u][j].y * v[u][j].y) + (v[u][j].z * v[u][j].z + v[u][j].w * v[u][j].w); o8[64 * j] = (v2u){pk2(v[u][j].x, v[u][j].y), pk2(v[u][j].z, v[u][j].w)}; }
              s = wave_sum(s);
              if (F.lane == 0) { SS[m] = s; if (m >= MA) { SS[MP + m] = 0.f; SS[2 * MP + m] = 0.f; } } }
      } }
}

constexpr int GL_LA = 0;
constexpr int GL_WG = 32768;
constexpr int GL_G = 40960;
constexpr int GL_BIAS = 49152;
constexpr int GL_SEG = 49664;
constexpr int GL_CL = 51712;
constexpr int GL_OP0 = 52224;
constexpr int GL_OP1 = GL_OP0 + 18432;
constexpr int GL_VT = GL_OP1 + 18432;
constexpr int GL_P = GL_VT + 18432;
constexpr int GL_SSQ = GL_P + 9216;
static_assert(GL_SSQ + 2048 <= RING_BYTES, "GLA LDS map");
constexpr int LDP = 72;
constexpr int LAP = 65;

DEVI int gla_row(int b, int n, int t) { return n == 0 ? MR + b * NM + t : b * S + (n - 1) * 64 + t; }
DEVI void gla_load_la(const bf16_t* U, int tid, int b, int h, int n, v4u& r0, v4u& r1) {
    const int dir = tid >> 8, t = (tid >> 2) & 63, dq = tid & 3, nval = (n == 0) ? NM : 64; r0 = (v4u){0u, 0u, 0u, 0u}; r1 = r0;
    if (t < nval) { const v4u* lp = (const v4u*)(U + (size_t)gla_row(b, n, t) * NU + U_LA + dir * 256 + h * 64 + dq * 16); r0 = lp[0]; r1 = lp[1]; }
}
DEVI void gla_cum(Frame& F, int n, v4u r0, v4u r1) {
    LAS float* LA = (LAS float*)(F.lds + GL_LA);
    LAS float* SEG = (LAS float*)(F.lds + GL_SEG); LAS float* CL = (LAS float*)(F.lds + GL_CL);
    const int tid = F.tid, nval = (n == 0) ? NM : 64;
    { const int dir = tid >> 8, t = (tid >> 2) & 63, dq = tid & 3; (void)nval;
      const unsigned lw[8] = {r0.x, r0.y, r0.z, r0.w, r1.x, r1.y, r1.z, r1.w};
#pragma unroll
      for (int i = 0; i < 16; ++i) LA[(dir * 64 + t) * LAP + dq * 16 + i] = bf2f((lw[i >> 1] >> ((i & 1) * 16)) & 0xffffu); }
    __syncthreads();
    { const int dir = tid >> 8, seg = (tid >> 6) & 3, d = tid & 63; float run = 0.f; float loc[16];
#pragma unroll
      for (int i = 0; i < 16; ++i) { const int p = seg * 16 + i, t = dir ? 63 - p : p; run += LA[(dir * 64 + t) * LAP + d]; loc[i] = run; }
      SEG[(dir * 4 + seg) * 64 + d] = run;
      __syncthreads();
      float off = 0.f;
#pragma unroll
      for (int s2 = 0; s2 < 4; ++s2) if (s2 < seg) off += SEG[(dir * 4 + s2) * 64 + d];
#pragma unroll
      for (int i = 0; i < 16; ++i) { const int p = seg * 16 + i, t = dir ? 63 - p : p; LA[(dir * 64 + t) * LAP + d] = off + loc[i]; }
      if (seg == 3) CL[dir * 64 + d] = off + run; }
    __syncthreads();
}

DEVI void p2_gla_kv(Frame& F) {
    const bf16_t* U = WSP(bf16_t, WS_BIG); bf16_t* KVSB = WSP(bf16_t, WS_H); float* DEC = WSP(float, WS_DEC);
    LAS float* LA = (LAS float*)(F.lds + GL_LA); LAS float* CL = (LAS float*)(F.lds + GL_CL);
    LAS bf16_t* KE = (LAS bf16_t*)(F.lds + GL_OP0); LAS bf16_t* VT = (LAS bf16_t*)(F.lds + GL_VT);
    const int tid = F.tid, lane = F.lane, w = F.wave;
#define P2_LOAD(UNIT, LA0, LA1, KR, V0, V1) do { const int n_ = (UNIT) % NCH, h_ = ((UNIT) / NCH) & 3, b_ = (UNIT) / (NCH * 4); gla_load_la(U, tid, b_, h_, n_, LA0, LA1); \
        const int t_ = tid >> 3, dg_ = tid & 7; KR = (v4u){0u, 0u, 0u, 0u}; V0 = KR; V1 = KR; \
        if (t_ < ((n_ == 0) ? NM : 64)) { const bf16_t* up_ = U + (size_t)gla_row(b_, n_, t_) * NU; KR = *(const v4u*)(up_ + U_K + h_ * 64 + dg_ * 8); const v4u* vp_ = (const v4u*)(up_ + U_V + h_ * 128 + dg_ * 16); V0 = vp_[0]; V1 = vp_[1]; } } while (0)
    v4u la0, la1, kr, v0, v1, nla0, nla1, nkr, nv0, nv1;
    if (F.vcu < Bz * 4 * NCH) P2_LOAD(F.vcu, la0, la1, kr, v0, v1);
    for (int unit = F.vcu; unit < Bz * 4 * NCH; unit += F.G) {
        const int n = unit % NCH, h = (unit / NCH) & 3, b = unit / (NCH * 4);
        const bool has_nx = unit + F.G < Bz * 4 * NCH;
        if (has_nx) P2_LOAD(unit + F.G, nla0, nla1, nkr, nv0, nv1);
        gla_cum(F, n, la0, la1);
        { const int t = tid >> 3, dg = tid & 7;
          const unsigned kw[4] = {kr.x, kr.y, kr.z, kr.w};
#pragma unroll
          for (int dir = 0; dir < 2; ++dir)
#pragma unroll
              for (int i = 0; i < 8; ++i) { const int d = dg * 8 + i; const float kv = bf2f((kw[i >> 1] >> ((i & 1) * 16)) & 0xffffu);
                  KE[(dir * 64 + d) * LDP + (t ^ (dg << 3))] = (bf16_t)f2bf(kv * __expf(CL[dir * 64 + d] - LA[(dir * 64 + t) * LAP + d])); }
          const unsigned vw[8] = {v0.x, v0.y, v0.z, v0.w, v1.x, v1.y, v1.z, v1.w};
#pragma unroll
          for (int i = 0; i < 16; ++i) VT[(dg * 16 + i) * LDP + (t ^ (dg << 3))] = (bf16_t)((vw[i >> 1] >> ((i & 1) * 16)) & 0xffffu); }
        __syncthreads();
        { const int dir = w >> 2, dt = w & 3, q = lane >> 4; const size_t seq = (size_t)((b * 4 + h) * 2 + dir) * NCH + n;
          bf16_t* outp = KVSB + seq * 8192;
#pragma unroll 2
          for (int vt = 0; vt < 8; ++vt) { f32x4 acc = (f32x4){0.f, 0.f, 0.f, 0.f};
              { const LAS bf16_t* ap = KE + (dir * 64 + dt * 16 + (lane & 15)) * LDP; const LAS bf16_t* bp = VT + (vt * 16 + (lane & 15)) * LDP; const int sa = (dt * 2 + ((lane & 15) >> 3)) << 3, sb = vt << 3, kq = 8 * (lane >> 4);
#pragma unroll
                for (int k0 = 0; k0 < 64; k0 += 32) acc = __builtin_amdgcn_mfma_f32_16x16x32_bf16(*(const LAS bf16x8*)(ap + ((k0 + kq) ^ sa)), *(const LAS bf16x8*)(bp + ((k0 + kq) ^ sb)), acc, 0, 0, 0); }
              *(v2u*)(outp + (vt * 16 + (lane & 15)) * 64 + dt * 16 + 4 * q) = (v2u){pk2(acc[0], acc[1]), pk2(acc[2], acc[3])}; }
          if (tid < 128) { const int dd = tid >> 6, d = tid & 63; DEC[((size_t)((b * 4 + h) * 2 + dd) * NCH + n) * 64 + d] = __expf(CL[dd * 64 + d]); } }
        __syncthreads();
        if (has_nx) { la0 = nla0; la1 = nla1; kr = nkr; v0 = nv0; v1 = nv1; }
    }
#undef P2_LOAD
}

DEVI void p3_gla_scan(Frame& F) {
    bf16_t* KVSB = WSP(bf16_t, WS_H); const float* DEC = WSP(float, WS_DEC);
    for (int item = F.vcu * 512 + F.tid; item < 64 * 2048; item += F.G * 512) {
        const int seq = item >> 11, off4 = item & 2047, dir = seq & 1, d = (off4 * 4) & 63;
        bf16_t* base = KVSB + (size_t)seq * NCH * 8192 + off4 * 4; const float* db = DEC + (size_t)seq * NCH * 64 + d;
        f32x4 Sx = (f32x4){0.f, 0.f, 0.f, 0.f};
#pragma unroll 1
        for (int g3 = 0; g3 < 2; ++g3) {
            v2u kv[17]; f32x4 dc[17];
#pragma unroll
            for (int i = 0; i < 17; ++i) { const int st = g3 * 17 + i; if (st < NCH) { const int n = dir ? NCH - 1 - st : st; kv[i] = *(const v2u*)(base + (size_t)n * 8192); dc[i] = *(const f32x4*)(db + n * 64); } }
#pragma unroll
            for (int i = 0; i < 17; ++i) { const int st = g3 * 17 + i; if (st < NCH) { const int n = dir ? NCH - 1 - st : st;
                *(v2u*)(base + (size_t)n * 8192) = (v2u){pk2(Sx[0], Sx[1]), pk2(Sx[2], Sx[3])};
                const f32x4 kvf = (f32x4){bf2f(kv[i].x & 0xffffu), bf2f(kv[i].x >> 16), bf2f(kv[i].y & 0xffffu), bf2f(kv[i].y >> 16)};
                Sx = dc[i] * Sx + kvf; } }
        }
    }
}

DEVI void p4_gla_out(Frame& F) {
    const bf16_t* U = WSP(bf16_t, WS_BIG); const bf16_t* KVSB = WSP(bf16_t, WS_H); bf16_t* YM = WSP(bf16_t, WS_HB);
    LAS float* LA = (LAS float*)(F.lds + GL_LA); LAS float* SSQ = (LAS float*)(F.lds + GL_SSQ);
    LAS bf16_t* QD = (LAS bf16_t*)(F.lds + GL_OP0); LAS bf16_t* KI = (LAS bf16_t*)(F.lds + GL_OP1); LAS bf16_t* VT = (LAS bf16_t*)(F.lds + GL_VT); LAS bf16_t* Pm = (LAS bf16_t*)(F.lds + GL_P);
    const float* cw = F.ka->in[6]; const float* gnw = F.ka->in[11];
    const int tid = F.tid, lane = F.lane, w = F.wave, q = lane >> 4, fr = lane & 15;
    for (int unit = F.vcu; unit < Bz * 4 * NCH; unit += F.G) {
        const int n = unit % NCH, h = (unit / NCH) & 3, b = unit / (NCH * 4), nval = (n == 0) ? NM : 64;
        v4u la0, la1; gla_load_la(U, tid, b, h, n, la0, la1);
        v4u cab[2], cz1[2], czp[2], czn[2]; f32x4 cwt[3][4];
        { const int t = tid >> 3, cg = tid & 7, c0 = h * 128 + cg * 16;
#pragma unroll
          for (int hh = 0; hh < 2; ++hh) { cab[hh] = (v4u){0u, 0u, 0u, 0u}; cz1[hh] = cab[hh]; czp[hh] = cab[hh]; czn[hh] = cab[hh]; }
          if (t < nval) { const int tpos = (n == 0) ? t : NM + (n - 1) * 64 + t;
              const bf16_t* u1 = U + (size_t)gla_row(b, n, t) * NU + c0; const bf16_t* u0 = (tpos > 0) ? U + (size_t)tok_row(b, tpos - 1) * NU + c0 : nullptr;
              const bf16_t* u2 = (tpos < T - 1) ? U + (size_t)tok_row(b, tpos + 1) * NU + c0 : nullptr;
#pragma unroll
              for (int hh = 0; hh < 2; ++hh) { cab[hh] = *(const v4u*)(u1 + U_AB + hh * 8); cz1[hh] = *(const v4u*)(u1 + U_Z + hh * 8);
                  if (u0) czp[hh] = *(const v4u*)(u0 + U_Z + hh * 8);
                  if (u2) czn[hh] = *(const v4u*)(u2 + U_Z + hh * 8); } }
#pragma unroll
          for (int tap = 0; tap < 3; ++tap)
#pragma unroll
              for (int j4 = 0; j4 < 4; ++j4) cwt[tap][j4] = *(const f32x4*)(cw + tap * 512 + c0 + 4 * j4); }
        v4u qr = (v4u){0u, 0u, 0u, 0u}, kr = qr, v0 = qr, v1 = qr;
        { const int t = tid >> 3, dg = tid & 7;
          if (t < nval) { const bf16_t* up = U + (size_t)gla_row(b, n, t) * NU; qr = *(const v4u*)(up + U_Q + h * 64 + dg * 8); kr = *(const v4u*)(up + U_K + h * 64 + dg * 8);
              const v4u* vp = (const v4u*)(up + U_V + h * 128 + dg * 16); v0 = vp[0]; v1 = vp[1]; } }
        const size_t seqf = (size_t)((b * 4 + h) * 2 + 0) * NCH + n, seqb = (size_t)((b * 4 + h) * 2 + 1) * NCH + n;
        const bf16_t* sfp = KVSB + seqf * 8192 + (size_t)(w * 16 + fr) * 64 + 8 * q; const bf16_t* sbp = KVSB + seqb * 8192 + (size_t)(w * 16 + fr) * 64 + 8 * q;
        const bf16x8 sf0 = *(const bf16x8*)(sfp), sf1 = *(const bf16x8*)(sfp + 32), sb0 = *(const bf16x8*)(sbp), sb1 = *(const bf16x8*)(sbp + 32);
        const f32x4 gw4 = *(const f32x4*)(gnw + w * 16 + 4 * q);
        v2u rg[4];
#pragma unroll
        for (int tt = 0; tt < 4; ++tt) { const int t = tt * 16 + fr; rg[tt] = (v2u){0u, 0u}; if (t < nval) rg[tt] = *(const v2u*)(U + (size_t)gla_row(b, n, t) * NU + U_R + h * 128 + w * 16 + 4 * q); }
        gla_cum(F, n, la0, la1);
        { const int t = tid >> 3, cg = tid & 7;
          if (t < nval) { const int c0 = h * 128 + cg * 16; unsigned outw[8];
#pragma unroll
              for (int hh = 0; hh < 2; ++hh) {
                  const unsigned abw[4] = {cab[hh].x, cab[hh].y, cab[hh].z, cab[hh].w}, z1w[4] = {cz1[hh].x, cz1[hh].y, cz1[hh].z, cz1[hh].w}, zpw[4] = {czp[hh].x, czp[hh].y, czp[hh].z, czp[hh].w}, znw[4] = {czn[hh].x, czn[hh].y, czn[hh].z, czn[hh].w};
#pragma unroll
                  for (int i2 = 0; i2 < 4; ++i2) { float yv[2];
#pragma unroll
                      for (int e2 = 0; e2 < 2; ++e2) { const int ci = hh * 8 + i2 * 2 + e2; const int sh = e2 * 16;
                          yv[e2] = bf2f((abw[i2] >> sh) & 0xffffu) * (cwt[0][ci >> 2][ci & 3] * bf2f((zpw[i2] >> sh) & 0xffffu) + cwt[1][ci >> 2][ci & 3] * bf2f((z1w[i2] >> sh) & 0xffffu) + cwt[2][ci >> 2][ci & 3] * bf2f((znw[i2] >> sh) & 0xffffu)); }
                      outw[hh * 4 + i2] = pk2(yv[0], yv[1]); } }
              v4u* yp = (v4u*)(YM + (size_t)gla_row(b, n, t) * D + c0); yp[0] = (v4u){outw[0], outw[1], outw[2], outw[3]}; yp[1] = (v4u){outw[4], outw[5], outw[6], outw[7]}; } }
        { const int t = tid >> 3, dg = tid & 7;
          const unsigned qw[4] = {qr.x, qr.y, qr.z, qr.w}, kw[4] = {kr.x, kr.y, kr.z, kr.w};
#pragma unroll
          for (int dir = 0; dir < 2; ++dir) { unsigned qo[4], ko[4];
#pragma unroll
              for (int i2 = 0; i2 < 4; ++i2) { float qv[2], kv[2];
#pragma unroll
                  for (int e2 = 0; e2 < 2; ++e2) { const int d = dg * 8 + i2 * 2 + e2; const float c = LA[(dir * 64 + t) * LAP + d];
                      qv[e2] = bf2f((qw[i2] >> (e2 * 16)) & 0xffffu) * 0.125f * __expf(c); kv[e2] = bf2f((kw[i2] >> (e2 * 16)) & 0xffffu) * __expf(-c); }
                  qo[i2] = pk2(qv[0], qv[1]); ko[i2] = pk2(kv[0], kv[1]); }
              *(LAS v4u*)(QD + (dir * 64 + t) * LDP + dg * 8) = (v4u){qo[0], qo[1], qo[2], qo[3]};
              *(LAS v4u*)(KI + (dir * 64 + t) * LDP + dg * 8) = (v4u){ko[0], ko[1], ko[2], ko[3]}; }
          const unsigned vw[8] = {v0.x, v0.y, v0.z, v0.w, v1.x, v1.y, v1.z, v1.w};
#pragma unroll
          for (int i = 0; i < 16; ++i) VT[(dg * 16 + i) * LDP + (t ^ (dg << 3))] = (bf16_t)((vw[i >> 1] >> ((i & 1) * 16)) & 0xffffu); }
        __syncthreads();
#pragma unroll
        for (int x = 0; x < 2; ++x) { const int tile = w * 2 + x, st = tile >> 2, tt = tile & 3; f32x4 af = (f32x4){0.f, 0.f, 0.f, 0.f}, ab = af;
            af = mma_nt(KI + (0 * 64 + st * 16) * LDP, LDP, QD + (0 * 64 + tt * 16) * LDP, LDP, 64, lane, af);
            ab = mma_nt(KI + (1 * 64 + st * 16) * LDP, LDP, QD + (1 * 64 + tt * 16) * LDP, LDP, 64, lane, ab);
            const int t = tt * 16 + fr, s0 = st * 16 + 4 * q; float pv[4];
#pragma unroll
            for (int r = 0; r < 4; ++r) pv[r] = (s0 + r <= t) ? af[r] : ab[r];
            *(LAS v2u*)(Pm + t * LDP + s0) = (v2u){pk2(pv[0], pv[1]), pk2(pv[2], pv[3])}; }
        __syncthreads();
        f32x4 o[4];
        { const LAS bf16_t* vtp = VT + (w * 16 + fr) * LDP; const bf16x8 va0 = *(const LAS bf16x8*)(vtp + ((8 * q) ^ (w << 3))), va1 = *(const LAS bf16x8*)(vtp + ((32 + 8 * q) ^ (w << 3)));
#pragma unroll
          for (int tt = 0; tt < 4; ++tt) { f32x4 acc = (f32x4){0.f, 0.f, 0.f, 0.f};
              const LAS bf16_t* pp = Pm + (tt * 16 + fr) * LDP + 8 * q; const LAS bf16_t* qf = QD + (0 * 64 + tt * 16 + fr) * LDP + 8 * q; const LAS bf16_t* qb = QD + (1 * 64 + tt * 16 + fr) * LDP + 8 * q;
              acc = __builtin_amdgcn_mfma_f32_16x16x32_bf16(va0, *(const LAS bf16x8*)(pp), acc, 0, 0, 0);
              acc = __builtin_amdgcn_mfma_f32_16x16x32_bf16(va1, *(const LAS bf16x8*)(pp + 32), acc, 0, 0, 0);
              acc = __builtin_amdgcn_mfma_f32_16x16x32_bf16(sf0, *(const LAS bf16x8*)(qf), acc, 0, 0, 0);
              acc = __builtin_amdgcn_mfma_f32_16x16x32_bf16(sf1, *(const LAS bf16x8*)(qf + 32), acc, 0, 0, 0);
              acc = __builtin_amdgcn_mfma_f32_16x16x32_bf16(sb0, *(const LAS bf16x8*)(qb), acc, 0, 0, 0);
              acc = __builtin_amdgcn_mfma_f32_16x16x32_bf16(sb1, *(const LAS bf16x8*)(qb + 32), acc, 0, 0, 0);
              o[tt] = acc;
              float s2 = (acc[0] * acc[0] + acc[1] * acc[1]) + (acc[2] * acc[2] + acc[3] * acc[3]); s2 += __shfl_xor(s2, 16); s2 += __shfl_xor(s2, 32);
              if (q == 0) SSQ[w * 64 + tt * 16 + fr] = s2; } }
        __syncthreads();
        { const int v0i = w * 16 + 4 * q;
#pragma unroll
          for (int tt = 0; tt < 4; ++tt) { const int t = tt * 16 + fr; float tot = 0.f;
#pragma unroll
              for (int w2 = 0; w2 < 8; ++w2) tot += SSQ[w2 * 64 + t];
              if (t < nval) { const float rs = rsqrtf(tot * (1.0f / 128.0f) + EPS); const size_t row = (size_t)gla_row(b, n, t);
                  const v2u rr = rg[tt];
                  const float rv[4] = {bf2f(rr.x & 0xffffu), bf2f(rr.x >> 16), bf2f(rr.y & 0xffffu), bf2f(rr.y >> 16)}; float y[4];
#pragma unroll
                  for (int r = 0; r < 4; ++r) y[r] = o[tt][r] * rs * gw4[r] * (rv[r] * __builtin_amdgcn_rcpf(1.0f + __expf(-rv[r])));
                  *(v2u*)(YM + row * D + 512 + h * 128 + v0i) = (v2u){pk2(y[0], y[1]), pk2(y[2], y[3])}; } } }
        __syncthreads();
    }
}

DEVI void p5_meta_rows(Frame& F) {
    const bf16_t* YM = WSP(bf16_t, WS_HB) + (size_t)MR * D; const bf16_t* WT = WSP(bf16_t, WS_WO0); bf16_t* HR = WSP(bf16_t, WS_H) + (size_t)MR * D; const float* meta = F.ka->in[1];
    const int lane = F.lane, fr = lane & 15, q = lane >> 4;
    LAS f32x4* part = (LAS f32x4*)(F.lds + RING_OFF);
    for (int t0 = F.vcu * 2; t0 < 512; t0 += F.G * 2) {
        const int task = t0 + (F.wave >> 2), kq = F.wave & 3, ct = task >> 3, rt = task & 7;
        const bf16_t* wp = WT + (size_t)(ct * 16 + fr) * D + kq * 256 + 8 * q; const bf16_t* ap = YM + (size_t)(rt * 16 + fr) * D + kq * 256 + 8 * q;
        bf16x8 wf[8], af[8];
#pragma unroll
        for (int i = 0; i < 8; ++i) { wf[i] = *(const bf16x8*)(wp + i * 32); af[i] = *(const bf16x8*)(ap + i * 32); }
        f32x4 acc = (f32x4){0.f, 0.f, 0.f, 0.f};
#pragma unroll
        for (int i = 0; i < 8; ++i) acc = __builtin_amdgcn_mfma_f32_16x16x32_bf16(wf[i], af[i], acc, 0, 0, 0);
        part[F.wave * 64 + lane] = acc;
        __syncthreads();
        if (kq == 0) { const int wb = F.wave * 64 + lane; acc = (part[wb] + part[wb + 64]) + (part[wb + 128] + part[wb + 192]);
            const int row = rt * 16 + fr, col = ct * 16 + 4 * q;
            const f32x4 hv = *(const f32x4*)(meta + (size_t)(row & 15) * D + col) + acc;
            *(v2u*)(HR + (size_t)row * D + col) = (v2u){pk2(hv[0], hv[1]), pk2(hv[2], hv[3])}; }
        __syncthreads();
    }
}
constexpr int RT_WLD = 136;
constexpr int RT_WBUF = 96 * RT_WLD * 2;
constexpr int RT_LG = 2 * RT_WBUF;
DEVI void route_phase(Frame& F, int layer, int nrows, bool dry) {
    const bf16_t* HR = WSP(bf16_t, WS_H);
    const bf16_t* WRb = WSP(bf16_t, WS_WR) + (size_t)(layer * 2) * 48 * D;
    const float* bg = F.ka->in[18] + layer * 4; const float* be = F.ka->in[20] + layer * 32;
    unsigned* CNT = (unsigned*)F.ctl + (layer ? CW_CNT1 : CW_CNT0); int* LIST = WSP(int, WS_LIST); unsigned* RI = WSP(unsigned, WS_RI); float* RSTD = WSP(float, WS_SS) + 2 * MP; float* RSL = WSP(float, WS_RSL);
    LAS float* LG = (LAS float*)(F.lds + RT_LG + F.wave * 4096); LAS float* RS = LG + 16 * 48;
    const int lane = F.lane, fr = lane & 15, q = lane >> 4, tid = F.tid;
    for (int gbase = 0; gbase < nrows / 16; gbase += NWAVES * F.G) {
    const int grp = gbase + F.vcu + F.wave * F.G; const bool act = grp < nrows / 16;
    const int r0 = act ? grp * 16 : 0; const bf16_t* hp = HR + (size_t)(r0 + fr) * D + 8 * q;
    v4u wreg[3];
#define RT_LOADW(c) do { _Pragma("unroll") for (int i = 0; i < 3; ++i) { const int p = tid + 512 * i; wreg[i] = *(const GAS v4u*)(WRb + (size_t)(p >> 4) * D + (c) * 128 + (p & 15) * 8); } } while (0)
#define RT_STOREW(b) do { _Pragma("unroll") for (int i = 0; i < 3; ++i) { const int p = tid + 512 * i; *(LAS v4u*)(F.lds + (b) * RT_WBUF + ((p >> 4) * RT_WLD + (p & 15) * 8) * 2) = wreg[i]; } } while (0)
    f32x4 acc[3]; acc[0] = (f32x4){0.f, 0.f, 0.f, 0.f}; acc[1] = acc[0]; acc[2] = acc[0]; float ss = 0.f;
    v4u xc[4], xn[4];
    RT_LOADW(0);
    if (act) {
#pragma unroll
        for (int i = 0; i < 4; ++i) xc[i] = *(const GAS v4u*)(hp + i * 32); }
    RT_STOREW(0);
    __syncthreads();
#pragma unroll 1
    for (int c = 0; c < 8; ++c) {
        if (c + 1 < 8) { RT_LOADW(c + 1);
            if (act) {
#pragma unroll
                for (int i = 0; i < 4; ++i) xn[i] = *(const GAS v4u*)(hp + (c + 1) * 128 + i * 32); } }
        if (act) { const LAS bf16_t* wb = (const LAS bf16_t*)(F.lds + (c & 1) * RT_WBUF);
#pragma unroll
            for (int kk = 0; kk < 4; ++kk) {
                const v4u hw = xc[kk]; const unsigned hx[4] = {hw.x, hw.y, hw.z, hw.w};
#pragma unroll
                for (int j = 0; j < 4; ++j) { const float lo_ = __uint_as_float(hx[j] << 16), hi_ = __uint_as_float(hx[j] & 0xffff0000u); ss += lo_ * lo_ + hi_ * hi_; }
                const bf16x8 ah = __builtin_bit_cast(bf16x8, hw);
#pragma unroll
                for (int ct = 0; ct < 3; ++ct) { const bf16x8 bh = *(const LAS bf16x8*)(wb + (ct * 16 + fr) * RT_WLD + kk * 32 + 8 * q), bl = *(const LAS bf16x8*)(wb + (48 + ct * 16 + fr) * RT_WLD + kk * 32 + 8 * q);
                    acc[ct] = __builtin_amdgcn_mfma_f32_16x16x32_bf16(ah, bh, acc[ct], 0, 0, 0);
                    acc[ct] = __builtin_amdgcn_mfma_f32_16x16x32_bf16(ah, bl, acc[ct], 0, 0, 0); }
            } }
        if (c + 1 < 8) { RT_STOREW((c + 1) & 1);
#pragma unroll
            for (int i = 0; i < 4; ++i) xc[i] = xn[i]; }
        __syncthreads();
    }
#undef RT_LOADW
#undef RT_STOREW
    if (act) {
        ss += __shfl_xor(ss, 16); ss += __shfl_xor(ss, 32);
        if (q == 0) RS[fr] = pg8::rs_of(ss);
#pragma unroll
        for (int ct = 0; ct < 3; ++ct)
#pragma unroll
            for (int r = 0; r < 4; ++r) LG[(4 * q + r) * 48 + ct * 16 + fr] = acc[ct][r];
        LDS_WAIT(); asm volatile("" ::: "memory");
        if (lane < 16) {
            const int row = r0 + lane; const float rs = RS[lane]; float lg[4], le[32];
#pragma unroll
            for (int j = 0; j < 4; ++j) lg[j] = LG[lane * 48 + j] * rs + bg[j];
#pragma unroll
            for (int j = 0; j < 32; ++j) le[j] = LG[lane * 48 + 4 + j] * rs + be[j];
            int gi = 0; float gm = lg[0];
#pragma unroll
            for (int j = 1; j < 4; ++j) if (lg[j] > gm) { gm = lg[j]; gi = j; }
            float gs = 0.f;
#pragma unroll
            for (int j = 0; j < 4; ++j) gs += __expf(lg[j] - gm);
            const float gp = 1.0f / gs; float es[8];
#pragma unroll
            for (int j = 0; j < 8; ++j) es[j] = gi == 0 ? le[j] : gi == 1 ? le[8 + j] : gi == 2 ? le[16 + j] : le[24 + j];
            int i0 = 0; float v0 = es[0];
#pragma unroll
            for (int j = 1; j < 8; ++j) if (es[j] > v0) { v0 = es[j]; i0 = j; }
            int i1 = 0; float v1 = -INFINITY;
#pragma unroll
            for (int j = 0; j < 8; ++j) if (j != i0 && es[j] > v1) { v1 = es[j]; i1 = j; }
            const float e1 = __expf(v1 - v0), w0 = gp / (1.0f + e1), w1 = gp * e1 / (1.0f + e1);
            const int ex0 = gi * 8 + i0, ex1 = gi * 8 + i1;
            if (dry) { if (w0 + w1 < -1.f) RSTD[row] = w0; } else {
            const unsigned s0 = atomicAdd(CNT + ex0, 1u), s1 = atomicAdd(CNT + ex1, 1u);
            LIST[(size_t)ex0 * MA + s0] = row; LIST[(size_t)ex1 * MA + s1] = row; RSL[(size_t)ex0 * MA + s0] = rs; RSL[(size_t)ex1 * MA + s1] = rs;
            v4u ri; ri.x = (unsigned)ex0; ri.y = (unsigned)ex1; ri.z = s0; ri.w = s1; *(v4u*)(RI + (size_t)row * 8) = ri;
            *(f32x2*)(RI + (size_t)row * 8 + 4) = (f32x2){w0, w1}; RSTD[row] = rs; }
        }
    }
    __syncthreads();
    }
}

constexpr int MOE_TB = RING_BYTES + 512;
DEVI void moe_table(Frame& F, int layer) {
    LAS unsigned* TB = (LAS unsigned*)(F.lds + MOE_TB);
    __syncthreads();
    if (F.wave == 0) { const gu32* CNT = F.ctl + (layer ? CW_CNT1 : CW_CNT0);
        const unsigned c = F.lane < NEXP ? __hip_atomic_load(CNT + F.lane, __ATOMIC_RELAXED, __HIP_MEMORY_SCOPE_AGENT) : 0u; unsigned inc = (c + 255u) >> 8;
#pragma unroll
        for (int o = 1; o < 32; o <<= 1) { const unsigned up = __shfl_up(inc, o); if ((F.lane & 31) >= o) inc += up; }
        if (F.lane < NEXP) { TB[F.lane] = inc - ((c + 255u) >> 8); TB[40 + F.lane] = c; if (F.lane == NEXP - 1) TB[32] = inc; } }
    __syncthreads();
}
template <int NPN, bool GATH> struct MoeOrder {
    static constexpr bool GATHER = GATH;
    LAS unsigned* TB; const int* LIST; int G, c, rep; LAS unsigned char* van; int off = 0, lim = 1 << 30;
    __device__ __forceinline__ bool next(int i, pg8::Unit& u) const {
        int L = i * G + c + off; const int ntile = (int)TB[32];
        if (L >= ntile * NPN * rep || L >= lim) return false; L %= ntile * NPN;
        const int tile = L / NPN, pnl = L % NPN; int e = 0;
#pragma unroll
        for (int st = 16; st >= 1; st >>= 1) if ((int)TB[e + st] <= tile) e += st;
        u.pm = tile; u.pn = e * NPN + pnl; u.e = e; u.mt = tile - (int)TB[e]; return true;
    }
    __device__ __forceinline__ unsigned arow(const pg8::Unit& u, int r) const { const int cnt = (int)TB[40 + u.e]; int idx = u.mt * 256 + r; idx = idx < cnt ? idx : cnt - 1; return (unsigned)LIST[(size_t)u.e * MA + idx]; }
    __device__ __forceinline__ void a_ready(const pg8::Unit&) const {}
    __device__ __forceinline__ void done(const pg8::Unit&) const {}
};
struct EpiGateUp {
    static constexpr bool PERM = true;
    bf16_t* HH; const float* RSTD; LAS unsigned* TB; const int* LIST;
    __device__ __forceinline__ void operator()(const pg8::f32x4 (&acc)[2][2][4][2], const pg8::Unit& u, int wr, int wc, int fr, int fq) const {
        const int col0 = (u.pn & 1) * 128 + wc * 32 + 8 * fq; const int cnt = (int)TB[40 + u.e];
#pragma unroll
        for (int ai = 0; ai < 2; ++ai)
#pragma unroll
            for (int m = 0; m < 4; ++m) { const int rl = ai * 128 + wr * 64 + m * 16 + fr, idx = u.mt * 256 + rl;
                const float rs = RSTD[(size_t)u.e * MA + (idx < cnt ? idx : cnt - 1)]; float hv[8];
#pragma unroll
                for (int n = 0; n < 2; ++n)
#pragma unroll
                    for (int i = 0; i < 4; ++i) { const float gg = acc[ai][0][m][n][i] * rs, uu = acc[ai][1][m][n][i] * rs; hv[n * 4 + i] = gg * __builtin_amdgcn_rcpf(1.0f + __expf(-gg)) * uu; }
                pg8::u32x4 wv; wv.x = pg8::cvt_pk_bf16(hv[0], hv[1]); wv.y = pg8::cvt_pk_bf16(hv[2], hv[3]); wv.z = pg8::cvt_pk_bf16(hv[4], hv[5]); wv.w = pg8::cvt_pk_bf16(hv[6], hv[7]);
                if (idx < cnt) *(pg8::u32x4*)(HH + (size_t)(u.pm * 256 + rl) * 256 + col0) = wv; asm volatile("" ::: "memory"); }
    }
};

template <int MODE> DEVI void combine_phase(Frame& F, int nrows, bool dry = false) {
    LAS unsigned* TB = (LAS unsigned*)(F.lds + MOE_TB);
    bf16_t* HR = WSP(bf16_t, WS_H); const bf16_t* Y = WSP(bf16_t, WS_Y); const unsigned* RI = WSP(unsigned, WS_RI); float* SS1 = WSP(float, WS_SS) + MP;
    const float* gf = F.ka->in[4];
    const int gw = F.vcu * NWAVES + F.wave, NGW = F.G * NWAVES;
    v4u rin[2]; f32x2 wvn[2];
#pragma unroll
    for (int u = 0; u < 2; ++u) { const int m = gw + u * NGW, mm = m < nrows ? m : 0; rin[u] = *(const v4u*)(RI + (size_t)mm * 8); wvn[u] = *(const f32x2*)(RI + (size_t)mm * 8 + 4); }
    for (int m0 = gw; m0 < nrows; m0 += 2 * NGW) {
        v2u hv[2][4], ya[2][4], yb[2][4]; f32x2 wv[2]; bool ok[2]; v4u ric[2];
#pragma unroll
        for (int u = 0; u < 2; ++u) { ric[u] = rin[u]; wv[u] = wvn[u]; }
#pragma unroll
        for (int u = 0; u < 2; ++u) { const int m = m0 + 2 * NGW + u * NGW, mm = m < nrows ? m : 0; rin[u] = *(const v4u*)(RI + (size_t)mm * 8); wvn[u] = *(const f32x2*)(RI + (size_t)mm * 8 + 4); }
#pragma unroll
        for (int u = 0; u < 2; ++u) { const int m = m0 + u * NGW; ok[u] = m < nrows; const int mm = ok[u] ? m : m0;
            const v4u ri = ric[u];
            const size_t p0 = (size_t)TB[ri.x] * 256 + ri.z, p1 = (size_t)TB[ri.y] * 256 + ri.w;
            const GAS v2u* hr = (const GAS v2u*)(HR + (size_t)mm * D) + F.lane; const GAS v2u* y0 = (const GAS v2u*)(Y + p0 * D) + F.lane; const GAS v2u* y1 = (const GAS v2u*)(Y + p1 * D) + F.lane;
#pragma unroll
            for (int j = 0; j < 4; ++j) { hv[u][j] = hr[64 * j]; ya[u][j] = y0[64 * j]; yb[u][j] = y1[64 * j]; } }
#pragma unroll
        for (int u = 0; u < 2; ++u) { const int m = m0 + u * NGW; if (!ok[u]) continue;
            f32x4 v[4]; v2u hb[4]; float s = 0.f;
#pragma unroll
            for (int j = 0; j < 4; ++j) { const v2u h2 = hv[u][j], a = ya[u][j], b = yb[u][j]; const float w0 = wv[u].x, w1 = wv[u].y;
                v[j].x = bf2f(h2.x & 0xffffu) + w0 * bf2f(a.x & 0xffffu) + w1 * bf2f(b.x & 0xffffu); v[j].y = bf2f(h2.x >> 16) + w0 * bf2f(a.x >> 16) + w1 * bf2f(b.x >> 16);
                v[j].z = bf2f(h2.y & 0xffffu) + w0 * bf2f(a.y & 0xffffu) + w1 * bf2f(b.y & 0xffffu); v[j].w = bf2f(h2.y >> 16) + w0 * bf2f(a.y >> 16) + w1 * bf2f(b.y >> 16);
                if (MODE == 0) { hb[j] = (v2u){pk2(v[j].x, v[j].y), pk2(v[j].z, v[j].w)};
                    v[j] = (f32x4){bf2f(hb[j].x & 0xffffu), bf2f(hb[j].x >> 16), bf2f(hb[j].y & 0xffffu), bf2f(hb[j].y >> 16)}; }
                s += (v[j].x * v[j].x + v[j].y * v[j].y) + (v[j].z * v[j].z + v[j].w * v[j].w); }
            s = wave_sum(s);
            if (MODE == 0) { if (dry) { if (s < -1.f) SS1[m] = s; continue; }
                GAS v2u* hr = (GAS v2u*)(HR + (size_t)m * D) + F.lane;
#pragma unroll
                for (int j = 0; j < 4; ++j) hr[64 * j] = hb[j];
                if (F.lane == 0) SS1[m] = s;
            } else { const float rs = pg8::rs_of(s); GAS f32x4* op = (GAS f32x4*)(F.out + (size_t)m * D) + F.lane; const GAS f32x4* gp = (const GAS f32x4*)gf + F.lane;
#pragma unroll
                for (int j = 0; j < 4; ++j) { const f32x4 g4 = gp[64 * j]; op[64 * j] = (f32x4){v[j].x * rs * g4.x, v[j].y * rs * g4.y, v[j].z * rs * g4.z, v[j].w * rs * g4.w}; } }
        }
    }
}

constexpr float ATT_C2 = 0.125f * 1.4426950408889634f;
DEVI void qkprep_phase(Frame& F) {
    bf16_t* U2 = WSP(bf16_t, WS_U2); const float* ROPE = WSP(float, WS_ROPE); const float* qn = F.ka->in[14]; const float* kn = F.ka->in[15];
    const int gw = F.vcu * NWAVES + F.wave, NGW = F.G * NWAVES, sub = F.lane >> 3, l8 = F.lane & 7;
    for (int it0 = gw * 8; it0 < MA * 20; it0 += NGW * 8) {
        const int it = it0 + sub, row = it / 20, head = it % 20;
        bf16_t* p = U2 + (size_t)row * NA + head * 64 + l8 * 8;
        const v4u raw = *(const v4u*)p; const unsigned rw[4] = {raw.x, raw.y, raw.z, raw.w}; float x[8]; float ss = 0.f;
#pragma unroll
        for (int i = 0; i < 8; ++i) { x[i] = bf2f((rw[i >> 1] >> ((i & 1) * 16)) & 0xffffu); ss += x[i] * x[i]; }
        ss += __shfl_xor(ss, 1); ss += __shfl_xor(ss, 2); ss += __shfl_xor(ss, 4);
        const float rs = rsqrtf(ss * (1.0f / 64.0f) + EPS) * (head < 16 ? ATT_C2 : 1.0f); const float* nw = (head < 16 ? qn : kn) + l8 * 8;
        unsigned ow[4];
#pragma unroll
        for (int i2 = 0; i2 < 4; ++i2) { const float a0 = x[2 * i2] * rs * nw[2 * i2], a1 = x[2 * i2 + 1] * rs * nw[2 * i2 + 1]; float cs = 1.f, sn = 0.f;
            if (row < MR) { const f32x2 cv = *(const f32x2*)(ROPE + ((size_t)(row & (S - 1)) * 32 + l8 * 4 + i2) * 2); cs = cv.x; sn = cv.y; }
            ow[i2] = pk2(a0 * cs - a1 * sn, a0 * sn + a1 * cs); }
        *(v4u*)p = (v4u){ow[0], ow[1], ow[2], ow[3]};
    }
}
constexpr int NPHASE = 19;
__global__ void __launch_bounds__(NWAVES * 64, 2) mega(Args args) {
    extern __shared__ __attribute__((aligned(16))) unsigned char lds[];
    Frame F;
    F.lds = (LAS unsigned char*)lds;
    F.MISC = (volatile LAS unsigned*)(F.lds + MISC_OFF);
    F.tid = threadIdx.x; F.lane = F.tid & 63; F.wave = __builtin_amdgcn_readfirstlane(F.tid >> 6);
    F.G = gridDim.x; { const int bx = blockIdx.x; F.vcu = (F.G % 8 == 0) ? (bx % 8) * (F.G / 8) + bx / 8 : bx; }
    F.ws = args.ws; F.ctl = (gu32*)(args.ws + WS_CTL); F.out = args.out;
    F.ka = (const __attribute__((address_space(4))) Args*)__builtin_amdgcn_kernarg_segment_ptr();
    for (int u = F.tid; u < (LDS_BYTES - LDSCTL_OFF) / 4; u += NWAVES * 64) ((LAS unsigned*)(F.lds + LDSCTL_OFF))[u] = 0u;
    __syncthreads();
    const int lo = args.ph_lo, hi = args.ph_hi;
    const bool multi = (hi - lo) > 1;
    XcdBarrier bar; bar.bar = (unsigned*)(F.ctl + CW_BAR); bar.x = 0; bar.st = nullptr;
    if (multi) bar = xcd_barrier_post((unsigned*)(F.ctl + CW_BAR), F.MISC + 8);
#ifndef PHASE_MASK
#define PHASE_MASK 0x7ffff
#endif
#define IN(k) (((PHASE_MASK >> (k)) & 1) && lo <= (k) && (k) < hi)
#ifndef DOUBLE_PHASE
#define DOUBLE_PHASE -1
#endif
#define RF(k) ((k) == DOUBLE_PHASE ? 2 : 1)
#define SEAM(k) do { if (IN(k) && IN((k) + 1)) xcd_barrier(bar); } while (0)
#define REP(k) for (int rep_ = 0; rep_ < RF(k); ++rep_, ((k) == DOUBLE_PHASE && rep_ == 1 ? xcd_barrier(bar) : (void)0))
    LAS unsigned char* ring = F.lds + RING_OFF;
    LAS unsigned* TB = (LAS unsigned*)(F.lds + MOE_TB);
    int tb_layer = -1;
#define MOE_TABLE(L) do { if (tb_layer != (L)) { moe_table(F, (L)); tb_layer = (L); } } while (0)
    bf16_t* HB = WSP(bf16_t, WS_HB); bf16_t* HR = WSP(bf16_t, WS_H); float* SS = WSP(float, WS_SS);

    if (IN(0)) REP(0) { p0_prologue(F); } SEAM(0);
    if (IN(1)) {
        pg8::Gemm g{HB, WSP(bf16_t, WS_WIN), MP, NG1, D}; pg8::StaticOrder So; So.init(MP, NG1, F.G, (int)blockIdx.x, RF(1));
        pg8::EpiInProj0 E{WSP(bf16_t, WS_BIG), SS, F.ka->in[8], F.ka->in[10]};
#ifdef PROBE_SPLIT1
        So.lim = 512; pg8::gemm_phase<pg8::EpiInProj0, pg8::StaticOrder, true>(ring, g, So, E); So.off = 512; So.lim = 1 << 30;
#endif
        pg8::gemm_phase<pg8::EpiInProj0, pg8::StaticOrder, true>(ring, g, So, E);
        { const int rem = So.nwg % 256; if (F.G == 256 && rem && (int)blockIdx.x >= rem) { const int j = (int)blockIdx.x - rem; convert_moe(F, 0, j * CONV_PER_WG, (j + 1) * CONV_PER_WG, F.wave, NWAVES); } } } SEAM(1);
#ifdef PROBE_BAR
    for (int i_ = 0; i_ < 10; ++i_) xcd_barrier(bar);
#endif
    if (IN(2)) REP(2) { p2_gla_kv(F);
        if (F.G == 256 && F.vcu >= GLA_SHORT0) { const int j = F.vcu - GLA_SHORT0; convert_moe(F, 0, CONV_P1_END + j * NWAVES, CONV_P1_END + (j + 1) * NWAVES, F.wave, NWAVES);
            router_weights(F, j * 512 + F.tid, (256 - GLA_SHORT0) * 512); } } SEAM(2);
    if (IN(3)) REP(3) { p3_gla_scan(F); } SEAM(3);
    if (IN(4)) REP(4) { p4_gla_out(F);
        if (F.G == 256 && F.vcu >= GLA_SHORT0) { const int j = F.vcu - GLA_SHORT0, lo_ = CONV_P1_END + (256 - GLA_SHORT0) * NWAVES + j * NWAVES;
            convert_moe(F, 0, lo_ < CONV_ITEMS ? lo_ : CONV_ITEMS, lo_ + NWAVES < CONV_ITEMS ? lo_ + NWAVES : CONV_ITEMS, F.wave, NWAVES);
            if (j < 32) convert_small_item(F, 0, j * NWAVES + F.wave); } } SEAM(4);
    if (IN(5)) {
        pg8::Gemm g{HB, WSP(bf16_t, WS_WO0), MR, D, D}; pg8::StaticOrder So; So.init(MR, D, F.G, (int)blockIdx.x, RF(5));
        pg8::EpiResBf16<false> E{F.ka->in[0], F.ka->in[1], 15, HR, nullptr};
        p5_meta_rows(F);
        pg8::gemm_phase<pg8::EpiResBf16<false>, pg8::StaticOrder, false>(ring, g, So, E); } SEAM(5);
#define MOE_PHASES(layer, pb) do { \
        if (IN(pb)) REP(pb) { route_phase(F, layer, layer ? MR : MA, rep_ > 0); } SEAM(pb); \
        if (IN((pb) + 1)) { MOE_TABLE(layer); \
            pg8::Gemm g{HR, WSP(bf16_t, layer ? WS_MOEGU1 : WS_MOEGU), MP, NEXP * 512, D}; MoeOrder<2, true> So{TB, WSP(int, WS_LIST), F.G, F.vcu, RF((pb) + 1), F.lds + RING_BYTES + 2048}; \
            EpiGateUp E{WSP(bf16_t, WS_HH), WSP(float, WS_RSL), TB, WSP(int, WS_LIST)}; \
            pg8::gemm_phase<EpiGateUp, MoeOrder<2, true>, true>(ring, g, So, E); \
            if (layer == 0 && F.G == 256) { const int nu_ = (int)TB[32] * 2, rem = nu_ - 256;        \
                if (rem > 0 && rem < 256 && F.vcu >= rem) { const int j = F.vcu - rem; convert_moe(F, 1, j * CONV_PER_WG, (j + 1) * CONV_PER_WG < CONV_ITEMS ? (j + 1) * CONV_PER_WG : CONV_ITEMS, F.wave, NWAVES); } } } SEAM((pb) + 1); \
        if (IN((pb) + 2)) { MOE_TABLE(layer); \
            pg8::Gemm g{WSP(bf16_t, WS_HH), WSP(bf16_t, layer ? WS_MOED1 : WS_MOED), YROWS, NEXP * 1024, 256}; MoeOrder<4, false> So{TB, WSP(int, WS_LIST), F.G, F.vcu, RF((pb) + 2), F.lds + RING_BYTES + 2048}; \
            pg8::EpiScaleBf16 E{WSP(bf16_t, WS_Y), D, nullptr, 4, nullptr, nullptr, 0, TB + 40}; \
            pg8::gemm_phase<pg8::EpiScaleBf16, MoeOrder<4, false>, true>(ring, g, So, E); \
            if (layer == 0 && F.G == 256) { const int nu_ = (int)TB[32] * 4, rem = nu_ % 256, nsh = rem ? 256 - rem : 256;        \
                const int j = rem ? F.vcu - rem : F.vcu; if (j >= 0) for (int it = j * NWAVES + F.wave; it < 640; it += nsh * NWAVES) convert_small_item(F, it < 384 ? 1 : 2, it < 384 ? it : it - 384); } } SEAM((pb) + 2); } while (0)
    MOE_PHASES(0, 6);
    if (IN(9)) REP(9) { MOE_TABLE(0); combine_phase<0>(F, MA, rep_ > 0);
        { const int nu_ = (int)TB[32] * 2, rem = nu_ - 256; const int taken = (F.G == 256 && rem > 0 && rem < 256) ? (256 - rem) * CONV_PER_WG : 0;
          convert_moe(F, 1, taken < CONV_ITEMS ? taken : CONV_ITEMS, CONV_ITEMS, F.vcu * NWAVES + F.wave, F.G * NWAVES); } } SEAM(9);
    if (IN(10)) {
        { LAS float* rt = (LAS float*)(F.lds + RING_BYTES + 2048);
          for (int e = F.tid; e < 1024; e += NWAVES * 64) { const float ang = (float)(e >> 4) * powf(10000.0f, -(float)(2 * (e & 15)) / 32.0f); rt[2 * e] = cosf(ang); rt[2 * e + 1] = sinf(ang); }
          __syncthreads(); }
        pg8::Gemm g{HR, WSP(bf16_t, WS_WAI), MP, NA, D}; pg8::StaticOrder So; So.init(MP, NA, F.G, (int)blockIdx.x, RF(10));
        pg8::EpiQKV E{WSP(bf16_t, WS_U2), SS + MP, F.ka->in[14], F.ka->in[15], (const LAS float*)(F.lds + RING_BYTES + 2048), ATT_C2};
        pg8::gemm_phase<pg8::EpiQKV, pg8::StaticOrder, true>(ring, g, So, E); } SEAM(10);
    if (IN(12)) {
        const attn_body::AttnTensors AT{(const attn_body::bf16*)WSP(bf16_t, WS_U2), (const attn_body::bf16*)WSP(bf16_t, WS_U2), (const attn_body::bf16*)WSP(bf16_t, WS_U2), (attn_body::bf16*)WSP(bf16_t, WS_AO)};
        const attn_body::StaticOrder Sa(F.vcu, RF(12), F.G);
        attn_body::attn_phase<attn_body::StaticOrder>((char*)lds + RING_OFF, AT, Sa);
        } SEAM(12);
    if (IN(13)) {
        pg8::Gemm g{WSP(bf16_t, WS_AO), WSP(bf16_t, WS_WAO), MR, D, D}; pg8::StaticOrder So; So.init(MR, D, F.G, (int)blockIdx.x, 1);
        pg8::EpiResBf16<true> E{nullptr, nullptr, 0, HR, HR};
        pg8::gemm_phase<pg8::EpiResBf16<true>, pg8::StaticOrder, false>(ring, g, So, E); } SEAM(13);
#undef MOE_PHASES
    if (IN(14)) REP(14) { route_phase(F, 1, MR, rep_ > 0); } SEAM(14);
    if (IN(15)) { MOE_TABLE(1);
        pg8::Gemm g{HR, WSP(bf16_t, WS_MOEGU1), MP, NEXP * 512, D}; MoeOrder<2, true> So{TB, WSP(int, WS_LIST), F.G, F.vcu, 1, F.lds + RING_BYTES + 2048, 0, 256};
        EpiGateUp E{WSP(bf16_t, WS_HH), WSP(float, WS_RSL), TB, WSP(int, WS_LIST)};
        pg8::gemm_phase<EpiGateUp, MoeOrder<2, true>, true>(ring, g, So, E); } SEAM(15);
    if (IN(16)) { MOE_TABLE(1);
        const int nGU = (int)TB[32] * 2, nD = (int)TB[32] * 4, remGU = nGU > 256 ? nGU - 256 : 0;
        if (F.vcu < remGU) {
            pg8::Gemm g{HR, WSP(bf16_t, WS_MOEGU1), MP, NEXP * 512, D}; MoeOrder<2, true> So{TB, WSP(int, WS_LIST), F.G, F.vcu, 1, F.lds + RING_BYTES + 2048, 256, 1 << 30};
            EpiGateUp E{WSP(bf16_t, WS_HH), WSP(float, WS_RSL), TB, WSP(int, WS_LIST)};
            pg8::gemm_phase<EpiGateUp, MoeOrder<2, true>, true>(ring, g, So, E);
        } else { const int j = F.vcu - remGU; const int cap = nD < 512 ? nD : 512;
            pg8::Gemm g{WSP(bf16_t, WS_HH), WSP(bf16_t, WS_MOED1), YROWS, NEXP * 1024, 256}; MoeOrder<4, false> So{TB, WSP(int, WS_LIST), 1, 2 * j, 1, F.lds + RING_BYTES + 2048, 0, (2 * j + 2) < cap ? (2 * j + 2) : cap};
            pg8::EpiScaleBf16 E{WSP(bf16_t, WS_Y), D, nullptr, 4, nullptr, nullptr, 0, TB + 40};
            pg8::gemm_phase<pg8::EpiScaleBf16, MoeOrder<4, false>, true>(ring, g, So, E); } } SEAM(16);
    if (IN(17)) { MOE_TABLE(1);
        const int nGU = (int)TB[32] * 2, nD = (int)TB[32] * 4, remGU = nGU > 256 ? nGU - 256 : 0; int nDB = 2 * (256 - remGU); { const int cap = nD < 512 ? nD : 512; if (nDB > cap) nDB = cap; }
        if (F.G != 256) nDB = 0;
        pg8::Gemm g{WSP(bf16_t, WS_HH), WSP(bf16_t, WS_MOED1), YROWS, NEXP * 1024, 256}; MoeOrder<4, false> So{TB, WSP(int, WS_LIST), F.G, F.vcu, 1, F.lds + RING_BYTES + 2048, nDB, 1 << 30};
        pg8::EpiScaleBf16 E{WSP(bf16_t, WS_Y), D, nullptr, 4, nullptr, nullptr, 0, TB + 40};
        pg8::gemm_phase<pg8::EpiScaleBf16, MoeOrder<4, false>, true>(ring, g, So, E); } SEAM(17);
    if (IN(18)) REP(18) { MOE_TABLE(1); combine_phase<1>(F, MR); }
#undef IN
#undef SEAM
}
#if SELFCHECK
struct CK { const float* in[24]; unsigned char* ws; float* out; };
#define CWS(T, off) ((T*)(c.ws + (off)))
__device__ __forceinline__ unsigned hsh(unsigned x) { x ^= x >> 16; x *= 0x7feb352du; x ^= x >> 15; x *= 0x846ca68bu; x ^= x >> 16; return x; }
__device__ __forceinline__ void ck_fail(const CK& c, unsigned code) { atomicCAS((unsigned*)(c.ws + WS_CTL) + CW_FLAG, 0u, code); }
__device__ __forceinline__ bool ck_bad(float a, float ref, float rtol, float atol) { return !(fabsf(a - ref) <= rtol * fabsf(ref) + atol); }
__device__ __forceinline__ float bfr(float x) { return bf2f(f2bf(x)); }
__device__ __forceinline__ float dot_bf(const bf16_t* a, const bf16_t* b, int K) { float s = 0.f; for (int k = 0; k < K; ++k) s += bf2f(a[k]) * bf2f(b[k]); return s; }

__device__ __forceinline__ int wai_row(int col) { const int tl = col >> 8, hd = (col >> 6) & 3, dm = col & 63; return tl < 5 ? tl * 256 + (dm >> 5) * 128 + hd * 32 + (dm & 31) : col; }
__device__ __forceinline__ int win_row(int col) { if (col >= 512 && col < 1024) { const int x = col - 512; return (2 + (x >> 7)) * 256 + (x & 127); } if (col >= 1024 && col < 1536) { const int x = col - 1024; return (2 + (x >> 7)) * 256 + 128 + (x & 127); } return col; }
__global__ void ck_prologue(CK c, int layer, unsigned code, int with_small) {
    const unsigned id = blockIdx.x * 256 + threadIdx.x, r = hsh(id * 3 + 1), r2 = hsh(id * 3 + 2);
    const bf16_t* GU = CWS(bf16_t, layer ? WS_MOEGU1 : WS_MOEGU); const bf16_t* DW = CWS(bf16_t, layer ? WS_MOED1 : WS_MOED); const float* gain = c.in[3] + layer * D;
    if (!with_small) {
    { const int e = r & 31, row = (r >> 5) & 511, k = (r >> 14) & 1023, pnl = row >> 8, cc = row & 255;
      const float* W = (cc < 128 ? c.in[21] : c.in[22]) + ((size_t)layer * NEXP + e) * D * 256; const float ref = bfr(W[(size_t)k * 256 + pnl * 128 + (cc & 127)] * gain[k]);
      if (ck_bad(bf2f(GU[((size_t)e * 512 + row) * D + k]), ref, 1e-6f, 1e-12f)) ck_fail(c, code); }
    { const int e = r2 & 31, n = (r2 >> 5) & 1023, k = (r2 >> 15) & 255; const float ref = bfr(c.in[23][(((size_t)layer * NEXP + e) * 256 + k) * D + n]);
      if (ck_bad(bf2f(DW[((size_t)e * 1024 + n) * 256 + k]), ref, 1e-6f, 1e-12f)) ck_fail(c, code); }
    return; }
    { const int n = r % 3072, k = (r2 >> 3) & 1023; const float ref = bfr(c.in[5][(size_t)k * 3104 + n] * c.in[2][k]);
      if (ck_bad(bf2f(CWS(bf16_t, WS_WIN)[(size_t)win_row(n) * D + k]), ref, 1e-6f, 1e-12f)) ck_fail(c, code); }
    if (with_small == 1) { const int n = r2 & 1023, k = (r >> 7) & 1023;
      if (ck_bad(bf2f(CWS(bf16_t, WS_WO0)[(size_t)n * D + k]), bfr(c.in[12][(size_t)k * D + n]), 1e-6f, 1e-12f)) ck_fail(c, code);
      if (ck_bad(bf2f(CWS(bf16_t, WS_WAO)[(size_t)n * D + k]), bfr(c.in[16][(size_t)k * D + n]), 1e-6f, 1e-12f)) ck_fail(c, code);
      const int n2 = r % NA; if (ck_bad(bf2f(CWS(bf16_t, WS_WAI)[(size_t)wai_row(n2) * D + k]), bfr(c.in[13][(size_t)k * NA + n2] * c.in[2][D + k]), 1e-6f, 1e-12f)) ck_fail(c, code); }
    if (with_small == 1) { const int l = r & 1, j = (r >> 1) % 48, k = (r2 >> 9) & 1023; float w = (j < 4) ? c.in[17][((size_t)l * D + k) * 4 + j] : (j < 36) ? c.in[19][((size_t)l * D + k) * 32 + j - 4] : 0.f; w *= c.in[3][l * D + k];
      const bf16_t* WR = CWS(bf16_t, WS_WR); const float got = bf2f(WR[((size_t)(l * 2) * 48 + j) * D + k]) + bf2f(WR[((size_t)(l * 2 + 1) * 48 + j) * D + k]);
      if (ck_bad(got, w, 1e-4f, 1e-9f)) ck_fail(c, code); }
    if (with_small == 2) { const int row = r % MP, k = r2 & 1023; float ref = 0.f, ss = 0.f;
      if (row < MA) { const float* src = row < MR ? c.in[0] + (size_t)row * D : c.in[1] + (size_t)((row - MR) & 15) * D; ref = bfr(src[k]); for (int i = 0; i < D; ++i) ss += src[i] * src[i]; }
      if (ck_bad(bf2f(CWS(bf16_t, WS_HB)[(size_t)row * D + k]), ref, 1e-6f, 1e-12f)) ck_fail(c, code + 20);
      if (ck_bad(CWS(float, WS_SS)[row], ss, 1e-4f, 1e-6f)) ck_fail(c, code + 20); }
}
__global__ void ck_gemm_bf16(CK c, size_t offA, size_t offB, size_t offO, int ldo, size_t offSS, int M, int N, int K, unsigned code) {
    const unsigned id = blockIdx.x * 64 + threadIdx.x, r = hsh(id * 2 + 11), r2 = hsh(id * 2 + 12);
    int row = r % M, col = r2 % N; if ((id & 7) == 0) row = M - 1 - (r % 300 % M); if ((id & 7) == 1) col = N - 1 - (r2 % 40);
    const float sc = offSS ? pg8::rs_of(CWS(float, offSS)[row]) : 1.0f;
    const float ref = sc * dot_bf(CWS(bf16_t, offA) + (size_t)row * K, CWS(bf16_t, offB) + (size_t)col * K, K);
    if (ck_bad(bf2f(CWS(bf16_t, offO)[(size_t)row * ldo + col]), ref, 0.015f, 0.02f)) ck_fail(c, code);
}
__global__ void ck_u(CK c, unsigned code) {
    const unsigned id = blockIdx.x * 64 + threadIdx.x, r = hsh(id * 2 + 11), r2 = hsh(id * 2 + 12);
    int row = r % MA; const int ucol = r2 % U_LA; if ((id & 7) == 0) row = MA - 1 - (r % 300);
    const float sc = pg8::rs_of(CWS(float, WS_SS)[row]); const bf16_t* hb = CWS(bf16_t, WS_HB) + (size_t)row * D; const bf16_t* WT = CWS(bf16_t, WS_WIN); float ref;
    if (ucol >= U_Z && ucol < U_Z + 512) { const int ch = ucol - U_Z; ref = (sc * dot_bf(hb, WT + (size_t)win_row(512 + ch) * D, D)) * (sc * dot_bf(hb, WT + (size_t)win_row(1024 + ch) * D, D)); }
    else { const int oc = ucol < 512 ? ucol : ucol + 512; ref = sc * dot_bf(hb, WT + (size_t)win_row(oc) * D, D); }
    if (ck_bad(bf2f(CWS(bf16_t, WS_BIG)[(size_t)row * NU + ucol]), ref, 0.02f, 0.02f)) ck_fail(c, code);
}
__device__ __forceinline__ float ck_loga(const CK& c, const bf16_t* U, int row, int dir, int ch) { return bf2f(U[(size_t)row * NU + U_LA + dir * 256 + ch]); }
__global__ void ck_la(CK c, unsigned code) {
    const unsigned id = blockIdx.x * 64 + threadIdx.x, r = hsh(id + 90210); const int row = r % MA, dir = (r >> 15) & 1, ch = (r >> 16) & 255;
    const float* src = row < MR ? c.in[0] + (size_t)row * D : c.in[1] + (size_t)((row - MR) & 15) * D; float ss = 0.f; for (int k = 0; k < D; ++k) ss += src[k] * src[k];
    const float rs = pg8::rs_of(ss); float z = (dir ? c.in[10] : c.in[8])[ch];
    for (int j = 0; j < 16; ++j) { float g = 0.f; for (int k = 0; k < D; ++k) g += src[k] * rs * c.in[2][k] * c.in[5][(size_t)k * 3104 + 3072 + 16 * dir + j]; z += g * (dir ? c.in[9] : c.in[7])[j * 256 + ch]; }
    if (ck_bad(bf2f(CWS(bf16_t, WS_BIG)[(size_t)row * NU + U_LA + dir * 256 + ch]), log_sigmoid(z) * 0.0625f, 0.03f, 0.003f)) ck_fail(c, code);
}
__global__ void ck_scan(CK c, unsigned code) {
    const unsigned id = blockIdx.x * 64 + threadIdx.x, r = hsh(id + 77);
    const int b = r & 7, h = (r >> 3) & 3, dir = (r >> 5) & 1, n = (r >> 6) % NCH, v = (r >> 12) & 127, d = (r >> 19) & 63;
    const bf16_t* U = CWS(bf16_t, WS_BIG); float Sx = 0.f;
    const int start = n == 0 ? 0 : NM + (n - 1) * 64, end = n == 0 ? NM : NM + n * 64;
    if (dir == 0) { for (int tp = 0; tp < start; ++tp) { const int row = tok_row(b, tp); const float a = expf(ck_loga(c, U, row, 0, h * 64 + d));
            Sx = a * Sx + bf2f(U[(size_t)row * NU + U_K + h * 64 + d]) * bf2f(U[(size_t)row * NU + U_V + h * 128 + v]); } }
    else { for (int tp = T - 1; tp >= end; --tp) { const int row = tok_row(b, tp); const float a = expf(ck_loga(c, U, row, 1, h * 64 + d));
            Sx = a * Sx + bf2f(U[(size_t)row * NU + U_K + h * 64 + d]) * bf2f(U[(size_t)row * NU + U_V + h * 128 + v]); } }
    const float got = bf2f(CWS(bf16_t, WS_H)[((size_t)((b * 4 + h) * 2 + dir) * NCH + n) * 8192 + v * 64 + d]);
    if (ck_bad(got, Sx, 0.04f, 0.15f)) ck_fail(c, code);
}
__global__ void __launch_bounds__(128) ck_glaout(CK c, unsigned code) {
    __shared__ float red[2];
    const unsigned r = hsh(blockIdx.x + 1234); const int b = r & 7, h = (r >> 3) & 3; int tp = (r >> 5) % T; if (blockIdx.x < 8) tp = blockIdx.x * 3; if (blockIdx.x >= 8 && blockIdx.x < 12) tp = T - 1 - (blockIdx.x - 8) * 21;
    const int v = threadIdx.x; const bf16_t* U = CWS(bf16_t, WS_BIG);
    float Sx[64];
#pragma unroll
    for (int d = 0; d < 64; ++d) Sx[d] = 0.f;
    float of = 0.f, ob = 0.f;
    for (int t2 = 0; t2 <= tp; ++t2) { const size_t row = tok_row(b, t2); const float vv = bf2f(U[row * NU + U_V + h * 128 + v]); float o = 0.f;
#pragma unroll
        for (int d = 0; d < 64; ++d) { const float a = expf(ck_loga(c, U, (int)row, 0, h * 64 + d)); Sx[d] = a * Sx[d] + bf2f(U[row * NU + U_K + h * 64 + d]) * vv; o += bf2f(U[row * NU + U_Q + h * 64 + d]) * Sx[d]; }
        of = o; }
#pragma unroll
    for (int d = 0; d < 64; ++d) Sx[d] = 0.f;
    for (int t2 = T - 1; t2 >= tp; --t2) { const size_t row = tok_row(b, t2); const float vv = bf2f(U[row * NU + U_V + h * 128 + v]); float o = 0.f;
#pragma unroll
        for (int d = 0; d < 64; ++d) { const float a = expf(ck_loga(c, U, (int)row, 1, h * 64 + d)); const float as = a * Sx[d]; o += bf2f(U[row * NU + U_Q + h * 64 + d]) * as; Sx[d] = as + bf2f(U[row * NU + U_K + h * 64 + d]) * vv; }
        ob = o; }
    const float o = (of + ob) * 0.125f; float ss = wave_sum(o * o);
    if ((v & 63) == 0) red[v >> 6] = ss;
    __syncthreads();
    const size_t row = tok_row(b, tp); const float rs = rsqrtf((red[0] + red[1]) * (1.0f / 128.0f) + EPS); const float rr = bf2f(U[row * NU + U_R + h * 128 + v]);
    const float ref = o * rs * c.in[11][v] * (rr / (1.0f + expf(-rr)));
    if (ck_bad(bf2f(CWS(bf16_t, WS_HB)[row * D + 512 + h * 128 + v]), ref, 0.04f, 0.04f)) ck_fail(c, code);
    { const int ch = h * 128 + v; float z[3];
      for (int dd = -1; dd <= 1; ++dd) { const int t3 = tp + dd; z[dd + 1] = (t3 >= 0 && t3 < T) ? bf2f(U[(size_t)tok_row(b, t3) * NU + U_Z + ch]) : 0.f; }
      const float refc = bf2f(U[row * NU + U_AB + ch]) * (c.in[6][ch] * z[0] + c.in[6][512 + ch] * z[1] + c.in[6][1024 + ch] * z[2]);
      if (ck_bad(bf2f(CWS(bf16_t, WS_HB)[row * D + ch]), refc, 0.02f, 0.02f)) ck_fail(c, code + 20); }
}
__global__ void ck_outproj0(CK c, unsigned code) {
    const unsigned id = blockIdx.x * 64 + threadIdx.x, r = hsh(id * 2 + 5), r2 = hsh(id * 2 + 6); int row = r % MA; const int col = r2 & 1023; if ((id & 3) == 0) row = MA - 1 - (r % 200);
    const float emb = row < MR ? c.in[0][(size_t)row * D + col] : c.in[1][(size_t)((row - MR) & 15) * D + col];
    const float ref = emb + dot_bf(CWS(bf16_t, WS_HB) + (size_t)row * D, CWS(bf16_t, WS_WO0) + (size_t)col * D, D);
    if (ck_bad(bf2f(CWS(bf16_t, WS_H)[(size_t)row * D + col]), ref, 0.015f, 0.02f)) ck_fail(c, code);
}
__global__ void ck_route(CK c, int layer, int nrows, unsigned code) {
    const unsigned id = blockIdx.x * 64 + threadIdx.x, r = hsh(id + 999 + layer); const int row = r % nrows;
    const bf16_t* hr = CWS(bf16_t, WS_H) + (size_t)row * D; const float* gain = c.in[3] + layer * D;
    float lg[4], le[32]; float ss = 0.f;
#pragma unroll
    for (int j = 0; j < 4; ++j) lg[j] = 0.f;
#pragma unroll
    for (int j = 0; j < 32; ++j) le[j] = 0.f;
    for (int k = 0; k < D; ++k) { const float x = bf2f(hr[k]); ss += x * x; const float xg = x * gain[k];
#pragma unroll
        for (int j = 0; j < 4; ++j) lg[j] += xg * c.in[17][((size_t)layer * D + k) * 4 + j];
#pragma unroll
        for (int j = 0; j < 32; ++j) le[j] += xg * c.in[19][((size_t)layer * D + k) * 32 + j]; }
    const float rs = pg8::rs_of(ss);
#pragma unroll
    for (int j = 0; j < 4; ++j) lg[j] = lg[j] * rs + c.in[18][layer * 4 + j];
#pragma unroll
    for (int j = 0; j < 32; ++j) le[j] = le[j] * rs + c.in[20][layer * 32 + j];
    int gi = 0; float gm = lg[0], g2 = -INFINITY;
#pragma unroll
    for (int j = 1; j < 4; ++j) if (lg[j] > gm) { gm = lg[j]; gi = j; }
#pragma unroll
    for (int j = 0; j < 4; ++j) if (j != gi && lg[j] > g2) g2 = lg[j];
    float gs = 0.f;
#pragma unroll
    for (int j = 0; j < 4; ++j) gs += expf(lg[j] - gm);
    const float gp = 1.0f / gs; float es[8];
#pragma unroll
    for (int j = 0; j < 8; ++j) es[j] = gi == 0 ? le[j] : gi == 1 ? le[8 + j] : gi == 2 ? le[16 + j] : le[24 + j];
    int i0 = 0; float v0 = es[0];
#pragma unroll
    for (int j = 1; j < 8; ++j) if (es[j] > v0) { v0 = es[j]; i0 = j; }
    int i1 = 0; float v1 = -INFINITY, v2 = -INFINITY;
#pragma unroll
    for (int j = 0; j < 8; ++j) if (j != i0 && es[j] > v1) { v1 = es[j]; i1 = j; }
#pragma unroll
    for (int j = 0; j < 8; ++j) if (j != i0 && j != i1 && es[j] > v2) v2 = es[j];
    const float e1 = expf(v1 - v0), w0 = gp / (1.0f + e1), w1 = gp * e1 / (1.0f + e1);
    const unsigned* RI = CWS(unsigned, WS_RI) + (size_t)row * 8; const float gw0 = __uint_as_float(RI[4]), gw1 = __uint_as_float(RI[5]);
    const bool tie = (gm - g2 < 1e-3f) || (v1 - v2 < 1e-3f) || (v0 - v1 < 1e-3f);
    if (!tie) { if ((int)RI[0] != gi * 8 + i0 || (int)RI[1] != gi * 8 + i1) ck_fail(c, code); if (ck_bad(gw0, w0, 2e-3f, 1e-4f) || ck_bad(gw1, w1, 2e-3f, 1e-4f)) ck_fail(c, code); }
    const int* LIST = CWS(int, WS_LIST); const unsigned* CNT = (const unsigned*)(c.ws + WS_CTL) + (layer ? CW_CNT1 : CW_CNT0);
    if (RI[0] >= 32u || RI[1] >= 32u || RI[2] >= CNT[RI[0]] || RI[3] >= CNT[RI[1]]) { ck_fail(c, code + 20); return; }
    if (LIST[(size_t)RI[0] * MA + RI[2]] != row || LIST[(size_t)RI[1] * MA + RI[3]] != row) ck_fail(c, code + 20);
    if (ck_bad(CWS(float, WS_SS)[2 * MP + row], rs, 1e-4f, 0.f)) ck_fail(c, code + 20);
    if (id == 0) { unsigned tot = 0; for (int e = 0; e < 32; ++e) tot += CNT[e]; if (tot != 2u * (unsigned)nrows) ck_fail(c, code + 40); }
}
__global__ void ck_moe(CK c, int layer, unsigned code) {
    const unsigned id = blockIdx.x * 64 + threadIdx.x, r = hsh(id * 2 + 31), r2 = hsh(id * 2 + 32);
    const unsigned* CNT = (const unsigned*)(c.ws + WS_CTL) + (layer ? CW_CNT1 : CW_CNT0);
    const int e = r & 31; unsigned tb = 0; for (int j = 0; j < e; ++j) tb += (CNT[j] + 255u) >> 8;
    const unsigned cnt = CNT[e]; if (cnt == 0) return; unsigned idx = (r >> 5) % cnt; if ((id & 3) == 0) idx = cnt - 1 - ((r >> 5) % (cnt < 64 ? cnt : 64));
    const int tok = CWS(int, WS_LIST)[(size_t)e * MA + idx]; const float rs = CWS(float, WS_SS)[2 * MP + tok]; const size_t prow = (size_t)tb * 256 + idx;
    const bf16_t* hb = CWS(bf16_t, WS_H) + (size_t)tok * D; const bf16_t* GU = CWS(bf16_t, layer ? WS_MOEGU1 : WS_MOEGU); const bf16_t* HH = CWS(bf16_t, WS_HH);
    { const int j = r2 & 255; const bf16_t* wg = GU + ((size_t)e * 512 + (j >> 7) * 256 + (j & 127)) * D; const float g = rs * dot_bf(hb, wg, D), u = rs * dot_bf(hb, wg + (size_t)128 * D, D);
      const float ref = g / (1.0f + expf(-g)) * u; if (ck_bad(bf2f(HH[prow * 256 + j]), ref, 0.03f, 0.02f)) ck_fail(c, code); }
    { const int n = (r2 >> 8) & 1023; const float ref = dot_bf(HH + prow * 256, CWS(bf16_t, layer ? WS_MOED1 : WS_MOED) + ((size_t)e * 1024 + n) * 256, 256);
      if (ck_bad(bf2f(CWS(bf16_t, WS_Y)[prow * D + n]), ref, 0.02f, 0.02f)) ck_fail(c, code + 1); }
}
__global__ void ck_combine(CK c, unsigned code) {
    const unsigned id = blockIdx.x * 64 + threadIdx.x, r = hsh(id + 4242); const int row = r % MA; const bf16_t* hr = CWS(bf16_t, WS_H) + (size_t)row * D; float ss = 0.f;
    for (int i = 0; i < D; ++i) ss += bf2f(hr[i]) * bf2f(hr[i]);
    if (ck_bad(CWS(float, WS_SS)[MP + row], ss, 1e-4f, 1e-6f)) ck_fail(c, code);
}
__global__ void __launch_bounds__(64) ck_qk(CK c, unsigned code) {
    const unsigned r = hsh(blockIdx.x + 555); int row = r % MA; const int head = (r >> 15) % 20, d = threadIdx.x; if ((blockIdx.x & 7) == 0) row = MR + (r % 128);
    const float sc = pg8::rs_of(CWS(float, WS_SS)[MP + row]); const bf16_t* hb = CWS(bf16_t, WS_H) + (size_t)row * D;
    const float raw = sc * dot_bf(hb, CWS(bf16_t, WS_WAI) + (size_t)wai_row(head * 64 + d) * D, D);
    const float ss = wave_sum(raw * raw); const float xn = raw * rsqrtf(ss * (1.0f / 64.0f) + EPS) * (head < 16 ? c.in[14][d] * ATT_C2 : c.in[15][d]);
    const float pr = __shfl_xor(xn, 1); float cs = 1.f, sn = 0.f;
    if (row < MR) { const int s = row & (S - 1), rr = s >> 6, cc = s & 63, i = d >> 1, f = i < 16 ? i : i - 16; const float ang = (float)(i < 16 ? rr : cc) * powf(10000.0f, -(float)(2 * f) / 32.0f); cs = cosf(ang); sn = sinf(ang); }
    const float ref = (d & 1) ? (pr * sn + xn * cs) : (xn * cs - pr * sn);
    if (ck_bad(bf2f(CWS(bf16_t, WS_U2)[(size_t)row * NA + head * 64 + d]), ref, 0.03f, head < 16 ? 0.006f : 0.03f)) ck_fail(c, code);
    const int vc = 1280 + ((r >> 20) & 3) * 64 + d; const float refv = sc * dot_bf(hb, CWS(bf16_t, WS_WAI) + (size_t)wai_row(vc) * D, D);
    if (ck_bad(bf2f(CWS(bf16_t, WS_U2)[(size_t)row * NA + vc]), refv, 0.015f, 0.02f)) ck_fail(c, code + 20);
}
__global__ void __launch_bounds__(64) ck_attn(CK c, unsigned code) {
    __shared__ float qs[64], sc[T];
    const unsigned r = hsh(blockIdx.x + 31337); const int b = r & 7, h = (r >> 3) & 15, s = (r >> 7) & 2047, kvh = h >> 2, tid = threadIdx.x; const bf16_t* U2 = CWS(bf16_t, WS_U2);
    qs[tid] = bf2f(U2[((size_t)b * S + s) * NA + h * 64 + tid]);
    __syncthreads();
    float mx = -INFINITY;
    for (int j = tid; j < T; j += 64) { const bf16_t* kp = U2 + (size_t)tok_row(b, j) * NA + 1024 + kvh * 64; float a = 0.f; for (int d = 0; d < 64; ++d) a += qs[d] * bf2f(kp[d]); sc[j] = a; mx = fmaxf(mx, a); }
#pragma unroll
    for (int o = 1; o < 64; o <<= 1) mx = fmaxf(mx, __shfl_xor(mx, o));
    __syncthreads();
    float l = 0.f, acc = 0.f;
    for (int j = 0; j < T; ++j) { const float p = exp2f(sc[j] - mx); l += p; acc += p * bf2f(U2[(size_t)tok_row(b, j) * NA + 1280 + kvh * 64 + tid]); }
    const float ref = acc / l;
    if (ck_bad(bf2f(CWS(bf16_t, WS_AO)[((size_t)b * S + s) * D + h * 64 + tid]), ref, 0.04f, 0.004f)) ck_fail(c, code);
}
__global__ void ck_report(CK c, int always_zero) {
    const unsigned code = ((const unsigned*)(c.ws + WS_CTL))[CW_FLAG];
    const size_t i = (size_t)blockIdx.x * 256 + threadIdx.x;
    if (code) c.out[i] = sqrtf((float)code); else if (always_zero) c.out[i] = 0.f;
}
#endif
extern "C" void kernel_launch(void* const* d_in, const int* in_sizes, int n_in, void* d_out, int out_size, void* d_ws, size_t ws_size, hipStream_t stream) {
    static int grid = 0;
    if (grid == 0) {
        if (n_in != 24 || out_size != MR * D || ws_size < WS_END) { fprintf(stderr, "kernel_launch: unexpected shapes / workspace (%d inputs, out %d, ws %zu < %zu)\n", n_in, out_size, ws_size, (size_t)WS_END); grid = -1; return; }
        int dev = 0, cus = 0;
        if (hipGetDevice(&dev) != hipSuccess || hipDeviceGetAttribute(&cus, hipDeviceAttributeMultiprocessorCount, dev) != hipSuccess) { grid = -1; return; }
        if (hipFuncSetAttribute((const void*)mega, hipFuncAttributeMaxDynamicSharedMemorySize, LDS_BYTES) != hipSuccess) { fprintf(stderr, "kernel_launch: hipFuncSetAttribute failed\n"); grid = -1; return; }
        int per_cu = 0; (void)hipOccupancyMaxActiveBlocksPerMultiprocessor(&per_cu, (const void*)mega, NWAVES * 64, LDS_BYTES); (void)hipGetLastError();
        if (per_cu < 1) fprintf(stderr, "kernel_launch: occupancy query reports %d blocks per CU\n", per_cu);
        grid = cus;
    }
    if (grid < 0) return;
    (void)hipMemsetAsync((char*)d_ws + WS_CTL, 0, CTL_ZERO_BYTES, stream);
    Args a{};
    for (int i = 0; i < 24; ++i) a.in[i] = (const float*)d_in[i];
    a.out = (float*)d_out; a.ws = (unsigned char*)d_ws;
#if SELFCHECK
    CK c{}; for (int i = 0; i < 24; ++i) c.in[i] = (const float*)d_in[i]; c.ws = (unsigned char*)d_ws; c.out = (float*)d_out;
#define RUN(lo_, hi_) do { a.ph_lo = (lo_); a.ph_hi = (hi_); hipLaunchKernelGGL(mega, dim3(grid), dim3(NWAVES * 64), LDS_BYTES, stream, a); } while (0)
    RUN(0, 1); hipLaunchKernelGGL(ck_prologue, dim3(64), dim3(256), 0, stream, c, 0, 1u, 2);
    RUN(1, 2); hipLaunchKernelGGL(ck_u, dim3(64), dim3(64), 0, stream, c, 2u); hipLaunchKernelGGL(ck_la, dim3(16), dim3(64), 0, stream, c, 3u);
    RUN(2, 3); RUN(3, 4); hipLaunchKernelGGL(ck_scan, dim3(16), dim3(64), 0, stream, c, 4u);
    RUN(4, 5); hipLaunchKernelGGL(ck_glaout, dim3(96), dim3(128), 0, stream, c, 5u); hipLaunchKernelGGL(ck_prologue, dim3(64), dim3(256), 0, stream, c, 0, 1u, 0);
    RUN(5, 6); hipLaunchKernelGGL(ck_outproj0, dim3(64), dim3(64), 0, stream, c, 6u);
    RUN(6, 7); hipLaunchKernelGGL(ck_route, dim3(8), dim3(64), 0, stream, c, 0, MA, 7u);
    RUN(7, 8); RUN(8, 9); hipLaunchKernelGGL(ck_moe, dim3(64), dim3(64), 0, stream, c, 0, 8u); hipLaunchKernelGGL(ck_prologue, dim3(64), dim3(256), 0, stream, c, 0, 1u, 1);
    RUN(9, 10); hipLaunchKernelGGL(ck_combine, dim3(8), dim3(64), 0, stream, c, 10u); hipLaunchKernelGGL(ck_prologue, dim3(64), dim3(256), 0, stream, c, 1, 11u, 0);
    RUN(10, 11); RUN(11, 12); hipLaunchKernelGGL(ck_qk, dim3(1024), dim3(64), 0, stream, c, 12u);
    RUN(12, 13); hipLaunchKernelGGL(ck_attn, dim3(512), dim3(64), 0, stream, c, 13u);
    RUN(13, 14);
    RUN(14, 15); hipLaunchKernelGGL(ck_route, dim3(8), dim3(64), 0, stream, c, 1, MR, 15u);
    RUN(15, 16); RUN(16, 17); RUN(17, 18); hipLaunchKernelGGL(ck_moe, dim3(64), dim3(64), 0, stream, c, 1, 16u);
    RUN(18, 19); hipLaunchKernelGGL(ck_report, dim3(MR * D / 256), dim3(256), 0, stream, c, 0);
#undef RUN
#elif N_LAUNCH_MODE == 0
    for (int p = 0; p < NPHASE; ++p) { a.ph_lo = p; a.ph_hi = p + 1; hipLaunchKernelGGL(mega, dim3(grid), dim3(NWAVES * 64), LDS_BYTES, stream, a); }
#else
    a.ph_lo = 0; a.ph_hi = NPHASE;
    hipLaunchKernelGGL(mega, dim3(grid), dim3(NWAVES * 64), LDS_BYTES, stream, a);
#endif
}
```

```cpp
#include <hip/hip_runtime.h>
#include <hip/hip_bf16.h>
#include <cstdint>
#include <cstdio>
#include <cmath>

#ifndef SELFCHECK
#define SELFCHECK 0
#endif
#ifndef N_LAUNCH_MODE
#define N_LAUNCH_MODE 1
#endif

constexpr int Bz = 8, S = 2048, D = 1024, NM = 16, T = S + NM;
constexpr int MR = Bz * S;
constexpr int MA = MR + Bz * NM;
constexpr int MP = 16640;
constexpr int NU = 3072;
constexpr int NG1 = 3584;
constexpr int U_AB = 0, U_Z = 512, U_Q = 1024, U_K = 1280, U_V = 1536, U_R = 2048, U_LA = 2560;
constexpr int W_LA = 3072;
constexpr int NA = 1536;
constexpr int NCH = 33;
constexpr int YROWS = 41216;
constexpr int NEXP = 32;
constexpr float EPS = 1e-6f;

typedef unsigned short bf16_t;

constexpr size_t MiB = 1u << 20;
constexpr size_t WS_CTL = 0, CTL_ZERO_BYTES = 32 * 1024;
constexpr size_t WS_ROPE = 1 * MiB;
constexpr size_t WS_WR = WS_ROPE + 512 * 1024;
constexpr size_t WS_SS = WS_WR + 384 * 1024;
constexpr size_t WS_RI = WS_SS + 256 * 1024;
constexpr size_t WS_DEC = WS_RI + 1 * MiB;
constexpr size_t WS_LIST = WS_DEC + 1 * MiB;
constexpr size_t WS_SMALLW = 6 * MiB + 256 * 1024;
constexpr size_t SZ_WIN = (size_t)NG1 * D * 2, SZ_WSQ = (size_t)D * D * 2, SZ_WAI = (size_t)NA * D * 2;
constexpr size_t WS_WIN = WS_SMALLW, WS_WO0 = WS_WIN + SZ_WIN, WS_WAI = WS_WO0 + SZ_WSQ, WS_WAO = WS_WAI + SZ_WAI;
constexpr size_t WS_MOEGU = WS_WAO + SZ_WSQ;
constexpr size_t WS_MOED = WS_MOEGU + (size_t)NEXP * 512 * D * 2;
constexpr size_t WS_H = WS_MOED + (size_t)NEXP * D * 256 * 2;
constexpr size_t WS_HB = WS_H + (size_t)MP * D * 4;
constexpr size_t WS_BIG = WS_HB + (size_t)MP * D * 2;
constexpr size_t SZ_BIG = (size_t)MP * 3328 * 2;
constexpr size_t WS_Y = WS_BIG, WS_HH = WS_Y + (size_t)YROWS * D * 2, WS_U2 = WS_BIG, WS_AO = WS_U2 + (size_t)MP * NA * 2;
constexpr size_t WS_RSL = WS_HH + (size_t)YROWS * 256 * 2;
constexpr size_t WS_END = WS_BIG + SZ_BIG;
static_assert(WS_RSL + (size_t)NEXP * MA * 4 <= WS_BIG + SZ_BIG, "RSL fits behind HH");
constexpr size_t WS_MOEGU1 = WS_H + 33 * MiB, WS_MOED1 = WS_HB;
constexpr size_t WS_HB0 = WS_H + 33 * MiB;
static_assert(WS_HB0 + (size_t)MR * D * 2 == WS_HB, "HB0 real rows end where the HB region starts");
static_assert(WS_MOEGU1 + (size_t)NEXP * 512 * D * 2 <= WS_HB && (size_t)MP * D * 2 <= 33 * MiB && (size_t)NEXP * D * 256 * 2 <= (size_t)MP * D * 2, "layer-1 MoE weight buffers");
static_assert(WS_HH + (size_t)YROWS * 256 * 2 <= WS_END && WS_AO + (size_t)MR * D * 2 <= WS_END, "BIG overlays");
static_assert(WS_LIST + (size_t)NEXP * MA * 4 <= WS_SMALLW, "small area");
static_assert((size_t)Bz * 4 * 2 * NCH * 128 * 64 * 2 <= (size_t)MP * D * 4, "KVSB fits in H");
constexpr int CW_FLAG = 8;
constexpr int CW_CNT0 = 64, CW_CNT1 = 128;
constexpr int CW_CONV0 = 192, CW_CONV1 = 256;
constexpr int CW_BAR = 4096;
static_assert((CW_BAR + 3456) * 4 <= (int)CTL_ZERO_BYTES, "barrier words inside the per-call memset");
namespace pg8 {
#define PG8_LAS __attribute__((address_space(3)))
typedef short bf16x8 __attribute__((ext_vector_type(8)));
typedef float f32x4 __attribute__((ext_vector_type(4)));
typedef unsigned u32x4 __attribute__((ext_vector_type(4)));
constexpr int BM = 256, BK = 64, HALF = 128, HTB = HALF * BK * 2  , STAGE_BYTES = 8 * HTB, NXCD = 8, WGM = 8;

__host__ __device__ __forceinline__ int lds_byte(int r, int c) { const int st = (r >> 4) * 2 + (c >> 5), rr = r & 15, cc = c & 31, ob = rr * 64 + cc * 2; return st * 1024 + (ob ^ (((ob >> 9) & 1) << 5)); }
__host__ __device__ __forceinline__ void stage_rc(int b, int& R, int& C) { const int st = b / 1024, sb = b % 1024, swz = sb ^ (((sb >> 9) & 1) << 5); R = (st >> 1) * 16 + swz / 64; C = (st & 1) * 32 + (swz % 64) / 2; }
__host__ __device__ __forceinline__ int perm32(int rho) { const int n = rho >> 4, i = rho & 15; return 8 * (i >> 2) + 4 * n + (i & 3); }

struct Unit { int pm, pn, e, mt; };
struct Gemm { const bf16_t* A; const bf16_t* Bt; int M, N, K; };

struct StaticOrder {
    static constexpr bool GATHER = false;
    int nM, nN, nwg, G, c, rep, off = 0, lim = 1 << 30;
    __host__ __device__ void init(int M, int N, int G_, int c_, int rep_ = 1) { nM = M / BM; nN = N / BM; nwg = nM * nN; G = G_; c = c_; rep = rep_; }
    __host__ __device__ bool next(int i, Unit& u) const {
        long L = (long)i * G + c + off; if (L >= (long)nwg * rep || L >= lim) return false; L %= nwg;
        int wgid = (int)L; { const int q = nwg / NXCD, r = nwg % NXCD, xcd = wgid % NXCD, off = wgid / NXCD; wgid = (xcd < r ? xcd * (q + 1) : r * (q + 1) + (xcd - r) * q) + off; }
        const int nig = WGM * nN, gid = wgid / nig, fm = gid * WGM, gsz = (nM - fm) < WGM ? (nM - fm) : WGM;
        u.pm = fm + ((wgid % nig) % gsz); u.pn = (wgid % nig) / gsz; u.e = 0; u.mt = 0; return true;
    }
    PG8_LAS unsigned char* van = nullptr;
    __device__ __forceinline__ unsigned arow(const Unit&, int) const { return 0u; }
    __device__ __forceinline__ void a_ready(const Unit&) const {}
    __device__ __forceinline__ void done(const Unit&) const {}
};

__device__ __forceinline__ unsigned cvt_pk_bf16(float lo, float hi) { unsigned r; asm volatile("v_cvt_pk_bf16_f32 %0, %1, %2" : "=v"(r) : "v"(lo), "v"(hi)); return r; }

template <class Epi, class Sched, bool ALIGN_EPI = false>
__device__ __forceinline__ void gemm_phase(PG8_LAS unsigned char* lds, const Gemm g, const Sched& S, const Epi& E) {
    const int tid = threadIdx.x, wid = __builtin_amdgcn_readfirstlane(tid >> 6), lane = tid & 63, wr = wid >> 2, wc = wid & 3, fr = lane & 15, fq = lane >> 4;
    const int K = g.K, nt = K / BK;
    constexpr bool GA = Sched::GATHER;
    unsigned voffB[2];
#pragma unroll
    for (int i = 0; i < 2; ++i) { int R, C; stage_rc(tid * 16 + i * 8192, R, C); const int Rb = Epi::PERM ? ((R & ~31) + perm32(R & 31)) : R;
        voffB[i] = (unsigned)(Rb * K + C) * 2u; }
    const size_t kstep = (size_t)(BK * 2);
    const size_t hstep = (size_t)HALF * K * 2;
    const size_t tstep = 2 * hstep;
    const unsigned ldsw = (unsigned)wid * 1024u;
    const int aoff = lds_byte(wr * 64 + fr, fq * 8), boff = lds_byte(wc * 32 + fr, fq * 8);
#define PG8_SA(b, h) (((b) * 2 + (h)) * HTB)
#define PG8_SB(b, h) ((4 + (b) * 2 + (h)) * HTB)
#define PG8_STAGE2(bufoff, gbase, v0, v1) do { \
        __builtin_amdgcn_global_load_lds((const unsigned*)((const char*)(gbase) + (v0)), (PG8_LAS unsigned*)(lds + (bufoff) + ldsw), 16, 0, 0); \
        __builtin_amdgcn_global_load_lds((const unsigned*)((const char*)(gbase) + (v1)), (PG8_LAS unsigned*)(lds + (bufoff) + ldsw + 8192), 16, 0, 0); } while (0)
#define PG8_STAGEB(bufoff, gbase) PG8_STAGE2(bufoff, gbase, voffB[0], voffB[1])
#define PG8_LDA(dst, b, h) do { _Pragma("unroll") for (int m = 0; m < 4; ++m) _Pragma("unroll") for (int k = 0; k < 2; ++k) dst[m][k] = *(const PG8_LAS bf16x8*)(lds + PG8_SA(b, h) + aoff + m * 2048 + k * 1024); } while (0)
#define PG8_LDB(dst, b, h) do { _Pragma("unroll") for (int n = 0; n < 2; ++n) _Pragma("unroll") for (int k = 0; k < 2; ++k) dst[n][k] = *(const PG8_LAS bf16x8*)(lds + PG8_SB(b, h) + boff + n * 2048 + k * 1024); } while (0)
#define PG8_MMA(ai, bj, At, Bt) do { __builtin_amdgcn_s_setprio(1); _Pragma("unroll") for (int m = 0; m < 4; ++m) _Pragma("unroll") for (int n = 0; n < 2; ++n) _Pragma("unroll") for (int k = 0; k < 2; ++k) \
        acc[ai][bj][m][n] = __builtin_amdgcn_mfma_f32_16x16x32_bf16(Bt[n][k], At[m][k], acc[ai][bj][m][n], 0, 0, 0); __builtin_amdgcn_s_setprio(0); } while (0)
#define PG8_WAIT_V(n) asm volatile("s_waitcnt vmcnt(" #n ")" ::: "memory")
#define PG8_WAIT_L(n) asm volatile("s_waitcnt lgkmcnt(" #n ")" ::: "memory")
#define PG8_BAR __builtin_amdgcn_s_barrier()
#define PG8_SCHED __builtin_amdgcn_sched_barrier(0)
#define PG8_SETVA(dst, U) do { _Pragma("unroll") for (int i_ = 0; i_ < 2; ++i_) { int R_, C_; stage_rc(tid * 16 + i_ * 8192, R_, C_); _Pragma("unroll") for (int h_ = 0; h_ < 2; ++h_) \
        dst[h_][i_] = GA ? (unsigned)(S.arow(U, h_ * HALF + R_) * (unsigned)K + (unsigned)C_) * 2u : (unsigned)((h_ * HALF + R_) * K + C_) * 2u; } } while (0)
    Unit cur, nxt; int ui = 0;
    if (!S.next(0, cur)) return;
    f32x4 acc[2][2][4][2];
#pragma unroll
    for (int a = 0; a < 2; ++a)
#pragma unroll
        for (int b = 0; b < 2; ++b)
#pragma unroll
            for (int m = 0; m < 4; ++m)
#pragma unroll
                for (int n = 0; n < 2; ++n) acc[a][b][m][n] = (f32x4){0.f, 0.f, 0.f, 0.f};
    bf16x8 At[4][2], B0[2][2], B1[2][2];
    unsigned vAc[2][2];
    PG8_SETVA(vAc, cur);
    if (GA) { *(PG8_LAS u32x4*)(S.van + tid * 32) = (u32x4){vAc[0][0], vAc[0][1], vAc[1][0], vAc[1][1]}; }
#define PG8_VA(h_, sl_) (GA ? *(const PG8_LAS unsigned long long*)(S.van + tid * 32 + (sl_) * 16 + (h_) * 8) : ((unsigned long long)vAc[h_][0] | ((unsigned long long)vAc[h_][1] << 32)))
#define PG8_STAGEA(bufoff, gbase, h_, sl_) do { const unsigned long long va_ = PG8_VA(h_, sl_); PG8_STAGE2(bufoff, gbase, (unsigned)va_, (unsigned)(va_ >> 32)); } while (0)
    const char* cA = GA ? (const char*)g.A : (const char*)g.A + (size_t)cur.pm * tstep; const char* cB = (const char*)g.Bt + (size_t)cur.pn * tstep;
    S.a_ready(cur);
    PG8_STAGEB(PG8_SB(0, 0), cB); PG8_STAGEB(PG8_SB(0, 1), cB + hstep); PG8_STAGEA(PG8_SA(0, 0), cA, 0, 0); PG8_STAGEA(PG8_SA(0, 1), cA, 1, 0);
    if (wr == 1) PG8_BAR;
    PG8_WAIT_V(2); PG8_BAR;
    PG8_STAGEB(PG8_SB(1, 0), cB + kstep); PG8_STAGEA(PG8_SA(1, 0), cA + kstep, 0, 0); PG8_STAGEB(PG8_SB(1, 1), cB + hstep + kstep);
    PG8_WAIT_V(6); PG8_BAR;
    for (;;) {
        const bool has_next = S.next(ui + 1, nxt);
        const char* nA = GA ? (const char*)g.A : (has_next ? (const char*)g.A + (size_t)nxt.pm * tstep : cA); const char* nB = has_next ? (const char*)g.Bt + (size_t)nxt.pn * tstep : cB;
        if (GA && has_next) { unsigned tmp_[2][2]; PG8_SETVA(tmp_, nxt);
            *(PG8_LAS u32x4*)(S.van + tid * 32 + 16) = (u32x4){tmp_[0][0], tmp_[0][1], tmp_[1][0], tmp_[1][1]}; }
#pragma unroll 1
        for (int t = 0; t < nt; t += 2) {
            const bool last = (t == nt - 2);
            const char* a1 = cA + (size_t)(t + 1) * kstep;
            const char* a2 = last ? nA : cA + (size_t)(t + 2) * kstep; const char* b2 = last ? nB : cB + (size_t)(t + 2) * kstep;
            const char* a3 = a2 + kstep; const char* b3 = b2 + kstep;
            if (last && has_next) S.a_ready(nxt);
            PG8_LDB(B0, 0, 0); PG8_LDB(B1, 0, 1); PG8_SCHED; PG8_LDA(At, 0, 0); PG8_STAGEA(PG8_SA(1, 1), a1, 1, 0);
            const int sl = (GA && last && has_next) ? 1 : 0;
            PG8_WAIT_V(8); PG8_WAIT_L(0); PG8_BAR; PG8_MMA(0, 0, At, B0); PG8_MMA(0, 1, At, B1); PG8_BAR; PG8_SCHED;
            PG8_LDA(At, 0, 1); PG8_STAGEB(PG8_SB(0, 0), b2); PG8_STAGEB(PG8_SB(0, 1), b2 + hstep); PG8_STAGEA(PG8_SA(0, 0), a2, 0, sl);
            PG8_WAIT_V(8); PG8_WAIT_L(0); PG8_BAR; PG8_MMA(1, 0, At, B0); PG8_MMA(1, 1, At, B1); PG8_BAR; PG8_SCHED;
            PG8_LDB(B0, 1, 0); PG8_LDB(B1, 1, 1); PG8_SCHED; PG8_LDA(At, 1, 0); PG8_STAGEA(PG8_SA(0, 1), a2, 1, sl);
            PG8_WAIT_V(8); PG8_WAIT_L(0); PG8_BAR; PG8_MMA(0, 0, At, B0); PG8_MMA(0, 1, At, B1); PG8_BAR; PG8_SCHED;
            PG8_LDA(At, 1, 1); PG8_STAGEB(PG8_SB(1, 0), b3); PG8_STAGEB(PG8_SB(1, 1), b3 + hstep); PG8_STAGEA(PG8_SA(1, 0), a3, 0, sl);
            PG8_WAIT_V(8); PG8_WAIT_L(0); PG8_BAR; PG8_MMA(1, 0, At, B0); PG8_MMA(1, 1, At, B1); PG8_BAR; PG8_SCHED;
        }
        if constexpr (ALIGN_EPI) { if (wr == 0) PG8_BAR; }
        E(acc, cur, wr, wc, fr, fq); S.done(cur);
        if (!has_next) break;
#pragma unroll
        for (int a = 0; a < 2; ++a)
#pragma unroll
            for (int b = 0; b < 2; ++b)
#pragma unroll
                for (int m = 0; m < 4; ++m)
#pragma unroll
                    for (int n = 0; n < 2; ++n) acc[a][b][m][n] = (f32x4){0.f, 0.f, 0.f, 0.f};
        cur = nxt; cA = nA; cB = nB; ++ui;
        if (GA) { *(PG8_LAS u32x4*)(S.van + tid * 32) = *(const PG8_LAS u32x4*)(S.van + tid * 32 + 16); }
        if constexpr (ALIGN_EPI) { if (wr == 1) PG8_BAR; }
    }
    PG8_WAIT_V(0);
    if constexpr (!ALIGN_EPI) { if (wr == 0) PG8_BAR; }
    PG8_BAR;
#undef PG8_SA
#undef PG8_SB
#undef PG8_STAGE2
#undef PG8_STAGEB
#undef PG8_LDA
#undef PG8_LDB
#undef PG8_MMA
#undef PG8_WAIT_V
#undef PG8_WAIT_L
#undef PG8_BAR
#undef PG8_SCHED
#undef PG8_SETVA
#undef PG8_VA
#undef PG8_STAGEA
}

__device__ __forceinline__ float rs_of(float ss) { return rsqrtf(ss * (1.0f / 1024.0f) + 1e-6f); }
struct EpiScaleBf16 {
    static constexpr bool PERM = true;
    bf16_t* O; int ldc; const float* ss; int npn; const float* lsb0; const float* lsb1; int ls_col0; const PG8_LAS unsigned* cntp = nullptr;
    __device__ __forceinline__ void operator()(const f32x4 (&acc)[2][2][4][2], const Unit& u, int wr, int wc, int fr, int fq) const {
        const int row0 = u.pm * BM + wr * 64 + fr; const int colt = (u.pn % npn) * BM, col0 = colt + wc * 32 + 8 * fq;
        const bool ls = lsb0 != nullptr && colt >= ls_col0;
        const int vrows = cntp ? (int)cntp[u.e] - u.mt * BM : BM;
        f32x4 bv[2][2];
#pragma unroll
        for (int bj = 0; bj < 2; ++bj)
#pragma unroll
            for (int n = 0; n < 2; ++n) bv[bj][n] = ls ? *(const f32x4*)((colt >= ls_col0 + 256 ? lsb1 : lsb0) + wc * 32 + 8 * fq + bj * HALF + 4 * n) : (f32x4){0.f, 0.f, 0.f, 0.f};
#pragma unroll
        for (int ai = 0; ai < 2; ++ai)
#pragma unroll
            for (int m = 0; m < 4; ++m) { const int row = row0 + ai * HALF + m * 16; const float sc = ss ? rs_of(ss[row]) : 1.0f; bf16_t* rowp = O + (size_t)row * ldc + col0;
#pragma unroll
                for (int bj = 0; bj < 2; ++bj) { f32x4 v0 = acc[ai][bj][m][0] * sc, v1 = acc[ai][bj][m][1] * sc;
                    if (ls) {
#pragma unroll
                        for (int i = 0; i < 4; ++i) { const float z0 = v0[i] + bv[bj][0][i], z1 = v1[i] + bv[bj][1][i];
                            v0[i] = (fminf(z0, 0.f) - __logf(1.0f + __expf(-fabsf(z0)))) * 0.0625f; v1[i] = (fminf(z1, 0.f) - __logf(1.0f + __expf(-fabsf(z1)))) * 0.0625f; } }
                    u32x4 w; w.x = cvt_pk_bf16(v0[0], v0[1]); w.y = cvt_pk_bf16(v0[2], v0[3]); w.z = cvt_pk_bf16(v1[0], v1[1]); w.w = cvt_pk_bf16(v1[2], v1[3]);
                    if (row - u.pm * BM < vrows) *(u32x4*)(rowp + bj * HALF) = w; } }
    }
};
struct EpiInProj0 {
    static constexpr bool PERM = true;
    bf16_t* O; const float* ss; const float* lsb0; const float* lsb1;
    __device__ __forceinline__ void operator()(const f32x4 (&acc)[2][2][4][2], const Unit& u, int wr, int wc, int fr, int fq) const {
        const int row0 = u.pm * BM + wr * 64 + fr, tile = u.pn;
        if (tile >= 2 && tile < 6) { const int col0 = 512 + (tile - 2) * 128 + wc * 32 + 8 * fq;
#pragma unroll
            for (int ai = 0; ai < 2; ++ai)
#pragma unroll
                for (int m = 0; m < 4; ++m) { const int row = row0 + ai * HALF + m * 16; const float sc = rs_of(ss[row]), s2 = sc * sc;
                    const f32x4 v0 = acc[ai][0][m][0] * acc[ai][1][m][0] * s2, v1 = acc[ai][0][m][1] * acc[ai][1][m][1] * s2;
                    u32x4 w; w.x = cvt_pk_bf16(v0[0], v0[1]); w.y = cvt_pk_bf16(v0[2], v0[3]); w.z = cvt_pk_bf16(v1[0], v1[1]); w.w = cvt_pk_bf16(v1[2], v1[3]);
                    *(u32x4*)(O + (size_t)row * 3072 + col0) = w; }
            return; }
        const int colt = tile < 2 ? tile * BM : (tile - 2) * BM, col0 = colt + wc * 32 + 8 * fq; const bool ls = tile >= 12;
        f32x4 bv[2][2];
#pragma unroll
        for (int bj = 0; bj < 2; ++bj)
#pragma unroll
            for (int n = 0; n < 2; ++n) bv[bj][n] = ls ? *(const f32x4*)((tile == 13 ? lsb1 : lsb0) + wc * 32 + 8 * fq + bj * HALF + 4 * n) : (f32x4){0.f, 0.f, 0.f, 0.f};
#pragma unroll
        for (int ai = 0; ai < 2; ++ai)
#pragma unroll
            for (int m = 0; m < 4; ++m) { const int row = row0 + ai * HALF + m * 16; const float sc = rs_of(ss[row]); bf16_t* rowp = O + (size_t)row * 3072 + col0;
#pragma unroll
                for (int bj = 0; bj < 2; ++bj) { f32x4 v0 = acc[ai][bj][m][0] * sc, v1 = acc[ai][bj][m][1] * sc;
                    if (ls) {
#pragma unroll
                        for (int i = 0; i < 4; ++i) { const float z0 = v0[i] + bv[bj][0][i], z1 = v1[i] + bv[bj][1][i];
                            v0[i] = (fminf(z0, 0.f) - __logf(1.0f + __expf(-fabsf(z0)))) * 0.0625f; v1[i] = (fminf(z1, 0.f) - __logf(1.0f + __expf(-fabsf(z1)))) * 0.0625f; } }
                    u32x4 w; w.x = cvt_pk_bf16(v0[0], v0[1]); w.y = cvt_pk_bf16(v0[2], v0[3]); w.z = cvt_pk_bf16(v1[0], v1[1]); w.w = cvt_pk_bf16(v1[2], v1[3]);
                    *(u32x4*)(rowp + bj * HALF) = w; } }
    }
};
template <bool RESBF> struct EpiResBf16 {
    static constexpr bool PERM = true;
    const float* resA; const float* resB; int rmask; bf16_t* out; const bf16_t* resb;
    __device__ __forceinline__ void operator()(const f32x4 (&acc)[2][2][4][2], const Unit& u, int wr, int wc, int fr, int fq) const {
        const int row0 = u.pm * BM + wr * 64 + fr, col0 = u.pn * BM + wc * 32 + 8 * fq;
#pragma unroll
        for (int ai = 0; ai < 2; ++ai)
#pragma unroll
            for (int m = 0; m < 4; ++m) { const int row = row0 + ai * HALF + m * 16; bf16_t* op = out + (size_t)row * D + col0;
#pragma unroll
                for (int bj = 0; bj < 2; ++bj) { f32x4 r0, r1;
                    if (RESBF) { const u32x4 rw = *(const u32x4*)(resb + (size_t)row * D + col0 + bj * HALF);
                        r0 = (f32x4){__uint_as_float(rw.x << 16), __uint_as_float(rw.x & 0xffff0000u), __uint_as_float(rw.y << 16), __uint_as_float(rw.y & 0xffff0000u)};
                        r1 = (f32x4){__uint_as_float(rw.z << 16), __uint_as_float(rw.z & 0xffff0000u), __uint_as_float(rw.w << 16), __uint_as_float(rw.w & 0xffff0000u)};
                    } else { const float* rp = (row < MR ? resA + (size_t)row * D : resB + (size_t)((row - MR) & rmask) * D) + col0 + bj * HALF; r0 = *(const f32x4*)rp; r1 = *(const f32x4*)(rp + 4); }
                    const f32x4 v0 = acc[ai][bj][m][0] + r0, v1 = acc[ai][bj][m][1] + r1;
                    u32x4 w; w.x = cvt_pk_bf16(v0[0], v0[1]); w.y = cvt_pk_bf16(v0[2], v0[3]); w.z = cvt_pk_bf16(v1[0], v1[1]); w.w = cvt_pk_bf16(v1[2], v1[3]);
                    *(u32x4*)(op + bj * HALF) = w; } }
    }
};
struct EpiQKV {
    static constexpr bool PERM = true;
    bf16_t* O; const float* ss; const float* qn; const float* kn; const PG8_LAS float* rope; float c2;
    __device__ __forceinline__ void operator()(const f32x4 (&acc)[2][2][4][2], const Unit& u, int wr, int wc, int fr, int fq) const {
        const int row0 = u.pm * BM + wr * 64 + fr, tile = u.pn;
        if (tile == 5) { const int col0 = tile * BM + wc * 32 + 8 * fq;
#pragma unroll
            for (int ai = 0; ai < 2; ++ai)
#pragma unroll
                for (int m = 0; m < 4; ++m) { const int row = row0 + ai * HALF + m * 16; const float sc = rs_of(ss[row]); bf16_t* rowp = O + (size_t)row * 1536 + col0;
#pragma unroll
                    for (int bj = 0; bj < 2; ++bj) { const f32x4 v0 = acc[ai][bj][m][0] * sc, v1 = acc[ai][bj][m][1] * sc;
                        u32x4 w; w.x = cvt_pk_bf16(v0[0], v0[1]); w.y = cvt_pk_bf16(v0[2], v0[3]); w.z = cvt_pk_bf16(v1[0], v1[1]); w.w = cvt_pk_bf16(v1[2], v1[3]);
                        *(u32x4*)(rowp + bj * HALF) = w; } }
            return; }
        const float* nw = (tile < 4 ? qn : kn) + 8 * fq; const float hs = tile < 4 ? c2 : 1.0f;
        f32x4 g[2][2];
#pragma unroll
        for (int bj = 0; bj < 2; ++bj)
#pragma unroll
            for (int n = 0; n < 2; ++n) g[bj][n] = *(const f32x4*)(nw + bj * 32 + 4 * n);
#pragma unroll
        for (int ai = 0; ai < 2; ++ai)
#pragma unroll
            for (int m = 0; m < 4; ++m) { const int row = row0 + ai * HALF + m * 16; const float sc = rs_of(ss[row]);
                f32x4 v[2][2]; float s2 = 0.f;
#pragma unroll
                for (int bj = 0; bj < 2; ++bj)
#pragma unroll
                    for (int n = 0; n < 2; ++n) { v[bj][n] = acc[ai][bj][m][n] * sc; s2 += (v[bj][n][0] * v[bj][n][0] + v[bj][n][1] * v[bj][n][1]) + (v[bj][n][2] * v[bj][n][2] + v[bj][n][3] * v[bj][n][3]); }
                s2 += __shfl_xor(s2, 16); s2 += __shfl_xor(s2, 32);
                const float rs = rsqrtf(s2 * (1.0f / 64.0f) + 1e-6f) * hs; const bool rot = row < MR; const int sp = row & 2047;
                bf16_t* rowp = O + (size_t)row * 1536 + tile * BM + wc * 64 + 8 * fq;
#pragma unroll
                for (int bj = 0; bj < 2; ++bj) { const int pos = bj ? (sp & 63) : (sp >> 6); unsigned ow[4];
#pragma unroll
                    for (int n = 0; n < 2; ++n) { f32x4 cs = (f32x4){1.f, 0.f, 1.f, 0.f}; if (rot) cs = *(const PG8_LAS f32x4*)(rope + (pos * 16 + 4 * fq + 2 * n) * 2);
                        const f32x4 a = v[bj][n] * rs * g[bj][n];
                        ow[2 * n] = cvt_pk_bf16(a[0] * cs[0] - a[1] * cs[1], a[0] * cs[1] + a[1] * cs[0]); ow[2 * n + 1] = cvt_pk_bf16(a[2] * cs[2] - a[3] * cs[3], a[2] * cs[3] + a[3] * cs[2]); }
                    *(u32x4*)(rowp + bj * 32) = (u32x4){ow[0], ow[1], ow[2], ow[3]}; } }
    }
};
}
namespace attn_body {
using bf16=__hip_bfloat16;
using bf16x8=__attribute__((ext_vector_type(8)))short;
using s16x4=__attribute__((ext_vector_type(4)))short;
using f32x16=__attribute__((ext_vector_type(16)))float;
using u32x4=__attribute__((ext_vector_type(4)))unsigned;
constexpr int BATCH=8,NHEAD=16,SEQ=2048,D=64,DM=1536,DMO=1024;
constexpr int KCOL=1024,VCOL=1280,META0=BATCH*SEQ;
constexpr int NW=8,QBLK=32,QB=QBLK*NW,KVBLK=64,NQB=SEQ/QB;
constexpr int ATTN_UNIT_ROWS=QB; constexpr int NTILES=33;
__device__ __forceinline__ int crow(int r,int hi){return (r&3)+8*(r>>2)+4*hi;}
#define SBAR() __builtin_amdgcn_sched_barrier(0)
__device__ __forceinline__ void cmask(f32x16&p0,f32x16&p1,int jb,int qrel,int hi){
  const float NEG=-INFINITY; int kb=64*jb+4*hi;
  #pragma unroll
  for(int r=0;r<16;++r){int kv=kb+(r&3)+8*(r>>2); if(kv>qrel)p0[r]=NEG; if(kv+32>qrel)p1[r]=NEG;}
}

__device__ __forceinline__ void kvmask(f32x16&p0,f32x16&p1,int limit,int hi){
  const float NEG=-INFINITY; const int kb=4*hi;
  #pragma unroll
  for(int r=0;r<16;++r){int kv=kb+(r&3)+8*(r>>2); if(kv>=limit)p0[r]=NEG; if(kv+32>=limit)p1[r]=NEG;}
}
constexpr int NSLOT=3, SLOTB=8192;
constexpr int LDS_K=0, LDS_V=NSLOT*SLOTB, LDS_WS=2*NSLOT*SLOTB, LDS_OST=LDS_WS+NW*64*4, LDS_BYTES=LDS_OST+NW*4096;
constexpr float C2=0.125f*1.4426950408889634f;
__device__ __forceinline__ void glds16(const void*gsrc,unsigned lds_dst){unsigned keep;
  asm volatile("s_mov_b32 %0, m0\n\ts_mov_b32 m0, %2\n\ts_nop 0\n\tglobal_load_lds_dwordx4 %1, off\n\ts_mov_b32 m0, %0":"=&s"(keep):"v"(gsrc),"s"(lds_dst):"memory");}
__device__ __forceinline__ float max3f(float a,float b,float c){float r;asm("v_max3_f32 %0, %1, %2, %3":"=v"(r):"v"(a),"v"(b),"v"(c));return r;}
__device__ __forceinline__ float max2f(float a,float b){float r;asm("v_max_f32_e32 %0, %1, %2":"=v"(r):"v"(a),"v"(b));return r;}
__device__ __forceinline__ float fadd_s(float a,float b){float r;asm("v_add_f32_e32 %0, %1, %2":"=v"(r):"v"(a),"v"(b));return r;}
__device__ __forceinline__ float fsub_s(float a,float b){float r;asm("v_sub_f32_e32 %0, %1, %2":"=v"(r):"v"(a),"v"(b));return r;}
typedef float f32x2_t __attribute__((ext_vector_type(2))); typedef __bf16 bf16x2_t __attribute__((ext_vector_type(2)));
__device__ __forceinline__ unsigned cvtpk_s(float lo,float hi){f32x2_t v={lo,hi};bf16x2_t b=__builtin_convertvector(v,bf16x2_t);return __builtin_bit_cast(unsigned,b);}
#define WAIT_BAR(N) asm volatile("s_waitcnt vmcnt(" #N ") lgkmcnt(0)\n\ts_barrier":::"memory")

__device__ __forceinline__ void qkt(f32x16&p0,f32x16&p1,const char*Kslot,const bf16x8*qr,const f32x16&negm,int r32,int hi){
  const char*kb=Kslot+hi*1024+r32*16;
  #pragma unroll
  for(int d0=0;d0<4;++d0){
    const bf16x8 b0=*reinterpret_cast<const bf16x8*>(kb+d0*2048);
    const bf16x8 b1=*reinterpret_cast<const bf16x8*>(kb+d0*2048+512);
    if(d0==0){p0=__builtin_amdgcn_mfma_f32_32x32x16_bf16(b0,qr[0],negm,0,0,0);p1=__builtin_amdgcn_mfma_f32_32x32x16_bf16(b1,qr[0],negm,0,0,0);}
    else{p0=__builtin_amdgcn_mfma_f32_32x32x16_bf16(b0,qr[d0],p0,0,0,0);p1=__builtin_amdgcn_mfma_f32_32x32x16_bf16(b1,qr[d0],p1,0,0,0);}}
}
typedef __attribute__((address_space(3))) const char* lds_cptr;
typedef short v4i16_t __attribute__((ext_vector_type(4)));
__device__ __forceinline__ void kload8(bf16x8*kf,lds_cptr kp){
  kf[0]=*(const __attribute__((address_space(3))) bf16x8*)(kp);      kf[1]=*(const __attribute__((address_space(3))) bf16x8*)(kp+512);
  kf[2]=*(const __attribute__((address_space(3))) bf16x8*)(kp+2048); kf[3]=*(const __attribute__((address_space(3))) bf16x8*)(kp+2560);
  kf[4]=*(const __attribute__((address_space(3))) bf16x8*)(kp+4096); kf[5]=*(const __attribute__((address_space(3))) bf16x8*)(kp+4608);
  kf[6]=*(const __attribute__((address_space(3))) bf16x8*)(kp+6144); kf[7]=*(const __attribute__((address_space(3))) bf16x8*)(kp+6656);
}
__device__ __forceinline__ void kload2(bf16x8*kf,lds_cptr kp,int j){ kf[2*j]=*(const __attribute__((address_space(3))) bf16x8*)(kp+j*2048); kf[2*j+1]=*(const __attribute__((address_space(3))) bf16x8*)(kp+j*2048+512); }
__device__ __forceinline__ s16x4 vtr(lds_cptr p){ return __builtin_bit_cast(s16x4,__builtin_amdgcn_ds_read_tr16_b64_v4i16((__attribute__((address_space(3))) v4i16_t*)p)); }
__device__ __forceinline__ float rowmax(const f32x16&p0,const f32x16&p1){
  float a=max3f(p0[0],p0[1],p1[0]),b=max3f(p0[2],p0[3],p1[1]);a=max3f(a,p1[2],p1[3]);
  #pragma unroll
  for(int r=4;r<16;r+=4){a=max3f(a,p0[r],p0[r+1]);b=max3f(b,p0[r+2],p0[r+3]);a=max3f(a,p1[r],p1[r+1]);b=max3f(b,p1[r+2],p1[r+3]);}
  const float m=max2f(a,b);
  auto rr=__builtin_amdgcn_permlane32_swap(__float_as_uint(m),__float_as_uint(m),false,false);
  return max2f(__uint_as_float(rr[0]),__uint_as_float(rr[1]));
}
__device__ __forceinline__ void pv(f32x16*o,int vb,bf16x8 pa0,bf16x8 pa1,bf16x8 pa2,bf16x8 pa3){
  #pragma unroll
  for(int d0=0;d0<2;++d0){s16x4 lo[4],hi[4];
    #pragma unroll
    for(int ks=0;ks<4;++ks){
      asm volatile("ds_read_b64_tr_b16 %0,%1 offset:%c2":"=&v"(lo[ks]):"v"(vb),"i"(d0*4096+ks*1024):"memory");
      asm volatile("ds_read_b64_tr_b16 %0,%1 offset:%c2":"=&v"(hi[ks]):"v"(vb),"i"(d0*4096+ks*1024+512):"memory");}
    asm volatile("s_waitcnt lgkmcnt(0)":::"memory");SBAR();
    #define PK(k) (bf16x8){lo[k][0],lo[k][1],lo[k][2],lo[k][3],hi[k][0],hi[k][1],hi[k][2],hi[k][3]}
    o[d0]=__builtin_amdgcn_mfma_f32_32x32x16_bf16(pa0,PK(0),o[d0],0,0,0);
    o[d0]=__builtin_amdgcn_mfma_f32_32x32x16_bf16(pa1,PK(1),o[d0],0,0,0);
    o[d0]=__builtin_amdgcn_mfma_f32_32x32x16_bf16(pa2,PK(2),o[d0],0,0,0);
    o[d0]=__builtin_amdgcn_mfma_f32_32x32x16_bf16(pa3,PK(3),o[d0],0,0,0);
    #undef PK
  }
}

#ifndef ATTN_STORE16
#define ATTN_STORE16(p,v) (*(u32x4*)(p)=(v))
#endif
template<int THRL> __device__ __forceinline__ void attn_unit(int b,int h,int qb,const bf16*Q,const bf16*__restrict__ K,const bf16*__restrict__ V,bf16*O,char*shm){
  const int tid=threadIdx.x,lane=tid&63,r32=lane&31,hi=lane>>5; const int wid=__builtin_amdgcn_readfirstlane(tid>>6);
  const long rowbase=(long)b*SEQ; const int q0=qb*QB; const int kvh=h>>2;
  const bf16*Qw=Q+(rowbase+q0+wid*QBLK)*DM+h*D;
  const bf16*Kh=K+KCOL+kvh*D,*Vh=K+VCOL+kvh*D; (void)V;
  #define TROW(t) ((long)(((t)==0)?(META0+b*16):(rowbase+((t)-1)*KVBLK)))
  const unsigned lds0=(unsigned)(uintptr_t)shm;
  float*wsf=(float*)(shm+LDS_WS)+wid*64;
  const bf16*ksrc=Kh+(long)lane*DM+wid*8;
  const bf16*vsrc=Vh+(long)(16*(wid&3)+(lane>>2))*DM+(wid>>2)*32+(lane&3)*8;
  const unsigned kdst=lds0+LDS_K+wid*1024, vdst=lds0+LDS_V+wid*1024;
  #define DMA_K(t,slot) glds16(ksrc+TROW(t)*DM,(unsigned)__builtin_amdgcn_readfirstlane(kdst+(slot)))
  #define DMA_V(t,slot) glds16(vsrc+TROW(t)*DM,(unsigned)__builtin_amdgcn_readfirstlane(vdst+(slot)))
  const int vb0=(int)(lds0+LDS_V)+((lane>>4)&1)*32+(lane&3)*8+(4*hi+((lane&15)>>2))*64;
  const char*Kbase=shm+LDS_K; bf16x8 kf[8];
  const lds_cptr shm3=(lds_cptr)shm; const lds_cptr kp0=shm3+LDS_K+hi*1024+r32*16; const lds_cptr vp0=shm3+LDS_V+((lane>>4)&1)*32+(lane&3)*8+(4*hi+((lane&15)>>2))*64;
  const int NT=NTILES;
  DMA_K(0,0);DMA_V(0,0);DMA_K(1,SLOTB);
  bf16x8 qr[4];
  #pragma unroll
  for(int d0=0;d0<4;++d0)qr[d0]=*reinterpret_cast<const bf16x8*>(&Qw[(long)r32*DM+d0*16+hi*8]);
  float mhat=0.f,l_reg=0.f;f32x16 o[2];o[0]=f32x16{};o[1]=f32x16{};f32x16 negm=f32x16{};asm volatile("":"+v"(negm));
  #define CMASK(P0,P1,t) do{ if((t)==0)kvmask(P0,P1,16,hi); }while(0)
  bool resc=false;
  #define START(P0,P1) do{ const float rm=rowmax(P0,P1); resc=false; \
    { const float dl=rm; mhat=fadd_s(mhat,dl); \
      _Pragma("unroll") for(int r=0;r<16;++r){P0[r]=fsub_s(P0[r],dl);P1[r]=fsub_s(P1[r],dl);} \
      _Pragma("unroll") for(int r=0;r<16;++r)negm[r]=-mhat; asm volatile("":"+v"(negm)); } \
    _Pragma("unroll") for(int r=0;r<16;++r)P0[r]=__builtin_amdgcn_exp2f(P0[r]); }while(0)
  #define RESC() do{ if(resc){ asm volatile("s_waitcnt lgkmcnt(0)":::"memory"); \
      _Pragma("unroll") for(int d_=0;d_<2;++d_) _Pragma("unroll") for(int r=0;r<16;++r)o[d_][r]*=wsf[crow(r,hi)]; } }while(0)
  f32x16 pA0,pA1,pB0,pB1;
  int sl_prev=0,sl_cur=0,sl_next=SLOTB;
  #define ROT() do{sl_prev=sl_cur;sl_cur=sl_next;sl_next=(sl_next==(NSLOT-1)*SLOTB)?0:sl_next+SLOTB;}while(0)
  DMA_K(2,2*SLOTB);
  WAIT_BAR(3);
  qkt(pA0,pA1,Kbase,qr,negm,r32,hi);asm volatile("s_nop 15\n\ts_nop 7":"+v"(pA0),"+v"(pA1));CMASK(pA0,pA1,0);
  START(pA0,pA1);
  _Pragma("unroll") for(int r=0;r<16;++r)pA1[r]=__builtin_amdgcn_exp2f(pA1[r]);
  WAIT_BAR(0);
  DMA_K(3,0);DMA_V(1,SLOTB);
  ROT();
  kload8(kf,kp0+sl_cur);
  WAIT_BAR(2);
  s16x4 vlo[8],vhi[8]; u32x4 pw0,pw1,pw2,pw3;
  #define PKW(P,B) cvtpk_s(P[B],P[B+1])
  #define PAF(k) __builtin_bit_cast(bf16x8,pw##k)
  #define VFR(i) (bf16x8){vlo[i][0],vlo[i][1],vlo[i][2],vlo[i][3],vhi[i][0],vhi[i][1],vhi[i][2],vhi[i][3]}
  #define PIN(x) asm volatile("":"+v"(x))
  #define MX3(a,b,c) __builtin_fmaxf(__builtin_fmaxf((a),(b)),(c))
  #define GAPA(MF,A0,A1,A2,A3,W0,W1,PW) do{ MF; sacc+=A0; sacc+=A1; sacc+=A2; sacc+=A3; PIN(sacc); W0; W1; PIN(PW); SBAR(); }while(0)
  #define EX(v) __builtin_amdgcn_exp2f(v)
  #define GAPB(MF,X,B) do{ MF; X[B]=EX(X[B]); X[B+1]=EX(X[B+1]); X[B+2]=EX(X[B+2]); X[B+3]=EX(X[B+3]); PIN(X); SBAR(); }while(0)
  #define VRD(i) do{ vlo[i]=vtr(vp_+(((i)>>2)*4096+((i)&3)*1024)); vhi[i]=vtr(vp_+(((i)>>2)*4096+((i)&3)*1024+512)); }while(0)
  #define KRD(G,j) do{ if(G){ kload2(kf,kp0+sl_next,j); SBAR(); } }while(0)
  #define STEP(C0,C1,P0,P1,t,GK,GV,GL) do{ SBAR(); \
    const lds_cptr vp_=vp0+sl_prev; \
    VRD(0); SBAR(); float sacc=(P0[0]+P0[1]); \
    GAPA(C0=__builtin_amdgcn_mfma_f32_32x32x16_bf16(kf[0],qr[0],negm,0,0,0), P0[2],P0[3],P0[4],P0[5],     pw0[0]=PKW(P0,0), pw0[1]=PKW(P0,2), pw0); \
    VRD(4); SBAR(); GAPA(C1=__builtin_amdgcn_mfma_f32_32x32x16_bf16(kf[1],qr[0],negm,0,0,0), P0[6],P0[7],P0[8],P0[9],     pw0[2]=PKW(P0,4), pw0[3]=PKW(P0,6), pw0); \
    VRD(1); SBAR(); GAPA(C0=__builtin_amdgcn_mfma_f32_32x32x16_bf16(kf[2],qr[1],C0,0,0,0),   P0[10],P0[11],P0[12],P0[13], pw1[0]=PKW(P0,8), pw1[1]=PKW(P0,10), pw1); \
    VRD(5); SBAR(); GAPA(C1=__builtin_amdgcn_mfma_f32_32x32x16_bf16(kf[3],qr[1],C1,0,0,0),   P0[14],P0[15],P1[0],P1[1],   pw1[2]=PKW(P0,12),pw1[3]=PKW(P0,14), pw1); \
    VRD(2); SBAR(); GAPA(C0=__builtin_amdgcn_mfma_f32_32x32x16_bf16(kf[4],qr[2],C0,0,0,0),   P1[2],P1[3],P1[4],P1[5],     pw2[0]=PKW(P1,0), pw2[1]=PKW(P1,2), pw2); \
    VRD(6); SBAR(); GAPA(C1=__builtin_amdgcn_mfma_f32_32x32x16_bf16(kf[5],qr[2],C1,0,0,0),   P1[6],P1[7],P1[8],P1[9],     pw2[2]=PKW(P1,4), pw2[3]=PKW(P1,6), pw2); \
    VRD(3); SBAR(); GAPA(C0=__builtin_amdgcn_mfma_f32_32x32x16_bf16(kf[6],qr[3],C0,0,0,0),   P1[10],P1[11],P1[12],P1[13], pw3[0]=PKW(P1,8), pw3[1]=PKW(P1,10), pw3); \
    VRD(7); SBAR(); GAPA(C1=__builtin_amdgcn_mfma_f32_32x32x16_bf16(kf[7],qr[3],C1,0,0,0),   P1[14],P1[15],0.f,0.f,       pw3[2]=PKW(P1,12),pw3[3]=PKW(P1,14), pw3); \
    l_reg+=sacc; \
    if(GK){DMA_K((t)+3,sl_cur);} if(GV){DMA_V((t)+1,sl_next);} \
    CMASK(C0,C1,t); \
    { float a=MX3(C0[0],C0[1],C1[0]),b=MX3(C0[2],C0[3],C1[1]); a=MX3(a,C1[2],C1[3]); \
      _Pragma("unroll") for(int r=4;r<16;r+=4){a=MX3(a,C0[r],C0[r+1]);b=MX3(b,C0[r+2],C0[r+3]);a=MX3(a,C1[r],C1[r+1]);b=MX3(b,C1[r+2],C1[r+3]);} \
      float rm=__builtin_fmaxf(a,b); { auto rr=__builtin_amdgcn_permlane32_swap(__float_as_uint(rm),__float_as_uint(rm),false,false); rm=__builtin_fmaxf(__uint_as_float(rr[0]),__uint_as_float(rr[1])); } \
      resc=false; \
      if(__builtin_expect(__any(rm>(float)THRL),0)){ const float dl=__builtin_fmaxf(rm,0.f); mhat+=dl; \
        _Pragma("unroll") for(int r=0;r<16;++r){C0[r]-=dl;C1[r]-=dl;} \
        _Pragma("unroll") for(int r=0;r<16;++r)negm[r]=-mhat; asm volatile("":"+v"(negm)); \
        const float f=__builtin_amdgcn_exp2f(-dl); l_reg*=f; if(hi==0)wsf[r32]=f; resc=true; } } \
    SBAR(); \
    GAPB(o[0]=__builtin_amdgcn_mfma_f32_32x32x16_bf16(PAF(0),VFR(0),o[0],0,0,0), C0,0); \
    GAPB(o[1]=__builtin_amdgcn_mfma_f32_32x32x16_bf16(PAF(0),VFR(4),o[1],0,0,0), C0,4); \
    KRD(GL,0); GAPB(o[0]=__builtin_amdgcn_mfma_f32_32x32x16_bf16(PAF(1),VFR(1),o[0],0,0,0), C0,8); \
    KRD(GL,1); GAPB(o[1]=__builtin_amdgcn_mfma_f32_32x32x16_bf16(PAF(1),VFR(5),o[1],0,0,0), C0,12); \
    KRD(GL,2); GAPB(o[0]=__builtin_amdgcn_mfma_f32_32x32x16_bf16(PAF(2),VFR(2),o[0],0,0,0), C1,0); \
    KRD(GL,3); GAPB(o[1]=__builtin_amdgcn_mfma_f32_32x32x16_bf16(PAF(2),VFR(6),o[1],0,0,0), C1,4); \
    GAPB(o[0]=__builtin_amdgcn_mfma_f32_32x32x16_bf16(PAF(3),VFR(3),o[0],0,0,0), C1,8); \
    GAPB(o[1]=__builtin_amdgcn_mfma_f32_32x32x16_bf16(PAF(3),VFR(7),o[1],0,0,0), C1,12); \
    }while(0)
  int t=1;
  #undef CMASK
  #define CMASK(P0,P1,t) do{}while(0)
  for(;t+5<NT;t+=2){
    STEP(pB0,pB1,pA0,pA1,t,true,true,true);     WAIT_BAR(2); RESC(); ROT();
    STEP(pA0,pA1,pB0,pB1,t+1,true,true,true);   WAIT_BAR(2); RESC(); ROT();
  }
  #undef CMASK
  #define CMASK(P0,P1,t) do{}while(0)
  #define ENDW(tt) do{ if((tt)+3<NT){WAIT_BAR(2);} else if((tt)+2<NT){WAIT_BAR(1);} else {WAIT_BAR(0);} }while(0)
  for(;t+1<NT;t+=2){
    STEP(pB0,pB1,pA0,pA1,t,(t+3<NT),(t+1<NT),(t+1<NT));       ENDW(t);   RESC(); ROT();
    STEP(pA0,pA1,pB0,pB1,t+1,(t+4<NT),(t+2<NT),(t+2<NT));     ENDW(t+1); RESC(); ROT();
  }
  static_assert(NTILES%2==1,"odd tile count: the last pair of steps ends with tile NT-1 in buffer A");
  { float sacc=pA0[0]+pA0[1]; _Pragma("unroll") for(int r=2;r<16;++r)sacc+=pA0[r]; _Pragma("unroll") for(int r=0;r<16;++r)sacc+=pA1[r]; l_reg+=sacc;
    pw0=(u32x4){PKW(pA0,0),PKW(pA0,2),PKW(pA0,4),PKW(pA0,6)};pw1=(u32x4){PKW(pA0,8),PKW(pA0,10),PKW(pA0,12),PKW(pA0,14)};pw2=(u32x4){PKW(pA1,0),PKW(pA1,2),PKW(pA1,4),PKW(pA1,6)};pw3=(u32x4){PKW(pA1,8),PKW(pA1,10),PKW(pA1,12),PKW(pA1,14)};
    SBAR(); pv(o,vb0+sl_prev,PAF(0),PAF(1),PAF(2),PAF(3)); }
  #undef PKW
  #undef PAF
  #undef VFR
  #undef PIN
  #undef MX3
  #undef GAPA
  #undef GAPB
  #undef EX
  #undef VRD
  #undef KRD
  #undef STEP
  #undef ENDW
  {auto rr=__builtin_amdgcn_permlane32_swap(__float_as_uint(l_reg),__float_as_uint(l_reg),false,false);l_reg=__uint_as_float(rr[0])+__uint_as_float(rr[1]);}
  if(hi==0)wsf[32+r32]=l_reg;asm volatile("s_waitcnt lgkmcnt(0)":::"memory");
  float rli[16];
  #pragma unroll
  for(int r=0;r<16;++r)rli[r]=__builtin_amdgcn_rcpf(wsf[32+crow(r,hi)]);
  bf16*Ow=O+(rowbase+q0+wid*QBLK)*DMO+h*D;
  { bf16*stg=(bf16*)(shm+LDS_OST)+wid*2048;
    #pragma unroll
    for(int r=0;r<16;++r){const int orow=crow(r,hi);
      #pragma unroll
      for(int d0=0;d0<2;++d0)stg[orow*64+d0*32+r32]=__float2bfloat16(o[d0][r]*rli[r]);}
    asm volatile("s_waitcnt lgkmcnt(0)":::"memory");
    #pragma unroll
    for(int i=0;i<4;++i){const int row=i*8+(lane>>3),ch=lane&7; const u32x4 v=*(const u32x4*)(stg+row*64+ch*8); ATTN_STORE16(Ow+(long)row*DMO+ch*8,v);} }
  asm volatile("s_waitcnt lgkmcnt(0)\n\ts_barrier":::"memory");
  #undef DMA_K
  #undef DMA_V
  #undef TROW
  #undef CMASK
  #undef START
  #undef RESC
  #undef ROT
}
constexpr int ATTN_LDS_BYTES=LDS_BYTES;
struct AttnTensors { const bf16* Q; const bf16* K; const bf16* V; bf16* O; };
struct AttnUnit { int bh; int qb; };
struct StaticOrder {
  int vcu,rep,G;
  __device__ __forceinline__ explicit StaticOrder(int v,int r,int g):vcu(v),rep(r),G(g){}
  __device__ __forceinline__ bool next(int i,AttnUnit&u)const{
    if(G==256){ if(i>=4*rep)return false; u.bh=vcu>>1; u.qb=(vcu&1)*4+(i&3); return true; }
    const int L=vcu+i*G; if(L>=BATCH*NHEAD*8)return false; u.bh=L>>3; u.qb=L&7; return true; }
  __device__ __forceinline__ void a_ready(const AttnUnit&)const{}
  __device__ __forceinline__ void done(const AttnUnit&)const{}
};
template<class Sched,int THRL=8> __device__ __forceinline__ void attn_phase(char*lds,const AttnTensors&T,const Sched&S){
  AttnUnit u;
  for(int i=0;S.next(i,u);++i){ S.a_ready(u); attn_unit<THRL>(u.bh/NHEAD,u.bh%NHEAD,u.qb,T.Q,T.K,T.V,T.O,lds); S.done(u); }
}
#undef SBAR
#undef WAIT_BAR
}
#define GAS __attribute__((address_space(1)))
#define LAS __attribute__((address_space(3)))
typedef unsigned v4u __attribute__((ext_vector_type(4)));
typedef float f32x4 __attribute__((ext_vector_type(4)));
typedef short bf16x8 __attribute__((ext_vector_type(8)));
typedef GAS unsigned gu32;
typedef GAS unsigned long long gu64;
#define RLX_AGENT __ATOMIC_RELAXED, __HIP_MEMORY_SCOPE_AGENT
#define LDS_WAIT() asm volatile("s_waitcnt lgkmcnt(0)" ::: "memory")
#define VM_WAIT() asm volatile("s_waitcnt vmcnt(0)" ::: "memory")
__device__ __forceinline__ unsigned long long rt() { return __builtin_amdgcn_s_memrealtime(); }
typedef float f32x2_cv __attribute__((ext_vector_type(2))); typedef __bf16 bf16x2_cv __attribute__((ext_vector_type(2)));
__device__ __forceinline__ unsigned pk2(float lo, float hi) { const f32x2_cv v = {lo, hi}; return __builtin_bit_cast(unsigned, __builtin_convertvector(v, bf16x2_cv)); }
__device__ __forceinline__ unsigned f2bf(float f) { return pk2(f, f) & 0xffffu; }

#define XB_TMO      128
#define XB_XCNT(j)  (256  + 64 * (j))
#define XB_XSUB(j)  (1280 + 64 * (j))
#define XB_XGEN(j)  (2304 + 64 * (j))
#define XB_TOP      3328
#define XB_TOPGEN   3392
#define XCD_BAR_WORDS 3456
#define XB_SPIN_CAP (1u << 18)

__device__ __forceinline__ unsigned xb_ld(unsigned* p)              { return __hip_atomic_load(p, __ATOMIC_RELAXED, __HIP_MEMORY_SCOPE_AGENT); }
__device__ __forceinline__ unsigned xb_add(unsigned* p, unsigned v) { return __hip_atomic_fetch_add(p, v, __ATOMIC_RELAXED, __HIP_MEMORY_SCOPE_AGENT); }
__device__ __forceinline__ unsigned xb_xcc_id() { return (unsigned)__builtin_amdgcn_s_getreg((3 << 11) | 20) & 0xFu; }
#define XB_SPIN(cond, bar) do { unsigned _sp = 0; while (cond) { __builtin_amdgcn_s_sleep(1); \
    if ((++_sp & 255u) == 0u) { if (xb_ld(&(bar)[XB_TMO])) break; if (_sp > XB_SPIN_CAP) { atomicAdd(&(bar)[XB_TMO], 1u); break; } } } } while (0)

struct XcdBarrier {
    unsigned* bar; unsigned x;
    volatile LAS unsigned* st;
};

__device__ __forceinline__ XcdBarrier xcd_barrier_post(unsigned* bar, volatile LAS unsigned* st) {
    XcdBarrier b; b.bar = bar; b.x = xb_xcc_id(); b.st = st;
    if (threadIdx.x == 0) (void)xb_add(&bar[XB_XCNT(b.x)], 1u);
    return b;
}
__device__ __forceinline__ void xcd_barrier_complete(unsigned* bar, unsigned x, unsigned& nloc, unsigned& nx) {
    const unsigned G = gridDim.x * gridDim.y * gridDim.z;
    unsigned sum, cnt, mine, sp = 0u;
    for (;;) {
        sum = 0u; cnt = 0u; mine = 0u;
#pragma unroll
        for (unsigned j = 0; j < 16; ++j) { const unsigned c = xb_ld(&bar[XB_XCNT(j)]); sum += c; cnt += (c > 0u) ? 1u : 0u; mine = (j == x) ? c : mine; }
        if (sum == G) break;
        __builtin_amdgcn_s_sleep(1);
        if ((++sp & 255u) == 0u) { if (xb_ld(&bar[XB_TMO])) break; if (sp > XB_SPIN_CAP) { atomicAdd(&bar[XB_TMO], 1u); break; } }
    }
    nloc = mine > 0u ? mine : 1u; nx = cnt > 0u ? cnt : 1u;
}

__device__ __forceinline__ void xcd_barrier(const XcdBarrier& b) {
    asm volatile("s_waitcnt vmcnt(0)" ::: "memory");
    __syncthreads();
    if (threadIdx.x == 0) {
        unsigned* bar = b.bar;
        __builtin_amdgcn_s_waitcnt(0);
        unsigned nloc = b.st[0], nx = b.st[1];
        if (nloc == 0u) { xcd_barrier_complete(bar, b.x, nloc, nx); b.st[0] = nloc; b.st[1] = nx; }
        const unsigned old = xb_add(&bar[XB_XSUB(b.x)], 1u);
        const unsigned gen = old / nloc;
        if (old + 1u == (gen + 1u) * nloc) {
            __builtin_amdgcn_fence(__ATOMIC_RELEASE, "agent");
            asm volatile("s_waitcnt vmcnt(0)" ::: "memory");
            const unsigned og = xb_add(&bar[XB_TOP], 1u);
            const unsigned tg = og / nx;
            if (og + 1u == (tg + 1u) * nx) xb_add(&bar[XB_TOPGEN], 1u);
            else XB_SPIN(xb_ld(&bar[XB_TOPGEN]) == tg, bar);
            __builtin_amdgcn_fence(__ATOMIC_ACQUIRE, "agent");
            xb_add(&bar[XB_XGEN(b.x)], 1u);
            asm volatile("s_waitcnt vmcnt(0)" ::: "memory");
        } else {
            XB_SPIN(xb_ld(&bar[XB_XGEN(b.x)]) == gen, bar);
            __builtin_amdgcn_fence(__ATOMIC_ACQUIRE, "agent");
            asm volatile("s_waitcnt vmcnt(0)" ::: "memory");
        }
    }
    __syncthreads();
}
#define DEVI __device__ __forceinline__
constexpr int NWAVES = 8;
constexpr int RING_OFF = 0, RING_BYTES = 131072;
constexpr int LDSCTL_OFF = RING_BYTES, MISC_OFF = LDSCTL_OFF + 320;
constexpr int LDS_BYTES = 151552;

typedef unsigned v2u __attribute__((ext_vector_type(2)));
typedef float f32x2 __attribute__((ext_vector_type(2)));
DEVI float bf2f(unsigned v) { return __uint_as_float(v << 16); }
DEVI float wave_sum(float v) {
#pragma unroll
    for (int o = 1; o < 64; o <<= 1) v += __shfl_xor(v, o);
    return v;
}
DEVI int tok_row(int b, int t) { return t < NM ? MR + b * NM + t : b * S + (t - NM); }
DEVI float log_sigmoid(float z) { return fminf(z, 0.f) - log1pf(__expf(-fabsf(z))); }

struct Args { const float* in[24]; float* out; unsigned char* ws; int ph_lo, ph_hi; };
struct Frame {
    const __attribute__((address_space(4))) Args* ka;
    LAS unsigned char* lds;
    volatile LAS unsigned* MISC;
    gu32* ctl;
    int tid, lane, wave, vcu, G;
    unsigned char* ws;
    float* out;
};
#define WSP(T, off) ((T*)(F.ws + (off)))

DEVI f32x4 mma_nt(const LAS bf16_t* A, int lda, const LAS bf16_t* B, int ldb, int K, int lane, f32x4 acc) {
    const LAS bf16_t* ap = A + (lane & 15) * lda + 8 * (lane >> 4); const LAS bf16_t* bp = B + (lane & 15) * ldb + 8 * (lane >> 4);
    for (int k0 = 0; k0 < K; k0 += 32) {
        const bf16x8 a = *(const LAS bf16x8*)(ap + k0), b = *(const LAS bf16x8*)(bp + k0);
        acc = __builtin_amdgcn_mfma_f32_16x16x32_bf16(a, b, acc, 0, 0, 0);
    }
    return acc;
}
constexpr int TLD = 72;
DEVI void tr_item(const float* W, int ldw, int nmax, const float* gain, bf16_t* WT, int ldk, int k0, int n0, int dest_row0, LAS bf16_t* Tt, int lane, int dest_row1 = -1) {
    if (dest_row1 < 0) dest_row1 = dest_row0 + 32;
    const int nq = lane & 15, kq = lane >> 4; const bool okc = (n0 + 4 * nq) < nmax;
    f32x4 v[16];
#pragma unroll
    for (int it = 0; it < 16; ++it) v[it] = okc ? *(const GAS f32x4*)(W + (size_t)(k0 + it * 4 + kq) * ldw + n0 + 4 * nq) : (f32x4){0.f, 0.f, 0.f, 0.f};
#pragma unroll
    for (int it = 0; it < 16; ++it) { const int k = it * 4 + kq; const float gsc = gain ? gain[k0 + k] : 1.0f;
#pragma unroll
        for (int i = 0; i < 4; ++i) Tt[(4 * nq + i) * TLD + (k ^ ((nq & 7) << 3))] = (bf16_t)f2bf(v[it][i] * gsc); }
    LDS_WAIT(); asm volatile("" ::: "memory");
    const int c = lane & 7;
#pragma unroll
    for (int j = 0; j < 8; ++j) { const int n = (lane >> 3) + 8 * j;
        if (n0 + n < nmax) *(GAS v4u*)(WT + (size_t)(n < 32 ? dest_row0 + n : dest_row1 + n - 32) * ldk + k0 + 8 * c) = *(const LAS v4u*)(Tt + n * TLD + ((8 * c) ^ (((n >> 2) & 7) << 3))); }
    LDS_WAIT(); asm volatile("" ::: "memory");
}
DEVI void convert_moe(Frame& F, int layer, int lo, int hi, int gw, int NGW) {
    LAS bf16_t* scr = (LAS bf16_t*)(F.lds + RING_OFF + F.wave * 16384);
    const float* Wg = F.ka->in[21] + (size_t)layer * NEXP * D * 256; const float* Wu = F.ka->in[22] + (size_t)layer * NEXP * D * 256; const float* Wd = F.ka->in[23] + (size_t)layer * NEXP * 256 * D;
    const float* gain = F.ka->in[3] + layer * D;
    bf16_t* GU = WSP(bf16_t, layer ? WS_MOEGU1 : WS_MOEGU); bf16_t* DW = WSP(bf16_t, layer ? WS_MOED1 : WS_MOED);
    for (int it = lo + gw; it < hi; it += NGW) {
        const int kind = it >> 11, r = it & 2047, e = r >> 6, q = r & 63;
        if (kind < 2) { const int kb = q >> 2, nb = q & 3, n0 = nb * 64;
            tr_item((kind ? Wu : Wg) + (size_t)e * D * 256, 256, 256, gain, GU, D, kb * 64, n0, e * 512 + (n0 >> 7) * 256 + (n0 & 127) + kind * 128, scr, F.lane);
        } else { const int kb = q >> 4, nb = q & 15;
            tr_item(Wd + (size_t)e * 256 * D, D, D, nullptr, DW, 256, kb * 64, nb * 64, e * 1024 + nb * 64, scr, F.lane); }
    }
}
constexpr int CONV_ITEMS = 3 * 2048, CONV_PER_WG = 24;
DEVI void convert_small_item(Frame& F, int which, int r) {
    LAS bf16_t* scr = (LAS bf16_t*)(F.lds + RING_OFF + F.wave * 16384);
    if (which == 0) { tr_item(F.ka->in[12], D, D, nullptr, WSP(bf16_t, WS_WO0), D, (r / 16) * 64, (r % 16) * 64, (r % 16) * 64, scr, F.lane); }
    else if (which == 1) { const int n0 = (r % 24) * 64, tl = n0 >> 8, hd = (n0 >> 6) & 3;
        tr_item(F.ka->in[13], NA, NA, F.ka->in[2] + D, WSP(bf16_t, WS_WAI), D, (r / 24) * 64, n0, tl < 5 ? tl * 256 + hd * 32 : n0, scr, F.lane, tl < 5 ? tl * 256 + 128 + hd * 32 : n0 + 32); }
    else { tr_item(F.ka->in[16], D, D, nullptr, WSP(bf16_t, WS_WAO), D, (r / 16) * 64, (r % 16) * 64, (r % 16) * 64, scr, F.lane); }
}
DEVI void router_weights(Frame& F, int gt, int NGT) {
    bf16_t* WR = WSP(bf16_t, WS_WR);
    for (int idx = gt; idx < 2 * 48 * D; idx += NGT) { const int l = idx / (48 * D), j = (idx / D) % 48, k = idx % D;
        float w = (j < 4) ? F.ka->in[17][((size_t)l * D + k) * 4 + j] : (j < 36) ? F.ka->in[19][((size_t)l * D + k) * 32 + (j - 4)] : 0.f; w *= F.ka->in[3][l * D + k];
        const unsigned hi = f2bf(w); const unsigned lo = f2bf(w - bf2f(hi));
        WR[((size_t)(l * 2 + 0) * 48 + j) * D + k] = (bf16_t)hi; WR[((size_t)(l * 2 + 1) * 48 + j) * D + k] = (bf16_t)lo; }
}
constexpr int GLA_SHORT0 = (Bz * 4 * NCH) % 256;
constexpr int CONV_P1_END = 114 * CONV_PER_WG;
DEVI void p0_prologue(Frame& F) {
    LAS bf16_t* scr = (LAS bf16_t*)(F.lds + RING_OFF + F.wave * 16384);
    const int gw = F.vcu * NWAVES + F.wave, NGW = F.G * NWAVES;
    const int gt = F.vcu * 512 + F.tid, NGT = F.G * 512;
    for (int it = gw; it < 16 * 48; it += NGW) { const int n0 = (it % 48) * 64; int dr = n0;
        if (n0 >= 512 && n0 < 1024) { const int c = n0 - 512; dr = (2 + (c >> 7)) * 256 + (c & 127); } else if (n0 >= 1024 && n0 < 1536) { const int c = n0 - 1024; dr = (2 + (c >> 7)) * 256 + 128 + (c & 127); }
        tr_item(F.ka->in[5], 3104, 3072, F.ka->in[2], WSP(bf16_t, WS_WIN), D, (it / 48) * 64, n0, dr, scr, F.lane); }
    if (F.G != 256) { for (int it = gw; it < 256 + 384 + 256; it += NGW) convert_small_item(F, it < 256 ? 0 : it < 640 ? 1 : 2, it < 256 ? it : it < 640 ? it - 256 : it - 640);
        convert_moe(F, 0, 0, CONV_ITEMS, gw, NGW); }
    { bf16_t* WT = WSP(bf16_t, WS_WIN);
      for (int idx = gt; idx < 2 * 256 * (D / 8); idx += NGT) { const int k8 = idx & 127, n = (idx >> 7) & 255, dir = idx >> 15; const float* wg = dir ? F.ka->in[9] : F.ka->in[7]; float wj[16];
#pragma unroll
          for (int j = 0; j < 16; ++j) wj[j] = wg[j * 256 + n];
          unsigned ow[4];
#pragma unroll
          for (int i2 = 0; i2 < 4; ++i2) { float r2[2];
#pragma unroll
              for (int e2 = 0; e2 < 2; ++e2) { const int k = k8 * 8 + i2 * 2 + e2; const f32x4* wp = (const f32x4*)(F.ka->in[5] + (size_t)k * 3104 + 3072 + 16 * dir); float s = 0.f;
#pragma unroll
                  for (int j4 = 0; j4 < 4; ++j4) { const f32x4 w4 = wp[j4]; s += w4[0] * wj[j4 * 4] + w4[1] * wj[j4 * 4 + 1] + w4[2] * wj[j4 * 4 + 2] + w4[3] * wj[j4 * 4 + 3]; }
                  r2[e2] = s * F.ka->in[2][k]; }
              ow[i2] = pk2(r2[0], r2[1]); }
          *(GAS v4u*)(WT + (size_t)(W_LA + dir * 256 + n) * D + k8 * 8) = (v4u){ow[0], ow[1], ow[2], ow[3]}; } }
    if (F.G != 256) router_weights(F, gt, NGT);
    { bf16_t* HB = WSP(bf16_t, WS_HB); float* SS = WSP(float, WS_SS);
      for (int m0 = gw; m0 < MP; m0 += 2 * NGW) { f32x4 v[2][4];
#pragma unroll
          for (int u = 0; u < 2; ++u) { const int m = m0 + u * NGW;
              if (m < MA) { const float* src = (m < MR) ? F.ka->in[0] + (size_t)m * D : F.ka->in[1] + (size_t)((m - MR) & 15) * D; const GAS f32x4* xr = (const GAS f32x4*)src + F.lane;
#pragma unroll
                  for (int j = 0; j < 4; ++j) v[u][j] = xr[64 * j];
              } else {
#pragma unroll
                  for (int j = 0; j < 4; ++j) v[u][j] = (f32x4){0.f, 0.f, 0.f, 0.f}; } }
#pragma unroll
          for (int u = 0; u < 2; ++u) { const int m = m0 + u * NGW; if (m >= MP) continue;
              GAS v2u* o8 = (GAS v2u*)(HB + (size_t)m * D) + F.lane; float s = 0.f;
#pragma unroll
              for (int j = 0; j < 4; ++j) { s += (v[u][j].x * v[u][j].x + v[u][j].y * v[u][j].y) + (v[u][j].z * v[u][j].z + v[u][j].w * v[u][j].w); o8[64 * j] = (v2u){pk2(v[u][j].x, v[u][j].y), pk2(v[u][j].z, v[u][j].w)}; }
              s = wave_sum(s);
              if (F.lane == 0) { SS[m] = s; if (m >= MA) { SS[MP + m] = 0.f; SS[2 * MP + m] = 0.f; } } }
      } }
}

constexpr int GL_LA = 0;
constexpr int GL_WG = 32768;
constexpr int GL_G = 40960;
constexpr int GL_BIAS = 49152;
constexpr int GL_SEG = 49664;
constexpr int GL_CL = 51712;
constexpr int GL_OP0 = 52224;
constexpr int GL_OP1 = GL_OP0 + 18432;
constexpr int GL_VT = GL_OP1 + 18432;
constexpr int GL_P = GL_VT + 18432;
constexpr int GL_SSQ = GL_P + 9216;
static_assert(GL_SSQ + 2048 <= RING_BYTES, "GLA LDS map");
constexpr int LDP = 72;
constexpr int LAP = 65;

DEVI int gla_row(int b, int n, int t) { return n == 0 ? MR + b * NM + t : b * S + (n - 1) * 64 + t; }
DEVI void gla_load_la(const bf16_t* U, int tid, int b, int h, int n, v4u& r0, v4u& r1) {
    const int dir = tid >> 8, t = (tid >> 2) & 63, dq = tid & 3, nval = (n == 0) ? NM : 64; r0 = (v4u){0u, 0u, 0u, 0u}; r1 = r0;
    if (t < nval) { const v4u* lp = (const v4u*)(U + (size_t)gla_row(b, n, t) * NU + U_LA + dir * 256 + h * 64 + dq * 16); r0 = lp[0]; r1 = lp[1]; }
}
DEVI void gla_cum(Frame& F, int n, v4u r0, v4u r1) {
    LAS float* LA = (LAS float*)(F.lds + GL_LA);
    LAS float* SEG = (LAS float*)(F.lds + GL_SEG); LAS float* CL = (LAS float*)(F.lds + GL_CL);
    const int tid = F.tid, nval = (n == 0) ? NM : 64;
    { const int dir = tid >> 8, t = (tid >> 2) & 63, dq = tid & 3; (void)nval;
      const unsigned lw[8] = {r0.x, r0.y, r0.z, r0.w, r1.x, r1.y, r1.z, r1.w};
#pragma unroll
      for (int i = 0; i < 16; ++i) LA[(dir * 64 + t) * LAP + dq * 16 + i] = bf2f((lw[i >> 1] >> ((i & 1) * 16)) & 0xffffu); }
    __syncthreads();
    { const int dir = tid >> 8, seg = (tid >> 6) & 3, d = tid & 63; float run = 0.f; float loc[16];
#pragma unroll
      for (int i = 0; i < 16; ++i) { const int p = seg * 16 + i, t = dir ? 63 - p : p; run += LA[(dir * 64 + t) * LAP + d]; loc[i] = run; }
      SEG[(dir * 4 + seg) * 64 + d] = run;
      __syncthreads();
      float off = 0.f;
#pragma unroll
      for (int s2 = 0; s2 < 4; ++s2) if (s2 < seg) off += SEG[(dir * 4 + s2) * 64 + d];
#pragma unroll
      for (int i = 0; i < 16; ++i) { const int p = seg * 16 + i, t = dir ? 63 - p : p; LA[(dir * 64 + t) * LAP + d] = off + loc[i]; }
      if (seg == 3) CL[dir * 64 + d] = off + run; }
    __syncthreads();
}

DEVI void p2_gla_kv(Frame& F) {
    const bf16_t* U = WSP(bf16_t, WS_BIG); bf16_t* KVSB = WSP(bf16_t, WS_H); float* DEC = WSP(float, WS_DEC);
    LAS float* LA = (LAS float*)(F.lds + GL_LA); LAS float* CL = (LAS float*)(F.lds + GL_CL);
    LAS bf16_t* KE = (LAS bf16_t*)(F.lds + GL_OP0); LAS bf16_t* VT = (LAS bf16_t*)(F.lds + GL_VT);
    const int tid = F.tid, lane = F.lane, w = F.wave;
#define P2_LOAD(UNIT, LA0, LA1, KR, V0, V1) do { const int n_ = (UNIT) % NCH, h_ = ((UNIT) / NCH) & 3, b_ = (UNIT) / (NCH * 4); gla_load_la(U, tid, b_, h_, n_, LA0, LA1); \
        const int t_ = tid >> 3, dg_ = tid & 7; KR = (v4u){0u, 0u, 0u, 0u}; V0 = KR; V1 = KR; \
        if (t_ < ((n_ == 0) ? NM : 64)) { const bf16_t* up_ = U + (size_t)gla_row(b_, n_, t_) * NU; KR = *(const v4u*)(up_ + U_K + h_ * 64 + dg_ * 8); const v4u* vp_ = (const v4u*)(up_ + U_V + h_ * 128 + dg_ * 16); V0 = vp_[0]; V1 = vp_[1]; } } while (0)
    v4u la0, la1, kr, v0, v1, nla0, nla1, nkr, nv0, nv1;
    if (F.vcu < Bz * 4 * NCH) P2_LOAD(F.vcu, la0, la1, kr, v0, v1);
    for (int unit = F.vcu; unit < Bz * 4 * NCH; unit += F.G) {
        const int n = unit % NCH, h = (unit / NCH) & 3, b = unit / (NCH * 4);
        const bool has_nx = unit + F.G < Bz * 4 * NCH;
        if (has_nx) P2_LOAD(unit + F.G, nla0, nla1, nkr, nv0, nv1);
        gla_cum(F, n, la0, la1);
        { const int t = tid >> 3, dg = tid & 7;
          const unsigned kw[4] = {kr.x, kr.y, kr.z, kr.w};
#pragma unroll
          for (int dir = 0; dir < 2; ++dir)
#pragma unroll
              for (int i = 0; i < 8; ++i) { const int d = dg * 8 + i; const float kv = bf2f((kw[i >> 1] >> ((i & 1) * 16)) & 0xffffu);
                  KE[(dir * 64 + d) * LDP + (t ^ (dg << 3))] = (bf16_t)f2bf(kv * __expf(CL[dir * 64 + d] - LA[(dir * 64 + t) * LAP + d])); }
          const unsigned vw[8] = {v0.x, v0.y, v0.z, v0.w, v1.x, v1.y, v1.z, v1.w};
#pragma unroll
          for (int i = 0; i < 16; ++i) VT[(dg * 16 + i) * LDP + (t ^ (dg << 3))] = (bf16_t)((vw[i >> 1] >> ((i & 1) * 16)) & 0xffffu); }
        __syncthreads();
        { const int dir = w >> 2, dt = w & 3, q = lane >> 4; const size_t seq = (size_t)((b * 4 + h) * 2 + dir) * NCH + n;
          bf16_t* outp = KVSB + seq * 8192;
#pragma unroll 2
          for (int vt = 0; vt < 8; ++vt) { f32x4 acc = (f32x4){0.f, 0.f, 0.f, 0.f};
              { const LAS bf16_t* ap = KE + (dir * 64 + dt * 16 + (lane & 15)) * LDP; const LAS bf16_t* bp = VT + (vt * 16 + (lane & 15)) * LDP; const int sa = (dt * 2 + ((lane & 15) >> 3)) << 3, sb = vt << 3, kq = 8 * (lane >> 4);
#pragma unroll
                for (int k0 = 0; k0 < 64; k0 += 32) acc = __builtin_amdgcn_mfma_f32_16x16x32_bf16(*(const LAS bf16x8*)(ap + ((k0 + kq) ^ sa)), *(const LAS bf16x8*)(bp + ((k0 + kq) ^ sb)), acc, 0, 0, 0); }
              *(v2u*)(outp + (vt * 16 + (lane & 15)) * 64 + dt * 16 + 4 * q) = (v2u){pk2(acc[0], acc[1]), pk2(acc[2], acc[3])}; }
          if (tid < 128) { const int dd = tid >> 6, d = tid & 63; DEC[((size_t)((b * 4 + h) * 2 + dd) * NCH + n) * 64 + d] = __expf(CL[dd * 64 + d]); } }
        __syncthreads();
        if (has_nx) { la0 = nla0; la1 = nla1; kr = nkr; v0 = nv0; v1 = nv1; }
    }
#undef P2_LOAD
}

DEVI void p3_gla_scan(Frame& F) {
    bf16_t* KVSB = WSP(bf16_t, WS_H); const float* DEC = WSP(float, WS_DEC);
    for (int item = F.vcu * 512 + F.tid; item < 64 * 2048; item += F.G * 512) {
        const int seq = item >> 11, off4 = item & 2047, dir = seq & 1, d = (off4 * 4) & 63;
        bf16_t* base = KVSB + (size_t)seq * NCH * 8192 + off4 * 4; const float* db = DEC + (size_t)seq * NCH * 64 + d;
        f32x4 Sx = (f32x4){0.f, 0.f, 0.f, 0.f};
#pragma unroll 1
        for (int g3 = 0; g3 < 2; ++g3) {
            v2u kv[17]; f32x4 dc[17];
#pragma unroll
            for (int i = 0; i < 17; ++i) { const int st = g3 * 17 + i; if (st < NCH) { const int n = dir ? NCH - 1 - st : st; kv[i] = *(const v2u*)(base + (size_t)n * 8192); dc[i] = *(const f32x4*)(db + n * 64); } }
#pragma unroll
            for (int i = 0; i < 17; ++i) { const int st = g3 * 17 + i; if (st < NCH) { const int n = dir ? NCH - 1 - st : st;
                *(v2u*)(base + (size_t)n * 8192) = (v2u){pk2(Sx[0], Sx[1]), pk2(Sx[2], Sx[3])};
                const f32x4 kvf = (f32x4){bf2f(kv[i].x & 0xffffu), bf2f(kv[i].x >> 16), bf2f(kv[i].y & 0xffffu), bf2f(kv[i].y >> 16)};
                Sx = dc[i] * Sx + kvf; } }
        }
    }
}

DEVI void p4_gla_out(Frame& F) {
    const bf16_t* U = WSP(bf16_t, WS_BIG); const bf16_t* KVSB = WSP(bf16_t, WS_H); bf16_t* YM = WSP(bf16_t, WS_HB);
    LAS float* LA = (LAS float*)(F.lds + GL_LA); LAS float* SSQ = (LAS float*)(F.lds + GL_SSQ);
    LAS bf16_t* QD = (LAS bf16_t*)(F.lds + GL_OP0); LAS bf16_t* KI = (LAS bf16_t*)(F.lds + GL_OP1); LAS bf16_t* VT = (LAS bf16_t*)(F.lds + GL_VT); LAS bf16_t* Pm = (LAS bf16_t*)(F.lds + GL_P);
    const float* cw = F.ka->in[6]; const float* gnw = F.ka->in[11];
    const int tid = F.tid, lane = F.lane, w = F.wave, q = lane >> 4, fr = lane & 15;
    for (int unit = F.vcu; unit < Bz * 4 * NCH; unit += F.G) {
        const int n = unit % NCH, h = (unit / NCH) & 3, b = unit / (NCH * 4), nval = (n == 0) ? NM : 64;
        v4u la0, la1; gla_load_la(U, tid, b, h, n, la0, la1);
        v4u cab[2], cz1[2], czp[2], czn[2]; f32x4 cwt[3][4];
        { const int t = tid >> 3, cg = tid & 7, c0 = h * 128 + cg * 16;
#pragma unroll
          for (int hh = 0; hh < 2; ++hh) { cab[hh] = (v4u){0u, 0u, 0u, 0u}; cz1[hh] = cab[hh]; czp[hh] = cab[hh]; czn[hh] = cab[hh]; }
          if (t < nval) { const int tpos = (n == 0) ? t : NM + (n - 1) * 64 + t;
              const bf16_t* u1 = U + (size_t)gla_row(b, n, t) * NU + c0; const bf16_t* u0 = (tpos > 0) ? U + (size_t)tok_row(b, tpos - 1) * NU + c0 : nullptr;
              const bf16_t* u2 = (tpos < T - 1) ? U + (size_t)tok_row(b, tpos + 1) * NU + c0 : nullptr;
#pragma unroll
              for (int hh = 0; hh < 2; ++hh) { cab[hh] = *(const v4u*)(u1 + U_AB + hh * 8); cz1[hh] = *(const v4u*)(u1 + U_Z + hh * 8);
                  if (u0) czp[hh] = *(const v4u*)(u0 + U_Z + hh * 8);
                  if (u2) czn[hh] = *(const v4u*)(u2 + U_Z + hh * 8); } }
#pragma unroll
          for (int tap = 0; tap < 3; ++tap)
#pragma unroll
              for (int j4 = 0; j4 < 4; ++j4) cwt[tap][j4] = *(const f32x4*)(cw + tap * 512 + c0 + 4 * j4); }
        v4u qr = (v4u){0u, 0u, 0u, 0u}, kr = qr, v0 = qr, v1 = qr;
        { const int t = tid >> 3, dg = tid & 7;
          if (t < nval) { const bf16_t* up = U + (size_t)gla_row(b, n, t) * NU; qr = *(const v4u*)(up + U_Q + h * 64 + dg * 8); kr = *(const v4u*)(up + U_K + h * 64 + dg * 8);
              const v4u* vp = (const v4u*)(up + U_V + h * 128 + dg * 16); v0 = vp[0]; v1 = vp[1]; } }
        const size_t seqf = (size_t)((b * 4 + h) * 2 + 0) * NCH + n, seqb = (size_t)((b * 4 + h) * 2 + 1) * NCH + n;
        const bf16_t* sfp = KVSB + seqf * 8192 + (size_t)(w * 16 + fr) * 64 + 8 * q; const bf16_t* sbp = KVSB + seqb * 8192 + (size_t)(w * 16 + fr) * 64 + 8 * q;
        const bf16x8 sf0 = *(const bf16x8*)(sfp), sf1 = *(const bf16x8*)(sfp + 32), sb0 = *(const bf16x8*)(sbp), sb1 = *(const bf16x8*)(sbp + 32);
        const f32x4 gw4 = *(const f32x4*)(gnw + w * 16 + 4 * q);
        v2u rg[4];
#pragma unroll
        for (int tt = 0; tt < 4; ++tt) { const int t = tt * 16 + fr; rg[tt] = (v2u){0u, 0u}; if (t < nval) rg[tt] = *(const v2u*)(U + (size_t)gla_row(b, n, t) * NU + U_R + h * 128 + w * 16 + 4 * q); }
        gla_cum(F, n, la0, la1);
        { const int t = tid >> 3, cg = tid & 7;
          if (t < nval) { const int c0 = h * 128 + cg * 16; unsigned outw[8];
#pragma unroll
              for (int hh = 0; hh < 2; ++hh) {
                  const unsigned abw[4] = {cab[hh].x, cab[hh].y, cab[hh].z, cab[hh].w}, z1w[4] = {cz1[hh].x, cz1[hh].y, cz1[hh].z, cz1[hh].w}, zpw[4] = {czp[hh].x, czp[hh].y, czp[hh].z, czp[hh].w}, znw[4] = {czn[hh].x, czn[hh].y, czn[hh].z, czn[hh].w};
#pragma unroll
                  for (int i2 = 0; i2 < 4; ++i2) { float yv[2];
#pragma unroll
                      for (int e2 = 0; e2 < 2; ++e2) { const int ci = hh * 8 + i2 * 2 + e2; const int sh = e2 * 16;
                          yv[e2] = bf2f((abw[i2] >> sh) & 0xffffu) * (cwt[0][ci >> 2][ci & 3] * bf2f((zpw[i2] >> sh) & 0xffffu) + cwt[1][ci >> 2][ci & 3] * bf2f((z1w[i2] >> sh) & 0xffffu) + cwt[2][ci >> 2][ci & 3] * bf2f((znw[i2] >> sh) & 0xffffu)); }
                      outw[hh * 4 + i2] = pk2(yv[0], yv[1]); } }
              v4u* yp = (v4u*)(YM + (size_t)gla_row(b, n, t) * D + c0); yp[0] = (v4u){outw[0], outw[1], outw[2], outw[3]}; yp[1] = (v4u){outw[4], outw[5], outw[6], outw[7]}; } }
        { const int t = tid >> 3, dg = tid & 7;
          const unsigned qw[4] = {qr.x, qr.y, qr.z, qr.w}, kw[4] = {kr.x, kr.y, kr.z, kr.w};
#pragma unroll
          for (int dir = 0; dir < 2; ++dir) { unsigned qo[4], ko[4];
#pragma unroll
              for (int i2 = 0; i2 < 4; ++i2) { float qv[2], kv[2];
#pragma unroll
                  for (int e2 = 0; e2 < 2; ++e2) { const int d = dg * 8 + i2 * 2 + e2; const float c = LA[(dir * 64 + t) * LAP + d];
                      qv[e2] = bf2f((qw[i2] >> (e2 * 16)) & 0xffffu) * 0.125f * __expf(c); kv[e2] = bf2f((kw[i2] >> (e2 * 16)) & 0xffffu) * __expf(-c); }
                  qo[i2] = pk2(qv[0], qv[1]); ko[i2] = pk2(kv[0], kv[1]); }
              *(LAS v4u*)(QD + (dir * 64 + t) * LDP + dg * 8) = (v4u){qo[0], qo[1], qo[2], qo[3]};
              *(LAS v4u*)(KI + (dir * 64 + t) * LDP + dg * 8) = (v4u){ko[0], ko[1], ko[2], ko[3]}; }
          const unsigned vw[8] = {v0.x, v0.y, v0.z, v0.w, v1.x, v1.y, v1.z, v1.w};
#pragma unroll
          for (int i = 0; i < 16; ++i) VT[(dg * 16 + i) * LDP + (t ^ (dg << 3))] = (bf16_t)((vw[i >> 1] >> ((i & 1) * 16)) & 0xffffu); }
        __syncthreads();
#pragma unroll
        for (int x = 0; x < 2; ++x) { const int tile = w * 2 + x, st = tile >> 2, tt = tile & 3; f32x4 af = (f32x4){0.f, 0.f, 0.f, 0.f}, ab = af;
            af = mma_nt(KI + (0 * 64 + st * 16) * LDP, LDP, QD + (0 * 64 + tt * 16) * LDP, LDP, 64, lane, af);
            ab = mma_nt(KI + (1 * 64 + st * 16) * LDP, LDP, QD + (1 * 64 + tt * 16) * LDP, LDP, 64, lane, ab);
            const int t = tt * 16 + fr, s0 = st * 16 + 4 * q; float pv[4];
#pragma unroll
            for (int r = 0; r < 4; ++r) pv[r] = (s0 + r <= t) ? af[r] : ab[r];
            *(LAS v2u*)(Pm + t * LDP + s0) = (v2u){pk2(pv[0], pv[1]), pk2(pv[2], pv[3])}; }
        __syncthreads();
        f32x4 o[4];
        { const LAS bf16_t* vtp = VT + (w * 16 + fr) * LDP; const bf16x8 va0 = *(const LAS bf16x8*)(vtp + ((8 * q) ^ (w << 3))), va1 = *(const LAS bf16x8*)(vtp + ((32 + 8 * q) ^ (w << 3)));
#pragma unroll
          for (int tt = 0; tt < 4; ++tt) { f32x4 acc = (f32x4){0.f, 0.f, 0.f, 0.f};
              const LAS bf16_t* pp = Pm + (tt * 16 + fr) * LDP + 8 * q; const LAS bf16_t* qf = QD + (0 * 64 + tt * 16 + fr) * LDP + 8 * q; const LAS bf16_t* qb = QD + (1 * 64 + tt * 16 + fr) * LDP + 8 * q;
              acc = __builtin_amdgcn_mfma_f32_16x16x32_bf16(va0, *(const LAS bf16x8*)(pp), acc, 0, 0, 0);
              acc = __builtin_amdgcn_mfma_f32_16x16x32_bf16(va1, *(const LAS bf16x8*)(pp + 32), acc, 0, 0, 0);
              acc = __builtin_amdgcn_mfma_f32_16x16x32_bf16(sf0, *(const LAS bf16x8*)(qf), acc, 0, 0, 0);
              acc = __builtin_amdgcn_mfma_f32_16x16x32_bf16(sf1, *(const LAS bf16x8*)(qf + 32), acc, 0, 0, 0);
              acc = __builtin_amdgcn_mfma_f32_16x16x32_bf16(sb0, *(const LAS bf16x8*)(qb), acc, 0, 0, 0);
              acc = __builtin_amdgcn_mfma_f32_16x16x32_bf16(sb1, *(const LAS bf16x8*)(qb + 32), acc, 0, 0, 0);
              o[tt] = acc;
              float s2 = (acc[0] * acc[0] + acc[1] * acc[1]) + (acc[2] * acc[2] + acc[3] * acc[3]); s2 += __shfl_xor(s2, 16); s2 += __shfl_xor(s2, 32);
              if (q == 0) SSQ[w * 64 + tt * 16 + fr] = s2; } }
        __syncthreads();
        { const int v0i = w * 16 + 4 * q;
#pragma unroll
          for (int tt = 0; tt < 4; ++tt) { const int t = tt * 16 + fr; float tot = 0.f;
#pragma unroll
              for (int w2 = 0; w2 < 8; ++w2) tot += SSQ[w2 * 64 + t];
              if (t < nval) { const float rs = rsqrtf(tot * (1.0f / 128.0f) + EPS); const size_t row = (size_t)gla_row(b, n, t);
                  const v2u rr = rg[tt];
                  const float rv[4] = {bf2f(rr.x & 0xffffu), bf2f(rr.x >> 16), bf2f(rr.y & 0xffffu), bf2f(rr.y >> 16)}; float y[4];
#pragma unroll
                  for (int r = 0; r < 4; ++r) y[r] = o[tt][r] * rs * gw4[r] * (rv[r] * __builtin_amdgcn_rcpf(1.0f + __expf(-rv[r])));
                  *(v2u*)(YM + row * D + 512 + h * 128 + v0i) = (v2u){pk2(y[0], y[1]), pk2(y[2], y[3])}; } } }
        __syncthreads();
    }
}

DEVI void p5_meta_rows(Frame& F) {
    const bf16_t* YM = WSP(bf16_t, WS_HB) + (size_t)MR * D; const bf16_t* WT = WSP(bf16_t, WS_WO0); bf16_t* HR = WSP(bf16_t, WS_H) + (size_t)MR * D; const float* meta = F.ka->in[1];
    const int lane = F.lane, fr = lane & 15, q = lane >> 4;
    LAS f32x4* part = (LAS f32x4*)(F.lds + RING_OFF);
    for (int t0 = F.vcu * 2; t0 < 512; t0 += F.G * 2) {
        const int task = t0 + (F.wave >> 2), kq = F.wave & 3, ct = task >> 3, rt = task & 7;
        const bf16_t* wp = WT + (size_t)(ct * 16 + fr) * D + kq * 256 + 8 * q; const bf16_t* ap = YM + (size_t)(rt * 16 + fr) * D + kq * 256 + 8 * q;
        bf16x8 wf[8], af[8];
#pragma unroll
        for (int i = 0; i < 8; ++i) { wf[i] = *(const bf16x8*)(wp + i * 32); af[i] = *(const bf16x8*)(ap + i * 32); }
        f32x4 acc = (f32x4){0.f, 0.f, 0.f, 0.f};
#pragma unroll
        for (int i = 0; i < 8; ++i) acc = __builtin_amdgcn_mfma_f32_16x16x32_bf16(wf[i], af[i], acc, 0, 0, 0);
        part[F.wave * 64 + lane] = acc;
        __syncthreads();
        if (kq == 0) { const int wb = F.wave * 64 + lane; acc = (part[wb] + part[wb + 64]) + (part[wb + 128] + part[wb + 192]);
            const int row = rt * 16 + fr, col = ct * 16 + 4 * q;
            const f32x4 hv = *(const f32x4*)(meta + (size_t)(row & 15) * D + col) + acc;
            *(v2u*)(HR + (size_t)row * D + col) = (v2u){pk2(hv[0], hv[1]), pk2(hv[2], hv[3])}; }
        __syncthreads();
    }
}
constexpr int RT_WLD = 136;
constexpr int RT_WBUF = 96 * RT_WLD * 2;
constexpr int RT_LG = 2 * RT_WBUF;
DEVI void route_phase(Frame& F, int layer, int nrows, bool dry) {
    const bf16_t* HR = WSP(bf16_t, WS_H);
    const bf16_t* WRb = WSP(bf16_t, WS_WR) + (size_t)(layer * 2) * 48 * D;
    const float* bg = F.ka->in[18] + layer * 4; const float* be = F.ka->in[20] + layer * 32;
    unsigned* CNT = (unsigned*)F.ctl + (layer ? CW_CNT1 : CW_CNT0); int* LIST = WSP(int, WS_LIST); unsigned* RI = WSP(unsigned, WS_RI); float* RSTD = WSP(float, WS_SS) + 2 * MP; float* RSL = WSP(float, WS_RSL);
    LAS float* LG = (LAS float*)(F.lds + RT_LG + F.wave * 4096); LAS float* RS = LG + 16 * 48;
    const int lane = F.lane, fr = lane & 15, q = lane >> 4, tid = F.tid;
    for (int gbase = 0; gbase < nrows / 16; gbase += NWAVES * F.G) {
    const int grp = gbase + F.vcu + F.wave * F.G; const bool act = grp < nrows / 16;
    const int r0 = act ? grp * 16 : 0; const bf16_t* hp = HR + (size_t)(r0 + fr) * D + 8 * q;
    v4u wreg[3];
#define RT_LOADW(c) do { _Pragma("unroll") for (int i = 0; i < 3; ++i) { const int p = tid + 512 * i; wreg[i] = *(const GAS v4u*)(WRb + (size_t)(p >> 4) * D + (c) * 128 + (p & 15) * 8); } } while (0)
#define RT_STOREW(b) do { _Pragma("unroll") for (int i = 0; i < 3; ++i) { const int p = tid + 512 * i; *(LAS v4u*)(F.lds + (b) * RT_WBUF + ((p >> 4) * RT_WLD + (p & 15) * 8) * 2) = wreg[i]; } } while (0)
    f32x4 acc[3]; acc[0] = (f32x4){0.f, 0.f, 0.f, 0.f}; acc[1] = acc[0]; acc[2] = acc[0]; float ss = 0.f;
    v4u xc[4], xn[4];
    RT_LOADW(0);
    if (act) {
#pragma unroll
        for (int i = 0; i < 4; ++i) xc[i] = *(const GAS v4u*)(hp + i * 32); }
    RT_STOREW(0);
    __syncthreads();
#pragma unroll 1
    for (int c = 0; c < 8; ++c) {
        if (c + 1 < 8) { RT_LOADW(c + 1);
            if (act) {
#pragma unroll
                for (int i = 0; i < 4; ++i) xn[i] = *(const GAS v4u*)(hp + (c + 1) * 128 + i * 32); } }
        if (act) { const LAS bf16_t* wb = (const LAS bf16_t*)(F.lds + (c & 1) * RT_WBUF);
#pragma unroll
            for (int kk = 0; kk < 4; ++kk) {
                const v4u hw = xc[kk]; const unsigned hx[4] = {hw.x, hw.y, hw.z, hw.w};
#pragma unroll
                for (int j = 0; j < 4; ++j) { const float lo_ = __uint_as_float(hx[j] << 16), hi_ = __uint_as_float(hx[j] & 0xffff0000u); ss += lo_ * lo_ + hi_ * hi_; }
                const bf16x8 ah = __builtin_bit_cast(bf16x8, hw);
#pragma unroll
                for (int ct = 0; ct < 3; ++ct) { const bf16x8 bh = *(const LAS bf16x8*)(wb + (ct * 16 + fr) * RT_WLD + kk * 32 + 8 * q), bl = *(const LAS bf16x8*)(wb + (48 + ct * 16 + fr) * RT_WLD + kk * 32 + 8 * q);
                    acc[ct] = __builtin_amdgcn_mfma_f32_16x16x32_bf16(ah, bh, acc[ct], 0, 0, 0);
                    acc[ct] = __builtin_amdgcn_mfma_f32_16x16x32_bf16(ah, bl, acc[ct], 0, 0, 0); }
            } }
        if (c + 1 < 8) { RT_STOREW((c + 1) & 1);
#pragma unroll
            for (int i = 0; i < 4; ++i) xc[i] = xn[i]; }
        __syncthreads();
    }
#undef RT_LOADW
#undef RT_STOREW
    if (act) {
        ss += __shfl_xor(ss, 16); ss += __shfl_xor(ss, 32);
        if (q == 0) RS[fr] = pg8::rs_of(ss);
#pragma unroll
        for (int ct = 0; ct < 3; ++ct)
#pragma unroll
            for (int r = 0; r < 4; ++r) LG[(4 * q + r) * 48 + ct * 16 + fr] = acc[ct][r];
        LDS_WAIT(); asm volatile("" ::: "memory");
        if (lane < 16) {
            const int row = r0 + lane; const float rs = RS[lane]; float lg[4], le[32];
#pragma unroll
            for (int j = 0; j < 4; ++j) lg[j] = LG[lane * 48 + j] * rs + bg[j];
#pragma unroll
            for (int j = 0; j < 32; ++j) le[j] = LG[lane * 48 + 4 + j] * rs + be[j];
            int gi = 0; float gm = lg[0];
#pragma unroll
            for (int j = 1; j < 4; ++j) if (lg[j] > gm) { gm = lg[j]; gi = j; }
            float gs = 0.f;
#pragma unroll
            for (int j = 0; j < 4; ++j) gs += __expf(lg[j] - gm);
            const float gp = 1.0f / gs; float es[8];
#pragma unroll
            for (int j = 0; j < 8; ++j) es[j] = gi == 0 ? le[j] : gi == 1 ? le[8 + j] : gi == 2 ? le[16 + j] : le[24 + j];
            int i0 = 0; float v0 = es[0];
#pragma unroll
            for (int j = 1; j < 8; ++j) if (es[j] > v0) { v0 = es[j]; i0 = j; }
            int i1 = 0; float v1 = -INFINITY;
#pragma unroll
            for (int j = 0; j < 8; ++j) if (j != i0 && es[j] > v1) { v1 = es[j]; i1 = j; }
            const float e1 = __expf(v1 - v0), w0 = gp / (1.0f + e1), w1 = gp * e1 / (1.0f + e1);
            const int ex0 = gi * 8 + i0, ex1 = gi * 8 + i1;
            if (dry) { if (w0 + w1 < -1.f) RSTD[row] = w0; } else {
            const unsigned s0 = atomicAdd(CNT + ex0, 1u), s1 = atomicAdd(CNT + ex1, 1u);
            LIST[(size_t)ex0 * MA + s0] = row; LIST[(size_t)ex1 * MA + s1] = row; RSL[(size_t)ex0 * MA + s0] = rs; RSL[(size_t)ex1 * MA + s1] = rs;
            v4u ri; ri.x = (unsigned)ex0; ri.y = (unsigned)ex1; ri.z = s0; ri.w = s1; *(v4u*)(RI + (size_t)row * 8) = ri;
            *(f32x2*)(RI + (size_t)row * 8 + 4) = (f32x2){w0, w1}; RSTD[row] = rs; }
        }
    }
    __syncthreads();
    }
}

constexpr int MOE_TB = RING_BYTES + 512;
DEVI void moe_table(Frame& F, int layer) {
    LAS unsigned* TB = (LAS unsigned*)(F.lds + MOE_TB);
    __syncthreads();
    if (F.wave == 0) { const gu32* CNT = F.ctl + (layer ? CW_CNT1 : CW_CNT0);
        const unsigned c = F.lane < NEXP ? __hip_atomic_load(CNT + F.lane, __ATOMIC_RELAXED, __HIP_MEMORY_SCOPE_AGENT) : 0u; unsigned inc = (c + 255u) >> 8;
#pragma unroll
        for (int o = 1; o < 32; o <<= 1) { const unsigned up = __shfl_up(inc, o); if ((F.lane & 31) >= o) inc += up; }
        if (F.lane < NEXP) { TB[F.lane] = inc - ((c + 255u) >> 8); TB[40 + F.lane] = c; if (F.lane == NEXP - 1) TB[32] = inc; } }
    __syncthreads();
}
template <int NPN, bool GATH> struct MoeOrder {
    static constexpr bool GATHER = GATH;
    LAS unsigned* TB; const int* LIST; int G, c, rep; LAS unsigned char* van; int off = 0, lim = 1 << 30;
    __device__ __forceinline__ bool next(int i, pg8::Unit& u) const {
        int L = i * G + c + off; const int ntile = (int)TB[32];
        if (L >= ntile * NPN * rep || L >= lim) return false; L %= ntile * NPN;
        const int tile = L / NPN, pnl = L % NPN; int e = 0;
#pragma unroll
        for (int st = 16; st >= 1; st >>= 1) if ((int)TB[e + st] <= tile) e += st;
        u.pm = tile; u.pn = e * NPN + pnl; u.e = e; u.mt = tile - (int)TB[e]; return true;
    }
    __device__ __forceinline__ unsigned arow(const pg8::Unit& u, int r) const { const int cnt = (int)TB[40 + u.e]; int idx = u.mt * 256 + r; idx = idx < cnt ? idx : cnt - 1; return (unsigned)LIST[(size_t)u.e * MA + idx]; }
    __device__ __forceinline__ void a_ready(const pg8::Unit&) const {}
    __device__ __forceinline__ void done(const pg8::Unit&) const {}
};
struct EpiGateUp {
    static constexpr bool PERM = true;
    bf16_t* HH; const float* RSTD; LAS unsigned* TB; const int* LIST;
    __device__ __forceinline__ void operator()(const pg8::f32x4 (&acc)[2][2][4][2], const pg8::Unit& u, int wr, int wc, int fr, int fq) const {
        const int col0 = (u.pn & 1) * 128 + wc * 32 + 8 * fq; const int cnt = (int)TB[40 + u.e];
#pragma unroll
        for (int ai = 0; ai < 2; ++ai)
#pragma unroll
            for (int m = 0; m < 4; ++m) { const int rl = ai * 128 + wr * 64 + m * 16 + fr, idx = u.mt * 256 + rl;
                const float rs = RSTD[(size_t)u.e * MA + (idx < cnt ? idx : cnt - 1)]; float hv[8];
#pragma unroll
                for (int n = 0; n < 2; ++n)
#pragma unroll
                    for (int i = 0; i < 4; ++i) { const float gg = acc[ai][0][m][n][i] * rs, uu = acc[ai][1][m][n][i] * rs; hv[n * 4 + i] = gg * __builtin_amdgcn_rcpf(1.0f + __expf(-gg)) * uu; }
                pg8::u32x4 wv; wv.x = pg8::cvt_pk_bf16(hv[0], hv[1]); wv.y = pg8::cvt_pk_bf16(hv[2], hv[3]); wv.z = pg8::cvt_pk_bf16(hv[4], hv[5]); wv.w = pg8::cvt_pk_bf16(hv[6], hv[7]);
                if (idx < cnt) *(pg8::u32x4*)(HH + (size_t)(u.pm * 256 + rl) * 256 + col0) = wv; asm volatile("" ::: "memory"); }
    }
};

template <int MODE> DEVI void combine_phase(Frame& F, int nrows, bool dry = false) {
    LAS unsigned* TB = (LAS unsigned*)(F.lds + MOE_TB);
    bf16_t* HR = WSP(bf16_t, WS_H); const bf16_t* Y = WSP(bf16_t, WS_Y); const unsigned* RI = WSP(unsigned, WS_RI); float* SS1 = WSP(float, WS_SS) + MP;
    const float* gf = F.ka->in[4];
    const int gw = F.vcu * NWAVES + F.wave, NGW = F.G * NWAVES;
    v4u rin[2]; f32x2 wvn[2];
#pragma unroll
    for (int u = 0; u < 2; ++u) { const int m = gw + u * NGW, mm = m < nrows ? m : 0; rin[u] = *(const v4u*)(RI + (size_t)mm * 8); wvn[u] = *(const f32x2*)(RI + (size_t)mm * 8 + 4); }
    for (int m0 = gw; m0 < nrows; m0 += 2 * NGW) {
        v2u hv[2][4], ya[2][4], yb[2][4]; f32x2 wv[2]; bool ok[2]; v4u ric[2];
#pragma unroll
        for (int u = 0; u < 2; ++u) { ric[u] = rin[u]; wv[u] = wvn[u]; }
#pragma unroll
        for (int u = 0; u < 2; ++u) { const int m = m0 + 2 * NGW + u * NGW, mm = m < nrows ? m : 0; rin[u] = *(const v4u*)(RI + (size_t)mm * 8); wvn[u] = *(const f32x2*)(RI + (size_t)mm * 8 + 4); }
#pragma unroll
        for (int u = 0; u < 2; ++u) { const int m = m0 + u * NGW; ok[u] = m < nrows; const int mm = ok[u] ? m : m0;
            const v4u ri = ric[u];
            const size_t p0 = (size_t)TB[ri.x] * 256 + ri.z, p1 = (size_t)TB[ri.y] * 256 + ri.w;
            const GAS v2u* hr = (const GAS v2u*)(HR + (size_t)mm * D) + F.lane; const GAS v2u* y0 = (const GAS v2u*)(Y + p0 * D) + F.lane; const GAS v2u* y1 = (const GAS v2u*)(Y + p1 * D) + F.lane;
#pragma unroll
            for (int j = 0; j < 4; ++j) { hv[u][j] = hr[64 * j]; ya[u][j] = y0[64 * j]; yb[u][j] = y1[64 * j]; } }
#pragma unroll
        for (int u = 0; u < 2; ++u) { const int m = m0 + u * NGW; if (!ok[u]) continue;
            f32x4 v[4]; v2u hb[4]; float s = 0.f;
#pragma unroll
            for (int j = 0; j < 4; ++j) { const v2u h2 = hv[u][j], a = ya[u][j], b = yb[u][j]; const float w0 = wv[u].x, w1 = wv[u].y;
                v[j].x = bf2f(h2.x & 0xffffu) + w0 * bf2f(a.x & 0xffffu) + w1 * bf2f(b.x & 0xffffu); v[j].y = bf2f(h2.x >> 16) + w0 * bf2f(a.x >> 16) + w1 * bf2f(b.x >> 16);
                v[j].z = bf2f(h2.y & 0xffffu) + w0 * bf2f(a.y & 0xffffu) + w1 * bf2f(b.y & 0xffffu); v[j].w = bf2f(h2.y >> 16) + w0 * bf2f(a.y >> 16) + w1 * bf2f(b.y >> 16);
                if (MODE == 0) { hb[j] = (v2u){pk2(v[j].x, v[j].y), pk2(v[j].z, v[j].w)};
                    v[j] = (f32x4){bf2f(hb[j].x & 0xffffu), bf2f(hb[j].x >> 16), bf2f(hb[j].y & 0xffffu), bf2f(hb[j].y >> 16)}; }
                s += (v[j].x * v[j].x + v[j].y * v[j].y) + (v[j].z * v[j].z + v[j].w * v[j].w); }
            s = wave_sum(s);
            if (MODE == 0) { if (dry) { if (s < -1.f) SS1[m] = s; continue; }
                GAS v2u* hr = (GAS v2u*)(HR + (size_t)m * D) + F.lane;
#pragma unroll
                for (int j = 0; j < 4; ++j) hr[64 * j] = hb[j];
                if (F.lane == 0) SS1[m] = s;
            } else { const float rs = pg8::rs_of(s); GAS f32x4* op = (GAS f32x4*)(F.out + (size_t)m * D) + F.lane; const GAS f32x4* gp = (const GAS f32x4*)gf + F.lane;
#pragma unroll
                for (int j = 0; j < 4; ++j) { const f32x4 g4 = gp[64 * j]; op[64 * j] = (f32x4){v[j].x * rs * g4.x, v[j].y * rs * g4.y, v[j].z * rs * g4.z, v[j].w * rs * g4.w}; } }
        }
    }
}

constexpr float ATT_C2 = 0.125f * 1.4426950408889634f;
DEVI void qkprep_phase(Frame& F) {
    bf16_t* U2 = WSP(bf16_t, WS_U2); const float* ROPE = WSP(float, WS_ROPE); const float* qn = F.ka->in[14]; const float* kn = F.ka->in[15];
    const int gw = F.vcu * NWAVES + F.wave, NGW = F.G * NWAVES, sub = F.lane >> 3, l8 = F.lane & 7;
    for (int it0 = gw * 8; it0 < MA * 20; it0 += NGW * 8) {
        const int it = it0 + sub, row = it / 20, head = it % 20;
        bf16_t* p = U2 + (size_t)row * NA + head * 64 + l8 * 8;
        const v4u raw = *(const v4u*)p; const unsigned rw[4] = {raw.x, raw.y, raw.z, raw.w}; float x[8]; float ss = 0.f;
#pragma unroll
        for (int i = 0; i < 8; ++i) { x[i] = bf2f((rw[i >> 1] >> ((i & 1) * 16)) & 0xffffu); ss += x[i] * x[i]; }
        ss += __shfl_xor(ss, 1); ss += __shfl_xor(ss, 2); ss += __shfl_xor(ss, 4);
        const float rs = rsqrtf(ss * (1.0f / 64.0f) + EPS) * (head < 16 ? ATT_C2 : 1.0f); const float* nw = (head < 16 ? qn : kn) + l8 * 8;
        unsigned ow[4];
#pragma unroll
        for (int i2 = 0; i2 < 4; ++i2) { const float a0 = x[2 * i2] * rs * nw[2 * i2], a1 = x[2 * i2 + 1] * rs * nw[2 * i2 + 1]; float cs = 1.f, sn = 0.f;
            if (row < MR) { const f32x2 cv = *(const f32x2*)(ROPE + ((size_t)(row & (S - 1)) * 32 + l8 * 4 + i2) * 2); cs = cv.x; sn = cv.y; }
            ow[i2] = pk2(a0 * cs - a1 * sn, a0 * sn + a1 * cs); }
        *(v4u*)p = (v4u){ow[0], ow[1], ow[2], ow[3]};
    }
}
constexpr int NPHASE = 19;
__global__ void __launch_bounds__(NWAVES * 64, 2) mega(Args args) {
    extern __shared__ __attribute__((aligned(16))) unsigned char lds[];
    Frame F;
    F.lds = (LAS unsigned char*)lds;
    F.MISC = (volatile LAS unsigned*)(F.lds + MISC_OFF);
    F.tid = threadIdx.x; F.lane = F.tid & 63; F.wave = __builtin_amdgcn_readfirstlane(F.tid >> 6);
    F.G = gridDim.x; { const int bx = blockIdx.x; F.vcu = (F.G % 8 == 0) ? (bx % 8) * (F.G / 8) + bx / 8 : bx; }
    F.ws = args.ws; F.ctl = (gu32*)(args.ws + WS_CTL); F.out = args.out;
    F.ka = (const __attribute__((address_space(4))) Args*)__builtin_amdgcn_kernarg_segment_ptr();
    for (int u = F.tid; u < (LDS_BYTES - LDSCTL_OFF) / 4; u += NWAVES * 64) ((LAS unsigned*)(F.lds + LDSCTL_OFF))[u] = 0u;
    __syncthreads();
    const int lo = args.ph_lo, hi = args.ph_hi;
    const bool multi = (hi - lo) > 1;
    XcdBarrier bar; bar.bar = (unsigned*)(F.ctl + CW_BAR); bar.x = 0; bar.st = nullptr;
    if (multi) bar = xcd_barrier_post((unsigned*)(F.ctl + CW_BAR), F.MISC + 8);
#ifndef PHASE_MASK
#define PHASE_MASK 0x7ffff
#endif
#define IN(k) (((PHASE_MASK >> (k)) & 1) && lo <= (k) && (k) < hi)
#ifndef DOUBLE_PHASE
#define DOUBLE_PHASE -1
#endif
#define RF(k) ((k) == DOUBLE_PHASE ? 2 : 1)
#define SEAM(k) do { if (IN(k) && IN((k) + 1)) xcd_barrier(bar); } while (0)
#define REP(k) for (int rep_ = 0; rep_ < RF(k); ++rep_, ((k) == DOUBLE_PHASE && rep_ == 1 ? xcd_barrier(bar) : (void)0))
    LAS unsigned char* ring = F.lds + RING_OFF;
    LAS unsigned* TB = (LAS unsigned*)(F.lds + MOE_TB);
    int tb_layer = -1;
#define MOE_TABLE(L) do { if (tb_layer != (L)) { moe_table(F, (L)); tb_layer = (L); } } while (0)
    bf16_t* HB = WSP(bf16_t, WS_HB); bf16_t* HR = WSP(bf16_t, WS_H); float* SS = WSP(float, WS_SS);

    if (IN(0)) REP(0) { p0_prologue(F); } SEAM(0);
    if (IN(1)) {
        pg8::Gemm g{HB, WSP(bf16_t, WS_WIN), MP, NG1, D}; pg8::StaticOrder So; So.init(MP, NG1, F.G, (int)blockIdx.x, RF(1));
        pg8::EpiInProj0 E{WSP(bf16_t, WS_BIG), SS, F.ka->in[8], F.ka->in[10]};
#ifdef PROBE_SPLIT1
        So.lim = 512; pg8::gemm_phase<pg8::EpiInProj0, pg8::StaticOrder, true>(ring, g, So, E); So.off = 512; So.lim = 1 << 30;
#endif
        pg8::gemm_phase<pg8::EpiInProj0, pg8::StaticOrder, true>(ring, g, So, E);
        { const int rem = So.nwg % 256; if (F.G == 256 && rem && (int)blockIdx.x >= rem) { const int j = (int)blockIdx.x - rem; convert_moe(F, 0, j * CONV_PER_WG, (j + 1) * CONV_PER_WG, F.wave, NWAVES); } } } SEAM(1);
#ifdef PROBE_BAR
    for (int i_ = 0; i_ < 10; ++i_) xcd_barrier(bar);
#endif
    if (IN(2)) REP(2) { p2_gla_kv(F);
        if (F.G == 256 && F.vcu >= GLA_SHORT0) { const int j = F.vcu - GLA_SHORT0; convert_moe(F, 0, CONV_P1_END + j * NWAVES, CONV_P1_END + (j + 1) * NWAVES, F.wave, NWAVES);
            router_weights(F, j * 512 + F.tid, (256 - GLA_SHORT0) * 512); } } SEAM(2);
    if (IN(3)) REP(3) { p3_gla_scan(F); } SEAM(3);
    if (IN(4)) REP(4) { p4_gla_out(F);
        if (F.G == 256 && F.vcu >= GLA_SHORT0) { const int j = F.vcu - GLA_SHORT0, lo_ = CONV_P1_END + (256 - GLA_SHORT0) * NWAVES + j * NWAVES;
            convert_moe(F, 0, lo_ < CONV_ITEMS ? lo_ : CONV_ITEMS, lo_ + NWAVES < CONV_ITEMS ? lo_ + NWAVES : CONV_ITEMS, F.wave, NWAVES);
            if (j < 32) convert_small_item(F, 0, j * NWAVES + F.wave); } } SEAM(4);
    if (IN(5)) {
        pg8::Gemm g{HB, WSP(bf16_t, WS_WO0), MR, D, D}; pg8::StaticOrder So; So.init(MR, D, F.G, (int)blockIdx.x, RF(5));
        pg8::EpiResBf16<false> E{F.ka->in[0], F.ka->in[1], 15, HR, nullptr};
        p5_meta_rows(F);
        pg8::gemm_phase<pg8::EpiResBf16<false>, pg8::StaticOrder, false>(ring, g, So, E); } SEAM(5);
#define MOE_PHASES(layer, pb) do { \
        if (IN(pb)) REP(pb) { route_phase(F, layer, layer ? MR : MA, rep_ > 0); } SEAM(pb); \
        if (IN((pb) + 1)) { MOE_TABLE(layer); \
            pg8::Gemm g{HR, WSP(bf16_t, layer ? WS_MOEGU1 : WS_MOEGU), MP, NEXP * 512, D}; MoeOrder<2, true> So{TB, WSP(int, WS_LIST), F.G, F.vcu, RF((pb) + 1), F.lds + RING_BYTES + 2048}; \
            EpiGateUp E{WSP(bf16_t, WS_HH), WSP(float, WS_RSL), TB, WSP(int, WS_LIST)}; \
            pg8::gemm_phase<EpiGateUp, MoeOrder<2, true>, true>(ring, g, So, E); \
            if (layer == 0 && F.G == 256) { const int nu_ = (int)TB[32] * 2, rem = nu_ - 256;        \
                if (rem > 0 && rem < 256 && F.vcu >= rem) { const int j = F.vcu - rem; convert_moe(F, 1, j * CONV_PER_WG, (j + 1) * CONV_PER_WG < CONV_ITEMS ? (j + 1) * CONV_PER_WG : CONV_ITEMS, F.wave, NWAVES); } } } SEAM((pb) + 1); \
        if (IN((pb) + 2)) { MOE_TABLE(layer); \
            pg8::Gemm g{WSP(bf16_t, WS_HH), WSP(bf16_t, layer ? WS_MOED1 : WS_MOED), YROWS, NEXP * 1024, 256}; MoeOrder<4, false> So{TB, WSP(int, WS_LIST), F.G, F.vcu, RF((pb) + 2), F.lds + RING_BYTES + 2048}; \
            pg8::EpiScaleBf16 E{WSP(bf16_t, WS_Y), D, nullptr, 4, nullptr, nullptr, 0, TB + 40}; \
            pg8::gemm_phase<pg8::EpiScaleBf16, MoeOrder<4, false>, true>(ring, g, So, E); \
            if (layer == 0 && F.G == 256) { const int nu_ = (int)TB[32] * 4, rem = nu_ % 256, nsh = rem ? 256 - rem : 256;        \
                const int j = rem ? F.vcu - rem : F.vcu; if (j >= 0) for (int it = j * NWAVES + F.wave; it < 640; it += nsh * NWAVES) convert_small_item(F, it < 384 ? 1 : 2, it < 384 ? it : it - 384); } } SEAM((pb) + 2); } while (0)
    MOE_PHASES(0, 6);
    if (IN(9)) REP(9) { MOE_TABLE(0); combine_phase<0>(F, MA, rep_ > 0);
        { const int nu_ = (int)TB[32] * 2, rem = nu_ - 256; const int taken = (F.G == 256 && rem > 0 && rem < 256) ? (256 - rem) * CONV_PER_WG : 0;
          convert_moe(F, 1, taken < CONV_ITEMS ? taken : CONV_ITEMS, CONV_ITEMS, F.vcu * NWAVES + F.wave, F.G * NWAVES); } } SEAM(9);
    if (IN(10)) {
        { LAS float* rt = (LAS float*)(F.lds + RING_BYTES + 2048);
          for (int e = F.tid; e < 1024; e += NWAVES * 64) { const float ang = (float)(e >> 4) * powf(10000.0f, -(float)(2 * (e & 15)) / 32.0f); rt[2 * e] = cosf(ang); rt[2 * e + 1] = sinf(ang); }
          __syncthreads(); }
        pg8::Gemm g{HR, WSP(bf16_t, WS_WAI), MP, NA, D}; pg8::StaticOrder So; So.init(MP, NA, F.G, (int)blockIdx.x, RF(10));
        pg8::EpiQKV E{WSP(bf16_t, WS_U2), SS + MP, F.ka->in[14], F.ka->in[15], (const LAS float*)(F.lds + RING_BYTES + 2048), ATT_C2};
        pg8::gemm_phase<pg8::EpiQKV, pg8::StaticOrder, true>(ring, g, So, E); } SEAM(10);
    if (IN(12)) {
        const attn_body::AttnTensors AT{(const attn_body::bf16*)WSP(bf16_t, WS_U2), (const attn_body::bf16*)WSP(bf16_t, WS_U2), (const attn_body::bf16*)WSP(bf16_t, WS_U2), (attn_body::bf16*)WSP(bf16_t, WS_AO)};
        const attn_body::StaticOrder Sa(F.vcu, RF(12), F.G);
        attn_body::attn_phase<attn_body::StaticOrder>((char*)lds + RING_OFF, AT, Sa);
        } SEAM(12);
    if (IN(13)) {
        pg8::Gemm g{WSP(bf16_t, WS_AO), WSP(bf16_t, WS_WAO), MR, D, D}; pg8::StaticOrder So; So.init(MR, D, F.G, (int)blockIdx.x, 1);
        pg8::EpiResBf16<true> E{nullptr, nullptr, 0, HR, HR};
        pg8::gemm_phase<pg8::EpiResBf16<true>, pg8::StaticOrder, false>(ring, g, So, E); } SEAM(13);
#undef MOE_PHASES
    if (IN(14)) REP(14) { route_phase(F, 1, MR, rep_ > 0); } SEAM(14);
    if (IN(15)) { MOE_TABLE(1);
        pg8::Gemm g{HR, WSP(bf16_t, WS_MOEGU1), MP, NEXP * 512, D}; MoeOrder<2, true> So{TB, WSP(int, WS_LIST), F.G, F.vcu, 1, F.lds + RING_BYTES + 2048, 0, 256};
        EpiGateUp E{WSP(bf16_t, WS_HH), WSP(float, WS_RSL), TB, WSP(int, WS_LIST)};
        pg8::gemm_phase<EpiGateUp, MoeOrder<2, true>, true>(ring, g, So, E); } SEAM(15);
    if (IN(16)) { MOE_TABLE(1);
        const int nGU = (int)TB[32] * 2, nD = (int)TB[32] * 4, remGU = nGU > 256 ? nGU - 256 : 0;
        if (F.vcu < remGU) {
            pg8::Gemm g{HR, WSP(bf16_t, WS_MOEGU1), MP, NEXP * 512, D}; MoeOrder<2, true> So{TB, WSP(int, WS_LIST), F.G, F.vcu, 1, F.lds + RING_BYTES + 2048, 256, 1 << 30};
            EpiGateUp E{WSP(bf16_t, WS_HH), WSP(float, WS_RSL), TB, WSP(int, WS_LIST)};
            pg8::gemm_phase<EpiGateUp, MoeOrder<2, true>, true>(ring, g, So, E);
        } else { const int j = F.vcu - remGU; const int cap = nD < 512 ? nD : 512;
            pg8::Gemm g{WSP(bf16_t, WS_HH), WSP(bf16_t, WS_MOED1), YROWS, NEXP * 1024, 256}; MoeOrder<4, false> So{TB, WSP(int, WS_LIST), 1, 2 * j, 1, F.lds + RING_BYTES + 2048, 0, (2 * j + 2) < cap ? (2 * j + 2) : cap};
            pg8::EpiScaleBf16 E{WSP(bf16_t, WS_Y), D, nullptr, 4, nullptr, nullptr, 0, TB + 40};
            pg8::gemm_phase<pg8::EpiScaleBf16, MoeOrder<4, false>, true>(ring, g, So, E); } } SEAM(16);
    if (IN(17)) { MOE_TABLE(1);
        const int nGU = (int)TB[32] * 2, nD = (int)TB[32] * 4, remGU = nGU > 256 ? nGU - 256 : 0; int nDB = 2 * (256 - remGU); { const int cap = nD < 512 ? nD : 512; if (nDB > cap) nDB = cap; }
        if (F.G != 256) nDB = 0;
        pg8::Gemm g{WSP(bf16_t, WS_HH), WSP(bf16_t, WS_MOED1), YROWS, NEXP * 1024, 256}; MoeOrder<4, false> So{TB, WSP(int, WS_LIST), F.G, F.vcu, 1, F.lds + RING_BYTES + 2048, nDB, 1 << 30};
        pg8::EpiScaleBf16 E{WSP(bf16_t, WS_Y), D, nullptr, 4, nullptr, nullptr, 0, TB + 40};
        pg8::gemm_phase<pg8::EpiScaleBf16, MoeOrder<4, false>, true>(ring, g, So, E); } SEAM(17);
    if (IN(18)) REP(18) { MOE_TABLE(1); combine_phase<1>(F, MR); }
#undef IN
#undef SEAM
}
#if SELFCHECK
struct CK { const float* in[24]; unsigned char* ws; float* out; };
#define CWS(T, off) ((T*)(c.ws + (off)))
__device__ __forceinline__ unsigned hsh(unsigned x) { x ^= x >> 16; x *= 0x7feb352du; x ^= x >> 15; x *= 0x846ca68bu; x ^= x >> 16; return x; }
__device__ __forceinline__ void ck_fail(const CK& c, unsigned code) { atomicCAS((unsigned*)(c.ws + WS_CTL) + CW_FLAG, 0u, code); }
__device__ __forceinline__ bool ck_bad(float a, float ref, float rtol, float atol) { return !(fabsf(a - ref) <= rtol * fabsf(ref) + atol); }
__device__ __forceinline__ float bfr(float x) { return bf2f(f2bf(x)); }
__device__ __forceinline__ float dot_bf(const bf16_t* a, const bf16_t* b, int K) { float s = 0.f; for (int k = 0; k < K; ++k) s += bf2f(a[k]) * bf2f(b[k]); return s; }

__device__ __forceinline__ int wai_row(int col) { const int tl = col >> 8, hd = (col >> 6) & 3, dm = col & 63; return tl < 5 ? tl * 256 + (dm >> 5) * 128 + hd * 32 + (dm & 31) : col; }
__device__ __forceinline__ int win_row(int col) { if (col >= 512 && col < 1024) { const int x = col - 512; return (2 + (x >> 7)) * 256 + (x & 127); } if (col >= 1024 && col < 1536) { const int x = col - 1024; return (2 + (x >> 7)) * 256 + 128 + (x & 127); } return col; }
__global__ void ck_prologue(CK c, int layer, unsigned code, int with_small) {
    const unsigned id = blockIdx.x * 256 + threadIdx.x, r = hsh(id * 3 + 1), r2 = hsh(id * 3 + 2);
    const bf16_t* GU = CWS(bf16_t, layer ? WS_MOEGU1 : WS_MOEGU); const bf16_t* DW = CWS(bf16_t, layer ? WS_MOED1 : WS_MOED); const float* gain = c.in[3] + layer * D;
    if (!with_small) {
    { const int e = r & 31, row = (r >> 5) & 511, k = (r >> 14) & 1023, pnl = row >> 8, cc = row & 255;
      const float* W = (cc < 128 ? c.in[21] : c.in[22]) + ((size_t)layer * NEXP + e) * D * 256; const float ref = bfr(W[(size_t)k * 256 + pnl * 128 + (cc & 127)] * gain[k]);
      if (ck_bad(bf2f(GU[((size_t)e * 512 + row) * D + k]), ref, 1e-6f, 1e-12f)) ck_fail(c, code); }
    { const int e = r2 & 31, n = (r2 >> 5) & 1023, k = (r2 >> 15) & 255; const float ref = bfr(c.in[23][(((size_t)layer * NEXP + e) * 256 + k) * D + n]);
      if (ck_bad(bf2f(DW[((size_t)e * 1024 + n) * 256 + k]), ref, 1e-6f, 1e-12f)) ck_fail(c, code); }
    return; }
    { const int n = r % 3072, k = (r2 >> 3) & 1023; const float ref = bfr(c.in[5][(size_t)k * 3104 + n] * c.in[2][k]);
      if (ck_bad(bf2f(CWS(bf16_t, WS_WIN)[(size_t)win_row(n) * D + k]), ref, 1e-6f, 1e-12f)) ck_fail(c, code); }
    if (with_small == 1) { const int n = r2 & 1023, k = (r >> 7) & 1023;
      if (ck_bad(bf2f(CWS(bf16_t, WS_WO0)[(size_t)n * D + k]), bfr(c.in[12][(size_t)k * D + n]), 1e-6f, 1e-12f)) ck_fail(c, code);
      if (ck_bad(bf2f(CWS(bf16_t, WS_WAO)[(size_t)n * D + k]), bfr(c.in[16][(size_t)k * D + n]), 1e-6f, 1e-12f)) ck_fail(c, code);
      const int n2 = r % NA; if (ck_bad(bf2f(CWS(bf16_t, WS_WAI)[(size_t)wai_row(n2) * D + k]), bfr(c.in[13][(size_t)k * NA + n2] * c.in[2][D + k]), 1e-6f, 1e-12f)) ck_fail(c, code); }
    if (with_small == 1) { const int l = r & 1, j = (r >> 1) % 48, k = (r2 >> 9) & 1023; float w = (j < 4) ? c.in[17][((size_t)l * D + k) * 4 + j] : (j < 36) ? c.in[19][((size_t)l * D + k) * 32 + j - 4] : 0.f; w *= c.in[3][l * D + k];
      const bf16_t* WR = CWS(bf16_t, WS_WR); const float got = bf2f(WR[((size_t)(l * 2) * 48 + j) * D + k]) + bf2f(WR[((size_t)(l * 2 + 1) * 48 + j) * D + k]);
      if (ck_bad(got, w, 1e-4f, 1e-9f)) ck_fail(c, code); }
    if (with_small == 2) { const int row = r % MP, k = r2 & 1023; float ref = 0.f, ss = 0.f;
      if (row < MA) { const float* src = row < MR ? c.in[0] + (size_t)row * D : c.in[1] + (size_t)((row - MR) & 15) * D; ref = bfr(src[k]); for (int i = 0; i < D; ++i) ss += src[i] * src[i]; }
      if (ck_bad(bf2f(CWS(bf16_t, WS_HB)[(size_t)row * D + k]), ref, 1e-6f, 1e-12f)) ck_fail(c, code + 20);
      if (ck_bad(CWS(float, WS_SS)[row], ss, 1e-4f, 1e-6f)) ck_fail(c, code + 20); }
}
__global__ void ck_gemm_bf16(CK c, size_t offA, size_t offB, size_t offO, int ldo, size_t offSS, int M, int N, int K, unsigned code) {
    const unsigned id = blockIdx.x * 64 + threadIdx.x, r = hsh(id * 2 + 11), r2 = hsh(id * 2 + 12);
    int row = r % M, col = r2 % N; if ((id & 7) == 0) row = M - 1 - (r % 300 % M); if ((id & 7) == 1) col = N - 1 - (r2 % 40);
    const float sc = offSS ? pg8::rs_of(CWS(float, offSS)[row]) : 1.0f;
    const float ref = sc * dot_bf(CWS(bf16_t, offA) + (size_t)row * K, CWS(bf16_t, offB) + (size_t)col * K, K);
    if (ck_bad(bf2f(CWS(bf16_t, offO)[(size_t)row * ldo + col]), ref, 0.015f, 0.02f)) ck_fail(c, code);
}
__global__ void ck_u(CK c, unsigned code) {
    const unsigned id = blockIdx.x * 64 + threadIdx.x, r = hsh(id * 2 + 11), r2 = hsh(id * 2 + 12);
    int row = r % MA; const int ucol = r2 % U_LA; if ((id & 7) == 0) row = MA - 1 - (r % 300);
    const float sc = pg8::rs_of(CWS(float, WS_SS)[row]); const bf16_t* hb = CWS(bf16_t, WS_HB) + (size_t)row * D; const bf16_t* WT = CWS(bf16_t, WS_WIN); float ref;
    if (ucol >= U_Z && ucol < U_Z + 512) { const int ch = ucol - U_Z; ref = (sc * dot_bf(hb, WT + (size_t)win_row(512 + ch) * D, D)) * (sc * dot_bf(hb, WT + (size_t)win_row(1024 + ch) * D, D)); }
    else { const int oc = ucol < 512 ? ucol : ucol + 512; ref = sc * dot_bf(hb, WT + (size_t)win_row(oc) * D, D); }
    if (ck_bad(bf2f(CWS(bf16_t, WS_BIG)[(size_t)row * NU + ucol]), ref, 0.02f, 0.02f)) ck_fail(c, code);
}
__device__ __forceinline__ float ck_loga(const CK& c, const bf16_t* U, int row, int dir, int ch) { return bf2f(U[(size_t)row * NU + U_LA + dir * 256 + ch]); }
__global__ void ck_la(CK c, unsigned code) {
    const unsigned id = blockIdx.x * 64 + threadIdx.x, r = hsh(id + 90210); const int row = r % MA, dir = (r >> 15) & 1, ch = (r >> 16) & 255;
    const float* src = row < MR ? c.in[0] + (size_t)row * D : c.in[1] + (size_t)((row - MR) & 15) * D; float ss = 0.f; for (int k = 0; k < D; ++k) ss += src[k] * src[k];
    const float rs = pg8::rs_of(ss); float z = (dir ? c.in[10] : c.in[8])[ch];
    for (int j = 0; j < 16; ++j) { float g = 0.f; for (int k = 0; k < D; ++k) g += src[k] * rs * c.in[2][k] * c.in[5][(size_t)k * 3104 + 3072 + 16 * dir + j]; z += g * (dir ? c.in[9] : c.in[7])[j * 256 + ch]; }
    if (ck_bad(bf2f(CWS(bf16_t, WS_BIG)[(size_t)row * NU + U_LA + dir * 256 + ch]), log_sigmoid(z) * 0.0625f, 0.03f, 0.003f)) ck_fail(c, code);
}
__global__ void ck_scan(CK c, unsigned code) {
    const unsigned id = blockIdx.x * 64 + threadIdx.x, r = hsh(id + 77);
    const int b = r & 7, h = (r >> 3) & 3, dir = (r >> 5) & 1, n = (r >> 6) % NCH, v = (r >> 12) & 127, d = (r >> 19) & 63;
    const bf16_t* U = CWS(bf16_t, WS_BIG); float Sx = 0.f;
    const int start = n == 0 ? 0 : NM + (n - 1) * 64, end = n == 0 ? NM : NM + n * 64;
    if (dir == 0) { for (int tp = 0; tp < start; ++tp) { const int row = tok_row(b, tp); const float a = expf(ck_loga(c, U, row, 0, h * 64 + d));
            Sx = a * Sx + bf2f(U[(size_t)row * NU + U_K + h * 64 + d]) * bf2f(U[(size_t)row * NU + U_V + h * 128 + v]); } }
    else { for (int tp = T - 1; tp >= end; --tp) { const int row = tok_row(b, tp); const float a = expf(ck_loga(c, U, row, 1, h * 64 + d));
            Sx = a * Sx + bf2f(U[(size_t)row * NU + U_K + h * 64 + d]) * bf2f(U[(size_t)row * NU + U_V + h * 128 + v]); } }
    const float got = bf2f(CWS(bf16_t, WS_H)[((size_t)((b * 4 + h) * 2 + dir) * NCH + n) * 8192 + v * 64 + d]);
    if (ck_bad(got, Sx, 0.04f, 0.15f)) ck_fail(c, code);
}
__global__ void __launch_bounds__(128) ck_glaout(CK c, unsigned code) {
    __shared__ float red[2];
    const unsigned r = hsh(blockIdx.x + 1234); const int b = r & 7, h = (r >> 3) & 3; int tp = (r >> 5) % T; if (blockIdx.x < 8) tp = blockIdx.x * 3; if (blockIdx.x >= 8 && blockIdx.x < 12) tp = T - 1 - (blockIdx.x - 8) * 21;
    const int v = threadIdx.x; const bf16_t* U = CWS(bf16_t, WS_BIG);
    float Sx[64];
#pragma unroll
    for (int d = 0; d < 64; ++d) Sx[d] = 0.f;
    float of = 0.f, ob = 0.f;
    for (int t2 = 0; t2 <= tp; ++t2) { const size_t row = tok_row(b, t2); const float vv = bf2f(U[row * NU + U_V + h * 128 + v]); float o = 0.f;
#pragma unroll
        for (int d = 0; d < 64; ++d) { const float a = expf(ck_loga(c, U, (int)row, 0, h * 64 + d)); Sx[d] = a * Sx[d] + bf2f(U[row * NU + U_K + h * 64 + d]) * vv; o += bf2f(U[row * NU + U_Q + h * 64 + d]) * Sx[d]; }
        of = o; }
#pragma unroll
    for (int d = 0; d < 64; ++d) Sx[d] = 0.f;
    for (int t2 = T - 1; t2 >= tp; --t2) { const size_t row = tok_row(b, t2); const float vv = bf2f(U[row * NU + U_V + h * 128 + v]); float o = 0.f;
#pragma unroll
        for (int d = 0; d < 64; ++d) { const float a = expf(ck_loga(c, U, (int)row, 1, h * 64 + d)); const float as = a * Sx[d]; o += bf2f(U[row * NU + U_Q + h * 64 + d]) * as; Sx[d] = as + bf2f(U[row * NU + U_K + h * 64 + d]) * vv; }
        ob = o; }
    const float o = (of + ob) * 0.125f; float ss = wave_sum(o * o);
    if ((v & 63) == 0) red[v >> 6] = ss;
    __syncthreads();
    const size_t row = tok_row(b, tp); const float rs = rsqrtf((red[0] + red[1]) * (1.0f / 128.0f) + EPS); const float rr = bf2f(U[row * NU + U_R + h * 128 + v]);
    const float ref = o * rs * c.in[11][v] * (rr / (1.0f + expf(-rr)));
    if (ck_bad(bf2f(CWS(bf16_t, WS_HB)[row * D + 512 + h * 128 + v]), ref, 0.04f, 0.04f)) ck_fail(c, code);
    { const int ch = h * 128 + v; float z[3];
      for (int dd = -1; dd <= 1; ++dd) { const int t3 = tp + dd; z[dd + 1] = (t3 >= 0 && t3 < T) ? bf2f(U[(size_t)tok_row(b, t3) * NU + U_Z + ch]) : 0.f; }
      const float refc = bf2f(U[row * NU + U_AB + ch]) * (c.in[6][ch] * z[0] + c.in[6][512 + ch] * z[1] + c.in[6][1024 + ch] * z[2]);
      if (ck_bad(bf2f(CWS(bf16_t, WS_HB)[row * D + ch]), refc, 0.02f, 0.02f)) ck_fail(c, code + 20); }
}
__global__ void ck_outproj0(CK c, unsigned code) {
    const unsigned id = blockIdx.x * 64 + threadIdx.x, r = hsh(id * 2 + 5), r2 = hsh(id * 2 + 6); int row = r % MA; const int col = r2 & 1023; if ((id & 3) == 0) row = MA - 1 - (r % 200);
    const float emb = row < MR ? c.in[0][(size_t)row * D + col] : c.in[1][(size_t)((row - MR) & 15) * D + col];
    const float ref = emb + dot_bf(CWS(bf16_t, WS_HB) + (size_t)row * D, CWS(bf16_t, WS_WO0) + (size_t)col * D, D);
    if (ck_bad(bf2f(CWS(bf16_t, WS_H)[(size_t)row * D + col]), ref, 0.015f, 0.02f)) ck_fail(c, code);
}
__global__ void ck_route(CK c, int layer, int nrows, unsigned code) {
    const unsigned id = blockIdx.x * 64 + threadIdx.x, r = hsh(id + 999 + layer); const int row = r % nrows;
    const bf16_t* hr = CWS(bf16_t, WS_H) + (size_t)row * D; const float* gain = c.in[3] + layer * D;
    float lg[4], le[32]; float ss = 0.f;
#pragma unroll
    for (int j = 0; j < 4; ++j) lg[j] = 0.f;
#pragma unroll
    for (int j = 0; j < 32; ++j) le[j] = 0.f;
    for (int k = 0; k < D; ++k) { const float x = bf2f(hr[k]); ss += x * x; const float xg = x * gain[k];
#pragma unroll
        for (int j = 0; j < 4; ++j) lg[j] += xg * c.in[17][((size_t)layer * D + k) * 4 + j];
#pragma unroll
        for (int j = 0; j < 32; ++j) le[j] += xg * c.in[19][((size_t)layer * D + k) * 32 + j]; }
    const float rs = pg8::rs_of(ss);
#pragma unroll
    for (int j = 0; j < 4; ++j) lg[j] = lg[j] * rs + c.in[18][layer * 4 + j];
#pragma unroll
    for (int j = 0; j < 32; ++j) le[j] = le[j] * rs + c.in[20][layer * 32 + j];
    int gi = 0; float gm = lg[0], g2 = -INFINITY;
#pragma unroll
    for (int j = 1; j < 4; ++j) if (lg[j] > gm) { gm = lg[j]; gi = j; }
#pragma unroll
    for (int j = 0; j < 4; ++j) if (j != gi && lg[j] > g2) g2 = lg[j];
    float gs = 0.f;
#pragma unroll
    for (int j = 0; j < 4; ++j) gs += expf(lg[j] - gm);
    const float gp = 1.0f / gs; float es[8];
#pragma unroll
    for (int j = 0; j < 8; ++j) es[j] = gi == 0 ? le[j] : gi == 1 ? le[8 + j] : gi == 2 ? le[16 + j] : le[24 + j];
    int i0 = 0; float v0 = es[0];
#pragma unroll
    for (int j = 1; j < 8; ++j) if (es[j] > v0) { v0 = es[j]; i0 = j; }
    int i1 = 0; float v1 = -INFINITY, v2 = -INFINITY;
#pragma unroll
    for (int j = 0; j < 8; ++j) if (j != i0 && es[j] > v1) { v1 = es[j]; i1 = j; }
#pragma unroll
    for (int j = 0; j < 8; ++j) if (j != i0 && j != i1 && es[j] > v2) v2 = es[j];
    const float e1 = expf(v1 - v0), w0 = gp / (1.0f + e1), w1 = gp * e1 / (1.0f + e1);
    const unsigned* RI = CWS(unsigned, WS_RI) + (size_t)row * 8; const float gw0 = __uint_as_float(RI[4]), gw1 = __uint_as_float(RI[5]);
    const bool tie = (gm - g2 < 1e-3f) || (v1 - v2 < 1e-3f) || (v0 - v1 < 1e-3f);
    if (!tie) { if ((int)RI[0] != gi * 8 + i0 || (int)RI[1] != gi * 8 + i1) ck_fail(c, code); if (ck_bad(gw0, w0, 2e-3f, 1e-4f) || ck_bad(gw1, w1, 2e-3f, 1e-4f)) ck_fail(c, code); }
    const int* LIST = CWS(int, WS_LIST); const unsigned* CNT = (const unsigned*)(c.ws + WS_CTL) + (layer ? CW_CNT1 : CW_CNT0);
    if (RI[0] >= 32u || RI[1] >= 32u || RI[2] >= CNT[RI[0]] || RI[3] >= CNT[RI[1]]) { ck_fail(c, code + 20); return; }
    if (LIST[(size_t)RI[0] * MA + RI[2]] != row || LIST[(size_t)RI[1] * MA + RI[3]] != row) ck_fail(c, code + 20);
    if (ck_bad(CWS(float, WS_SS)[2 * MP + row], rs, 1e-4f, 0.f)) ck_fail(c, code + 20);
    if (id == 0) { unsigned tot = 0; for (int e = 0; e < 32; ++e) tot += CNT[e]; if (tot != 2u * (unsigned)nrows) ck_fail(c, code + 40); }
}
__global__ void ck_moe(CK c, int layer, unsigned code) {
    const unsigned id = blockIdx.x * 64 + threadIdx.x, r = hsh(id * 2 + 31), r2 = hsh(id * 2 + 32);
    const unsigned* CNT = (const unsigned*)(c.ws + WS_CTL) + (layer ? CW_CNT1 : CW_CNT0);
    const int e = r & 31; unsigned tb = 0; for (int j = 0; j < e; ++j) tb += (CNT[j] + 255u) >> 8;
    const unsigned cnt = CNT[e]; if (cnt == 0) return; unsigned idx = (r >> 5) % cnt; if ((id & 3) == 0) idx = cnt - 1 - ((r >> 5) % (cnt < 64 ? cnt : 64));
    const int tok = CWS(int, WS_LIST)[(size_t)e * MA + idx]; const float rs = CWS(float, WS_SS)[2 * MP + tok]; const size_t prow = (size_t)tb * 256 + idx;
    const bf16_t* hb = CWS(bf16_t, WS_H) + (size_t)tok * D; const bf16_t* GU = CWS(bf16_t, layer ? WS_MOEGU1 : WS_MOEGU); const bf16_t* HH = CWS(bf16_t, WS_HH);
    { const int j = r2 & 255; const bf16_t* wg = GU + ((size_t)e * 512 + (j >> 7) * 256 + (j & 127)) * D; const float g = rs * dot_bf(hb, wg, D), u = rs * dot_bf(hb, wg + (size_t)128 * D, D);
      const float ref = g / (1.0f + expf(-g)) * u; if (ck_bad(bf2f(HH[prow * 256 + j]), ref, 0.03f, 0.02f)) ck_fail(c, code); }
    { const int n = (r2 >> 8) & 1023; const float ref = dot_bf(HH + prow * 256, CWS(bf16_t, layer ? WS_MOED1 : WS_MOED) + ((size_t)e * 1024 + n) * 256, 256);
      if (ck_bad(bf2f(CWS(bf16_t, WS_Y)[prow * D + n]), ref, 0.02f, 0.02f)) ck_fail(c, code + 1); }
}
__global__ void ck_combine(CK c, unsigned code) {
    const unsigned id = blockIdx.x * 64 + threadIdx.x, r = hsh(id + 4242); const int row = r % MA; const bf16_t* hr = CWS(bf16_t, WS_H) + (size_t)row * D; float ss = 0.f;
    for (int i = 0; i < D; ++i) ss += bf2f(hr[i]) * bf2f(hr[i]);
    if (ck_bad(CWS(float, WS_SS)[MP + row], ss, 1e-4f, 1e-6f)) ck_fail(c, code);
}
__global__ void __launch_bounds__(64) ck_qk(CK c, unsigned code) {
    const unsigned r = hsh(blockIdx.x + 555); int row = r % MA; const int head = (r >> 15) % 20, d = threadIdx.x; if ((blockIdx.x & 7) == 0) row = MR + (r % 128);
    const float sc = pg8::rs_of(CWS(float, WS_SS)[MP + row]); const bf16_t* hb = CWS(bf16_t, WS_H) + (size_t)row * D;
    const float raw = sc * dot_bf(hb, CWS(bf16_t, WS_WAI) + (size_t)wai_row(head * 64 + d) * D, D);
    const float ss = wave_sum(raw * raw); const float xn = raw * rsqrtf(ss * (1.0f / 64.0f) + EPS) * (head < 16 ? c.in[14][d] * ATT_C2 : c.in[15][d]);
    const float pr = __shfl_xor(xn, 1); float cs = 1.f, sn = 0.f;
    if (row < MR) { const int s = row & (S - 1), rr = s >> 6, cc = s & 63, i = d >> 1, f = i < 16 ? i : i - 16; const float ang = (float)(i < 16 ? rr : cc) * powf(10000.0f, -(float)(2 * f) / 32.0f); cs = cosf(ang); sn = sinf(ang); }
    const float ref = (d & 1) ? (pr * sn + xn * cs) : (xn * cs - pr * sn);
    if (ck_bad(bf2f(CWS(bf16_t, WS_U2)[(size_t)row * NA + head * 64 + d]), ref, 0.03f, head < 16 ? 0.006f : 0.03f)) ck_fail(c, code);
    const int vc = 1280 + ((r >> 20) & 3) * 64 + d; const float refv = sc * dot_bf(hb, CWS(bf16_t, WS_WAI) + (size_t)wai_row(vc) * D, D);
    if (ck_bad(bf2f(CWS(bf16_t, WS_U2)[(size_t)row * NA + vc]), refv, 0.015f, 0.02f)) ck_fail(c, code + 20);
}
__global__ void __launch_bounds__(64) ck_attn(CK c, unsigned code) {
    __shared__ float qs[64], sc[T];
    const unsigned r = hsh(blockIdx.x + 31337); const int b = r & 7, h = (r >> 3) & 15, s = (r >> 7) & 2047, kvh = h >> 2, tid = threadIdx.x; const bf16_t* U2 = CWS(bf16_t, WS_U2);
    qs[tid] = bf2f(U2[((size_t)b * S + s) * NA + h * 64 + tid]);
    __syncthreads();
    float mx = -INFINITY;
    for (int j = tid; j < T; j += 64) { const bf16_t* kp = U2 + (size_t)tok_row(b, j) * NA + 1024 + kvh * 64; float a = 0.f; for (int d = 0; d < 64; ++d) a += qs[d] * bf2f(kp[d]); sc[j] = a; mx = fmaxf(mx, a); }
#pragma unroll
    for (int o = 1; o < 64; o <<= 1) mx = fmaxf(mx, __shfl_xor(mx, o));
    __syncthreads();
    float l = 0.f, acc = 0.f;
    for (int j = 0; j < T; ++j) { const float p = exp2f(sc[j] - mx); l += p; acc += p * bf2f(U2[(size_t)tok_row(b, j) * NA + 1280 + kvh * 64 + tid]); }
    const float ref = acc / l;
    if (ck_bad(bf2f(CWS(bf16_t, WS_AO)[((size_t)b * S + s) * D + h * 64 + tid]), ref, 0.04f, 0.004f)) ck_fail(c, code);
}
__global__ void ck_report(CK c, int always_zero) {
    const unsigned code = ((const unsigned*)(c.ws + WS_CTL))[CW_FLAG];
    const size_t i = (size_t)blockIdx.x * 256 + threadIdx.x;
    if (code) c.out[i] = sqrtf((float)code); else if (always_zero) c.out[i] = 0.f;
}
#endif
extern "C" void kernel_launch(void* const* d_in, const int* in_sizes, int n_in, void* d_out, int out_size, void* d_ws, size_t ws_size, hipStream_t stream) {
    static int grid = 0;
    if (grid == 0) {
        if (n_in != 24 || out_size != MR * D || ws_size < WS_END) { fprintf(stderr, "kernel_launch: unexpected shapes / workspace (%d inputs, out %d, ws %zu < %zu)\n", n_in, out_size, ws_size, (size_t)WS_END); grid = -1; return; }
        int dev = 0, cus = 0;
        if (hipGetDevice(&dev) != hipSuccess || hipDeviceGetAttribute(&cus, hipDeviceAttributeMultiprocessorCount, dev) != hipSuccess) { grid = -1; return; }
        if (hipFuncSetAttribute((const void*)mega, hipFuncAttributeMaxDynamicSharedMemorySize, LDS_BYTES) != hipSuccess) { fprintf(stderr, "kernel_launch: hipFuncSetAttribute failed\n"); grid = -1; return; }
        int per_cu = 0; (void)hipOccupancyMaxActiveBlocksPerMultiprocessor(&per_cu, (const void*)mega, NWAVES * 64, LDS_BYTES); (void)hipGetLastError();
        if (per_cu < 1) fprintf(stderr, "kernel_launch: occupancy query reports %d blocks per CU\n", per_cu);
        grid = cus;
    }
    if (grid < 0) return;
    (void)hipMemsetAsync((char*)d_ws + WS_CTL, 0, CTL_ZERO_BYTES, stream);
    Args a{};
    for (int i = 0; i < 24; ++i) a.in[i] = (const float*)d_in[i];
    a.out = (float*)d_out; a.ws = (unsigned char*)d_ws;
#if SELFCHECK
    CK c{}; for (int i = 0; i < 24; ++i) c.in[i] = (const float*)d_in[i]; c.ws = (unsigned char*)d_ws; c.out = (float*)d_out;
#define RUN(lo_, hi_) do { a.ph_lo = (lo_); a.ph_hi = (hi_); hipLaunchKernelGGL(mega, dim3(grid), dim3(NWAVES * 64), LDS_BYTES, stream, a); } while (0)
    RUN(0, 1); hipLaunchKernelGGL(ck_prologue, dim3(64), dim3(256), 0, stream, c, 0, 1u, 2);
    RUN(1, 2); hipLaunchKernelGGL(ck_u, dim3(64), dim3(64), 0, stream, c, 2u); hipLaunchKernelGGL(ck_la, dim3(16), dim3(64), 0, stream, c, 3u);
    RUN(2, 3); RUN(3, 4); hipLaunchKernelGGL(ck_scan, dim3(16), dim3(64), 0, stream, c, 4u);
    RUN(4, 5); hipLaunchKernelGGL(ck_glaout, dim3(96), dim3(128), 0, stream, c, 5u); hipLaunchKernelGGL(ck_prologue, dim3(64), dim3(256), 0, stream, c, 0, 1u, 0);
    RUN(5, 6); hipLaunchKernelGGL(ck_outproj0, dim3(64), dim3(64), 0, stream, c, 6u);
    RUN(6, 7); hipLaunchKernelGGL(ck_route, dim3(8), dim3(64), 0, stream, c, 0, MA, 7u);
    RUN(7, 8); RUN(8, 9); hipLaunchKernelGGL(ck_moe, dim3(64), dim3(64), 0, stream, c, 0, 8u); hipLaunchKernelGGL(ck_prologue, dim3(64), dim3(256), 0, stream, c, 0, 1u, 1);
    RUN(9, 10); hipLaunchKernelGGL(ck_combine, dim3(8), dim3(64), 0, stream, c, 10u); hipLaunchKernelGGL(ck_prologue, dim3(64), dim3(256), 0, stream, c, 1, 11u, 0);
    RUN(10, 11); RUN(11, 12); hipLaunchKernelGGL(ck_qk, dim3(1024), dim3(64), 0, stream, c, 12u);
    RUN(12, 13); hipLaunchKernelGGL(ck_attn, dim3(512), dim3(64), 0, stream, c, 13u);
    RUN(13, 14);
    RUN(14, 15); hipLaunchKernelGGL(ck_route, dim3(8), dim3(64), 0, stream, c, 1, MR, 15u);
    RUN(15, 16); RUN(16, 17); RUN(17, 18); hipLaunchKernelGGL(ck_moe, dim3(64), dim3(64), 0, stream, c, 1, 16u);
    RUN(18, 19); hipLaunchKernelGGL(ck_report, dim3(MR * D / 256), dim3(256), 0, stream, c, 0);
#undef RUN
#elif N_LAUNCH_MODE == 0
    for (int p = 0; p < NPHASE; ++p) { a.ph_lo = p; a.ph_hi = p + 1; hipLaunchKernelGGL(mega, dim3(grid), dim3(NWAVES * 64), LDS_BYTES, stream, a); }
#else
    a.ph_lo = 0; a.ph_hi = NPHASE;
    hipLaunchKernelGGL(mega, dim3(grid), dim3(NWAVES * 64), LDS_BYTES, stream, a);
#endif
}
```

```cpp
#include <hip/hip_runtime.h>
#include <hip/hip_bf16.h>
#include <cstdint>
#include <cstdio>
#include <cmath>

#ifndef SELFCHECK
#define SELFCHECK 0
#endif
#ifndef N_LAUNCH_MODE
#define N_LAUNCH_MODE 1
#endif

constexpr int Bz = 8, S = 2048, D = 1024, NM = 16, T = S + NM;
constexpr int MR = Bz * S;
constexpr int MA = MR + Bz * NM;
constexpr int MP = 16640;
constexpr int NU = 3072;
constexpr int NG1 = 3584;
__host__ __device__ __forceinline__ size_t uoff(int row, int col) { return (size_t)(col >> 8) * ((size_t)16640 * 256) + (size_t)row * 256 + (size_t)(col & 255); }
constexpr int U_AB = 0, U_Z = 512, U_Q = 1024, U_K = 1280, U_V = 1536, U_R = 2048, U_LA = 2560;
constexpr int W_LA = 3072;
constexpr int NA = 1536;
constexpr int NCH = 33;
constexpr int YROWS = 41216;
constexpr int NEXP = 32;
constexpr float EPS = 1e-6f;

typedef unsigned short bf16_t;

constexpr size_t MiB = 1u << 20;
constexpr size_t WS_CTL = 0, CTL_ZERO_BYTES = 32 * 1024;
constexpr size_t WS_ROPE = 1 * MiB;
constexpr size_t WS_WR = WS_ROPE + 512 * 1024;
constexpr size_t WS_SS = WS_WR + 384 * 1024;
constexpr size_t WS_RI = WS_SS + 256 * 1024;
constexpr size_t WS_DEC = WS_RI + 1 * MiB;
constexpr size_t WS_LIST = WS_DEC + 1 * MiB;
constexpr size_t WS_SMALLW = 6 * MiB + 256 * 1024;
constexpr size_t SZ_WIN = (size_t)NG1 * D * 2, SZ_WSQ = (size_t)D * D * 2, SZ_WAI = (size_t)NA * D * 2;
constexpr size_t WS_WIN = WS_SMALLW, WS_WO0 = WS_WIN + SZ_WIN, WS_WAI = WS_WO0 + SZ_WSQ, WS_WAO = WS_WAI + SZ_WAI;
constexpr size_t WS_MOEGU = WS_WAO + SZ_WSQ;
constexpr size_t WS_MOED = WS_MOEGU + (size_t)NEXP * 512 * D * 2;
constexpr size_t WS_H = WS_MOED + (size_t)NEXP * D * 256 * 2;
constexpr size_t WS_HB = WS_H + (size_t)MP * D * 4;
constexpr size_t WS_BIG = WS_HB + (size_t)MP * D * 2;
constexpr size_t SZ_BIG = (size_t)MP * 3328 * 2;
constexpr size_t WS_Y = WS_BIG, WS_HH = WS_Y + (size_t)YROWS * D * 2, WS_U2 = WS_BIG, WS_AO = WS_U2 + (size_t)MP * NA * 2;
constexpr size_t WS_HR8A = WS_Y + (size_t)YROWS * D;
static_assert(WS_HR8A + (size_t)MP * D <= WS_HH, "layer-0 fp8(h) fits behind the fp8 Y");
constexpr size_t WS_RSL = WS_HH + (size_t)YROWS * 256 * 2;
constexpr size_t WS_END = WS_BIG + SZ_BIG;
static_assert(WS_RSL + (size_t)NEXP * MA * 4 <= WS_BIG + SZ_BIG, "RSL fits behind HH");
constexpr size_t WS_MOEGU1 = WS_H + 33 * MiB, WS_MOED1 = WS_HB;
constexpr size_t WS_HR8 = WS_HB + 16 * MiB;
static_assert(WS_MOED1 + (size_t)NEXP * D * 256 * 2 <= WS_HR8 && WS_HR8 + (size_t)MP * D <= WS_HB + (size_t)MP * D * 2, "HR8 fits behind the layer-1 down weights");
constexpr int F8_WSHIFT = 6, F8_OSHIFT = 4;
constexpr size_t WS_HB0 = WS_H + 33 * MiB;
static_assert(WS_HB0 + (size_t)MR * D * 2 == WS_HB, "HB0 real rows end where the HB region starts");
static_assert(WS_MOEGU1 + (size_t)NEXP * 512 * D * 2 <= WS_HB && (size_t)MP * D * 2 <= 33 * MiB && (size_t)NEXP * D * 256 * 2 <= (size_t)MP * D * 2, "layer-1 MoE weight buffers");
static_assert(WS_HH + (size_t)YROWS * 256 * 2 <= WS_END && WS_AO + (size_t)MR * D * 2 <= WS_END, "BIG overlays");
static_assert(WS_LIST + (size_t)NEXP * MA * 4 <= WS_SMALLW, "small area");
static_assert((size_t)Bz * 4 * 2 * NCH * 128 * 64 * 2 <= (size_t)MP * D * 4, "KVSB fits in H");
constexpr int CW_FLAG = 8;
constexpr int CW_CNT0 = 1024, CW_CNT1 = 2048, CNT_STRIDE = 32;
constexpr int CW_CONV0 = 192, CW_CONV1 = 256;
constexpr int CW_BAR = 4096;
static_assert((CW_BAR + 3456) * 4 <= (int)CTL_ZERO_BYTES, "barrier words inside the per-call memset");
__device__ __forceinline__ int lane_now() { int l; asm volatile("v_mbcnt_lo_u32_b32 %0, -1, 0\n\tv_mbcnt_hi_u32_b32 %0, -1, %0" : "=v"(l)); return l; }
__device__ __forceinline__ unsigned f8pack4(float x0, float x1, float x2, float x3) { unsigned w = 0u; w = (unsigned)__builtin_amdgcn_cvt_pk_fp8_f32(x0, x1, (int)w, false); w = (unsigned)__builtin_amdgcn_cvt_pk_fp8_f32(x2, x3, (int)w, true); return w; }
constexpr bool MOE0_FP8 = true;
constexpr bool Y0_FP8 = true;
constexpr int F8_YSHIFT = 4;
constexpr int F8_HSHIFT = 2;
#ifndef WT_STORES
#define WT_STORES 0
#endif
#if WT_STORES
#define ST16WT(p, v) asm volatile("global_store_dwordx4 %0, %1, off sc1\n\ts_nop 1" :: "v"((const void*)(p)), "v"(v))
#else
#define ST16WT(p, v) (*(__typeof__((v) + (v))*)(p) = (v))
#endif
namespace pg8 {
#define PG8_LAS __attribute__((address_space(3)))
typedef short bf16x8 __attribute__((ext_vector_type(8)));
typedef float f32x4 __attribute__((ext_vector_type(4)));
typedef unsigned u32x4 __attribute__((ext_vector_type(4)));
constexpr int BM = 256, BK = 64, HALF = 128, HTB = HALF * BK * 2  , STAGE_BYTES = 8 * HTB, NXCD = 8, WGM = 8;

__host__ __device__ __forceinline__ int lds_byte(int r, int c) { const int st = (r >> 4) * 2 + (c >> 5), rr = r & 15, cc = c & 31, ob = rr * 64 + cc * 2; return st * 1024 + (ob ^ (((ob >> 9) & 1) << 5)); }
__host__ __device__ __forceinline__ void stage_rc(int b, int& R, int& C) { const int st = b / 1024, sb = b % 1024, swz = sb ^ (((sb >> 9) & 1) << 5); R = (st >> 1) * 16 + swz / 64; C = (st & 1) * 32 + (swz % 64) / 2; }
__host__ __device__ __forceinline__ int perm32(int rho) { const int n = rho >> 4, i = rho & 15; return 8 * (i >> 2) + 4 * n + (i & 3); }

struct Unit { int pm, pn, e, mt; };
struct Gemm { const bf16_t* A; const bf16_t* Bt; int M, N, K; int scl = 127; };

struct StaticOrder {
    static constexpr bool GATHER = false;
    int nM, nN, nwg, G, c, rep, off = 0, lim = 1 << 30;
    __host__ __device__ void init(int M, int N, int G_, int c_, int rep_ = 1) { nM = M / BM; nN = N / BM; nwg = nM * nN; G = G_; c = c_; rep = rep_; }
    __host__ __device__ bool next(int i, Unit& u) const {
        long L = (long)i * G + c + off; if (L >= (long)nwg * rep || L >= lim) return false; L %= nwg;
        int wgid = (int)L; { const int q = nwg / NXCD, r = nwg % NXCD, xcd = wgid % NXCD, off = wgid / NXCD; wgid = (xcd < r ? xcd * (q + 1) : r * (q + 1) + (xcd - r) * q) + off; }
        const int nig = WGM * nN, gid = wgid / nig, fm = gid * WGM, gsz = (nM - fm) < WGM ? (nM - fm) : WGM;
        u.pm = fm + ((wgid % nig) % gsz); u.pn = (wgid % nig) / gsz; u.e = 0; u.mt = 0; return true;
    }
    PG8_LAS unsigned char* van = nullptr;
    __device__ __forceinline__ unsigned arow(const Unit&, int) const { return 0u; }
    __device__ __forceinline__ void a_ready(const Unit&) const {}
    __device__ __forceinline__ void done(const Unit&) const {}
};

__device__ __forceinline__ unsigned cvt_pk_bf16(float lo, float hi) { unsigned r; asm volatile("v_cvt_pk_bf16_f32 %0, %1, %2" : "=v"(r) : "v"(lo), "v"(hi)); return r; }

typedef int v8i32 __attribute__((ext_vector_type(8)));
template <class Epi, class Sched, bool ALIGN_EPI = false, bool F8 = false>
__device__ __forceinline__ void gemm_phase(PG8_LAS unsigned char* lds, const Gemm g, const Sched& S, const Epi& E, const int wid) {
    const int lane = lane_now(), tid = wid * 64 + lane, wr = wid >> 2, wc = wid & 3, fr = lane & 15, fq = lane >> 4;
    constexpr int ESZ = F8 ? 1 : 2;
    int K_ = g.K; asm volatile("" : "+s"(K_));
    const int K = K_, nt = K * ESZ / (BK * 2);
    constexpr bool GA = Sched::GATHER;
    unsigned voffB[2];
#pragma unroll
    for (int i = 0; i < 2; ++i) { int R, C; stage_rc(tid * 16 + i * 8192, R, C); const int Rb = Epi::PERM ? ((R & ~31) + perm32(R & 31)) : R;
        voffB[i] = (unsigned)(Rb * K * ESZ + C * 2); }
    const size_t kstep = (size_t)(BK * 2);
    const size_t hstep = (size_t)HALF * K * ESZ;
    const size_t tstep = 2 * hstep;
    const unsigned ldsw = (unsigned)wid * 1024u, ldsb = (unsigned)(size_t)lds;
    int aoffk[2], boffk[2];
#pragma unroll
    for (int k = 0; k < 2; ++k) { aoffk[k] = lds_byte(wr * 64 + fr, fq * 8) + k * 1024; boffk[k] = lds_byte(wc * 32 + fr, fq * 8) + k * 1024; }
    int boffB = boffk[0] + 4 * HTB; asm volatile("" : "+v"(boffB));
    int scl = g.scl * 0x01010101;
    if constexpr (F8) asm volatile("s_mov_b32 %0, %1" : "=s"(scl) : "s"(scl));
#define PG8_SA(b, h) (((b) * 2 + (h)) * HTB)
#define PG8_SB(b, h) ((4 + (b) * 2 + (h)) * HTB)
#define PG8_GLDS(gbase, voff, ldsdst) do { unsigned keep_; asm volatile("s_mov_b32 %0, m0\n\ts_mov_b32 m0, %3\n\ts_nop 0\n\tglobal_load_lds_dwordx4 %1, %2\n\ts_mov_b32 m0, %0" : "=&s"(keep_) : "v"(voff), "s"(gbase), "s"(ldsdst) : "memory"); } while (0)
#define PG8_STAGE2(bufoff, gbase, v0, v1) do { const unsigned ld_ = ldsb + (unsigned)(bufoff) + ldsw; PG8_GLDS((const char*)(gbase), (unsigned)(v0), ld_); PG8_GLDS((const char*)(gbase), (unsigned)(v1), ld_ + 8192u); } while (0)
#define PG8_STAGEB(bufoff, gbase) PG8_STAGE2(bufoff, gbase, voffB[0], voffB[1])
#define PG8_LDA(dst, b, h) do { _Pragma("unroll") for (int m = 0; m < 4; ++m) _Pragma("unroll") for (int k = 0; k < 2; ++k) dst[m][k] = *(const PG8_LAS bf16x8*)(lds + PG8_SA(b, h) + aoffk[k] + m * 2048); } while (0)
#define PG8_LDB(dst, b, h) do { _Pragma("unroll") for (int n = 0; n < 2; ++n) _Pragma("unroll") for (int k = 0; k < 2; ++k) dst[n][k] = *(const PG8_LAS bf16x8*)(lds + boffB + PG8_SA(b, h) + k * 1024 + n * 2048); } while (0)
#define PG8_CAT(x0, x1) __builtin_shufflevector(__builtin_bit_cast(u32x4, x0), __builtin_bit_cast(u32x4, x1), 0, 1, 2, 3, 4, 5, 6, 7)
#define PG8_MMA(ai, bj, At, Bt) do { __builtin_amdgcn_s_setprio(1); _Pragma("unroll") for (int m = 0; m < 4; ++m) _Pragma("unroll") for (int n = 0; n < 2; ++n) { \
        if constexpr (F8) acc[ai][bj][m][n] = __builtin_amdgcn_mfma_scale_f32_16x16x128_f8f6f4(__builtin_bit_cast(v8i32, PG8_CAT(Bt[n][0], Bt[n][1])), __builtin_bit_cast(v8i32, PG8_CAT(At[m][0], At[m][1])), acc[ai][bj][m][n], 0, 0, 0, scl, 0, scl); \
        else { _Pragma("unroll") for (int k = 0; k < 2; ++k) acc[ai][bj][m][n] = __builtin_amdgcn_mfma_f32_16x16x32_bf16(Bt[n][k], At[m][k], acc[ai][bj][m][n], 0, 0, 0); } } \
        __builtin_amdgcn_s_setprio(0); } while (0)
#define PG8_WAIT_V(n) asm volatile("s_waitcnt vmcnt(" #n ")" ::: "memory")
#define PG8_WAIT_L(n) asm volatile("s_waitcnt lgkmcnt(" #n ")" ::: "memory")
#define PG8_BAR __builtin_amdgcn_s_barrier()
#define PG8_SCHED __builtin_amdgcn_sched_barrier(0)
#define PG8_SETVA(dst, U, T_) do { _Pragma("unroll") for (int i_ = 0; i_ < 2; ++i_) { int R_, C_; stage_rc((T_) * 16 + i_ * 8192, R_, C_); _Pragma("unroll") for (int h_ = 0; h_ < 2; ++h_) \
        dst[h_][i_] = GA ? (unsigned)(S.arow(U, h_ * HALF + R_) * (unsigned)(K * ESZ) + (unsigned)C_ * 2u) : (unsigned)((h_ * HALF + R_) * K * ESZ + C_ * 2); } } while (0)
    Unit cur, nxt; int ui = 0;
    if (!S.next(0, cur)) return;
    f32x4 acc[2][2][4][2];
#pragma unroll
    for (int a = 0; a < 2; ++a)
#pragma unroll
        for (int b = 0; b < 2; ++b)
#pragma unroll
            for (int m = 0; m < 4; ++m)
#pragma unroll
                for (int n = 0; n < 2; ++n) acc[a][b][m][n] = (f32x4){0.f, 0.f, 0.f, 0.f};
    bf16x8 At[4][2], B0[2][2], B1[2][2];
    unsigned vAc[2][2];
    PG8_SETVA(vAc, cur, tid);
    if (GA) { *(PG8_LAS u32x4*)(S.van + tid * 32) = (u32x4){vAc[0][0], vAc[0][1], vAc[1][0], vAc[1][1]}; }
#define PG8_VA(h_, sl_) (GA ? *(const PG8_LAS unsigned long long*)(S.van + tid * 32 + (sl_) * 16 + (h_) * 8) : ((unsigned long long)vAc[h_][0] | ((unsigned long long)vAc[h_][1] << 32)))
#define PG8_STAGEA(bufoff, gbase, h_, sl_) do { const unsigned long long va_ = PG8_VA(h_, sl_); PG8_STAGE2(bufoff, gbase, (unsigned)va_, (unsigned)(va_ >> 32)); } while (0)
    const char* cA = GA ? (const char*)g.A : (const char*)g.A + (size_t)cur.pm * tstep; const char* cB = (const char*)g.Bt + (size_t)cur.pn * tstep;
    S.a_ready(cur);
    PG8_STAGEB(PG8_SB(0, 0), cB); PG8_STAGEB(PG8_SB(0, 1), cB + hstep); PG8_STAGEA(PG8_SA(0, 0), cA, 0, 0); PG8_STAGEA(PG8_SA(0, 1), cA, 1, 0);
    if (wr == 1) PG8_BAR;
    PG8_WAIT_V(2); PG8_BAR;
    PG8_STAGEB(PG8_SB(1, 0), cB + kstep); PG8_STAGEA(PG8_SA(1, 0), cA + kstep, 0, 0); PG8_STAGEB(PG8_SB(1, 1), cB + hstep + kstep);
    PG8_WAIT_V(6); PG8_BAR;
    for (;;) {
        const bool has_next = S.next(ui + 1, nxt);
        const char* nA = GA ? (const char*)g.A : (has_next ? (const char*)g.A + (size_t)nxt.pm * tstep : cA); const char* nB = has_next ? (const char*)g.Bt + (size_t)nxt.pn * tstep : cB;
        if (GA && has_next) { const int tu_ = wid * 64 + lane_now(); unsigned tmp_[2][2]; PG8_SETVA(tmp_, nxt, tu_);
            *(PG8_LAS u32x4*)(S.van + tu_ * 32 + 16) = (u32x4){tmp_[0][0], tmp_[0][1], tmp_[1][0], tmp_[1][1]}; }
#pragma unroll 1
        for (int t = 0; t < nt; t += 2) {
            const bool last = (t == nt - 2);
            const char* a1 = cA + (size_t)(t + 1) * kstep;
            const char* a2 = last ? nA : cA + (size_t)(t + 2) * kstep; const char* b2 = last ? nB : cB + (size_t)(t + 2) * kstep;
            const char* a3 = a2 + kstep; const char* b3 = b2 + kstep;
            if (last && has_next) S.a_ready(nxt);
            PG8_LDB(B0, 0, 0); PG8_LDB(B1, 0, 1); PG8_SCHED; PG8_LDA(At, 0, 0); PG8_STAGEA(PG8_SA(1, 1), a1, 1, 0);
            const int sl = (GA && last && has_next) ? 1 : 0;
            PG8_WAIT_V(8); PG8_WAIT_L(0); PG8_BAR; PG8_MMA(0, 0, At, B0); PG8_MMA(0, 1, At, B1); PG8_BAR; PG8_SCHED;
            PG8_LDA(At, 0, 1); PG8_STAGEB(PG8_SB(0, 0), b2); PG8_STAGEB(PG8_SB(0, 1), b2 + hstep); PG8_STAGEA(PG8_SA(0, 0), a2, 0, sl);
            PG8_WAIT_V(8); PG8_WAIT_L(0); PG8_BAR; PG8_MMA(1, 0, At, B0); PG8_MMA(1, 1, At, B1); PG8_BAR; PG8_SCHED;
            PG8_LDB(B0, 1, 0); PG8_LDB(B1, 1, 1); PG8_SCHED; PG8_LDA(At, 1, 0); PG8_STAGEA(PG8_SA(0, 1), a2, 1, sl);
            PG8_WAIT_V(8); PG8_WAIT_L(0); PG8_BAR; PG8_MMA(0, 0, At, B0); PG8_MMA(0, 1, At, B1); PG8_BAR; PG8_SCHED;
            PG8_LDA(At, 1, 1); PG8_STAGEB(PG8_SB(1, 0), b3); PG8_STAGEB(PG8_SB(1, 1), b3 + hstep); PG8_STAGEA(PG8_SA(1, 0), a3, 0, sl);
            PG8_WAIT_V(8); PG8_WAIT_L(0); PG8_BAR; PG8_MMA(1, 0, At, B0); PG8_MMA(1, 1, At, B1); PG8_BAR; PG8_SCHED;
        }
        if constexpr (ALIGN_EPI) { if (wr == 0) PG8_BAR; }
        { const int l2 = lane_now();
          E(acc, cur, wr, wc, l2 & 15, l2 >> 4); } S.done(cur);
        if (!has_next) break;
#pragma unroll
        for (int a = 0; a < 2; ++a)
#pragma unroll
            for (int b = 0; b < 2; ++b)
#pragma unroll
                for (int m = 0; m < 4; ++m)
#pragma unroll
                    for (int n = 0; n < 2; ++n) acc[a][b][m][n] = (f32x4){0.f, 0.f, 0.f, 0.f};
        cur = nxt; cA = nA; cB = nB; ++ui;
        if (GA) { *(PG8_LAS u32x4*)(S.van + tid * 32) = *(const PG8_LAS u32x4*)(S.van + tid * 32 + 16); }
        if constexpr (ALIGN_EPI) { if (wr == 1) PG8_BAR; }
    }
    PG8_WAIT_V(0);
    if constexpr (!ALIGN_EPI) { if (wr == 0) PG8_BAR; }
    PG8_BAR;
#undef PG8_SA
#undef PG8_SB
#undef PG8_STAGE2
#undef PG8_STAGEB
#undef PG8_LDA
#undef PG8_LDB
#undef PG8_MMA
#undef PG8_CAT
#undef PG8_WAIT_V
#undef PG8_WAIT_L
#undef PG8_BAR
#undef PG8_SCHED
#undef PG8_SETVA
#undef PG8_VA
#undef PG8_STAGEA
}

__device__ __forceinline__ float rs_of(float ss) { return rsqrtf(ss * (1.0f / 1024.0f) + 1e-6f); }
struct EpiScaleBf16 {
    static constexpr bool PERM = true;
    bf16_t* O; int ldc; const float* ss; int npn; const float* lsb0; const float* lsb1; int ls_col0; const PG8_LAS unsigned* cntp = nullptr;
    int f8shift = -1;
    __device__ __forceinline__ void operator()(const f32x4 (&acc)[2][2][4][2], const Unit& u, int wr, int wc, int fr, int fq) const {
        const int row0 = u.pm * BM + wr * 64 + fr; const int colt = (u.pn % npn) * BM, col0 = colt + wc * 32 + 8 * fq;
        const bool ls = lsb0 != nullptr && colt >= ls_col0;
        const int vrows = cntp ? (int)cntp[u.e] - u.mt * BM : BM;
        f32x4 bv[2][2];
#pragma unroll
        for (int bj = 0; bj < 2; ++bj)
#pragma unroll
            for (int n = 0; n < 2; ++n) bv[bj][n] = ls ? *(const f32x4*)((colt >= ls_col0 + 256 ? lsb1 : lsb0) + wc * 32 + 8 * fq + bj * HALF + 4 * n) : (f32x4){0.f, 0.f, 0.f, 0.f};
        float ssv[2][4];
#pragma unroll
        for (int ai = 0; ai < 2; ++ai)
#pragma unroll
            for (int m = 0; m < 4; ++m) ssv[ai][m] = ss ? ss[row0 + ai * HALF + m * 16] : 0.f;
#pragma unroll
        for (int ai = 0; ai < 2; ++ai)
#pragma unroll
            for (int m = 0; m < 4; ++m) { const int row = row0 + ai * HALF + m * 16; const float sc = ss ? rs_of(ssv[ai][m]) : 1.0f; bf16_t* rowp = O + (size_t)row * ldc + col0;
#pragma unroll
                for (int bj = 0; bj < 2; ++bj) { f32x4 v0 = acc[ai][bj][m][0] * sc, v1 = acc[ai][bj][m][1] * sc;
                    if (ls) {
#pragma unroll
                        for (int i = 0; i < 4; ++i) { const float z0 = v0[i] + bv[bj][0][i], z1 = v1[i] + bv[bj][1][i];
                            v0[i] = (fminf(z0, 0.f) - __logf(1.0f + __expf(-fabsf(z0)))) * 0.0625f; v1[i] = (fminf(z1, 0.f) - __logf(1.0f + __expf(-fabsf(z1)))) * 0.0625f; } }
                    u32x4 w; w.x = cvt_pk_bf16(v0[0], v0[1]); w.y = cvt_pk_bf16(v0[2], v0[3]); w.z = cvt_pk_bf16(v1[0], v1[1]); w.w = cvt_pk_bf16(v1[2], v1[3]);
                    if (f8shift >= 0) { const float fs = (float)(1 << f8shift);
                        if (row - u.pm * BM < vrows) *(unsigned long long*)((unsigned char*)O + (size_t)row * ldc + col0 + bj * HALF) = (unsigned long long)f8pack4(v0[0] * fs, v0[1] * fs, v0[2] * fs, v0[3] * fs) | ((unsigned long long)f8pack4(v1[0] * fs, v1[1] * fs, v1[2] * fs, v1[3] * fs) << 32);
                    } else if (row - u.pm * BM < vrows) ST16WT(rowp + bj * HALF, w); } }
    }
};
struct EpiInProj0 {
    static constexpr bool PERM = true;
    bf16_t* O; const float* ss; const float* lsb0; const float* lsb1; int nols = 0;
    __device__ __forceinline__ void operator()(const f32x4 (&acc)[2][2][4][2], const Unit& u, int wr, int wc, int fr, int fq) const {
        const int row0 = u.pm * BM + wr * 64 + fr, tile = u.pn;
        float ssv[2][4];
#pragma unroll
        for (int ai = 0; ai < 2; ++ai)
#pragma unroll
            for (int m = 0; m < 4; ++m) ssv[ai][m] = ss[row0 + ai * HALF + m * 16];
        if (tile >= 2 && tile < 6) { const int col0 = 512 + (tile - 2) * 128 + wc * 32 + 8 * fq;
#pragma unroll
            for (int ai = 0; ai < 2; ++ai)
#pragma unroll
                for (int m = 0; m < 4; ++m) { const int row = row0 + ai * HALF + m * 16; const float sc = rs_of(ssv[ai][m]), s2 = sc * sc;
                    const f32x4 v0 = acc[ai][0][m][0] * acc[ai][1][m][0] * s2, v1 = acc[ai][0][m][1] * acc[ai][1][m][1] * s2;
                    u32x4 w; w.x = cvt_pk_bf16(v0[0], v0[1]); w.y = cvt_pk_bf16(v0[2], v0[3]); w.z = cvt_pk_bf16(v1[0], v1[1]); w.w = cvt_pk_bf16(v1[2], v1[3]);
                    ST16WT(O + uoff(row, col0), w); }
            return; }
        const int colt = tile < 2 ? tile * BM : (tile - 2) * BM, col0 = colt + wc * 32 + 8 * fq; const bool ls = tile >= 12 && !nols;
        f32x4 bv[2][2];
#pragma unroll
        for (int bj = 0; bj < 2; ++bj)
#pragma unroll
            for (int n = 0; n < 2; ++n) bv[bj][n] = ls ? *(const f32x4*)((tile == 13 ? lsb1 : lsb0) + wc * 32 + 8 * fq + bj * HALF + 4 * n) : (f32x4){0.f, 0.f, 0.f, 0.f};
#pragma unroll
        for (int ai = 0; ai < 2; ++ai)
#pragma unroll
            for (int m = 0; m < 4; ++m) { const int row = row0 + ai * HALF + m * 16; const float sc = rs_of(ssv[ai][m]); bf16_t* rowp = O + uoff(row, col0);
#pragma unroll
                for (int bj = 0; bj < 2; ++bj) { f32x4 v0 = acc[ai][bj][m][0] * sc, v1 = acc[ai][bj][m][1] * sc;
                    if (ls) {
#pragma unroll
                        for (int i = 0; i < 4; ++i) { const float z0 = v0[i] + bv[bj][0][i], z1 = v1[i] + bv[bj][1][i];
                            v0[i] = (fminf(z0, 0.f) - __logf(1.0f + __expf(-fabsf(z0)))) * 0.0625f; v1[i] = (fminf(z1, 0.f) - __logf(1.0f + __expf(-fabsf(z1)))) * 0.0625f; } }
                    u32x4 w; w.x = cvt_pk_bf16(v0[0], v0[1]); w.y = cvt_pk_bf16(v0[2], v0[3]); w.z = cvt_pk_bf16(v1[0], v1[1]); w.w = cvt_pk_bf16(v1[2], v1[3]);
                    ST16WT(rowp + bj * HALF, w); } }
    }
};
template <bool RESBF> struct EpiResBf16 {
    static constexpr bool PERM = true;
    const float* resA; const float* resB; int rmask; bf16_t* out; const bf16_t* resb; unsigned char* out8 = nullptr;
    __device__ __forceinline__ void operator()(const f32x4 (&acc)[2][2][4][2], const Unit& u, int wr, int wc, int fr, int fq) const {
        const int row0 = u.pm * BM + wr * 64 + fr, col0 = u.pn * BM + wc * 32 + 8 * fq;
        constexpr int MB = RESBF ? 4 : 2;
#pragma unroll
        for (int ai = 0; ai < 2; ++ai)
#pragma unroll
            for (int m0 = 0; m0 < 4; m0 += MB) {
                f32x4 r0[MB][2], r1[MB][2];
#pragma unroll
                for (int mi = 0; mi < MB; ++mi) { const int row = row0 + ai * HALF + (m0 + mi) * 16;
#pragma unroll
                    for (int bj = 0; bj < 2; ++bj) {
                        if (RESBF) { const u32x4 rw = *(const u32x4*)(resb + (size_t)row * D + col0 + bj * HALF);
                            r0[mi][bj] = (f32x4){__uint_as_float(rw.x << 16), __uint_as_float(rw.x & 0xffff0000u), __uint_as_float(rw.y << 16), __uint_as_float(rw.y & 0xffff0000u)};
                            r1[mi][bj] = (f32x4){__uint_as_float(rw.z << 16), __uint_as_float(rw.z & 0xffff0000u), __uint_as_float(rw.w << 16), __uint_as_float(rw.w & 0xffff0000u)};
                        } else { const float* rp = (row < MR ? resA + (size_t)row * D : resB + (size_t)((row - MR) & rmask) * D) + col0 + bj * HALF; r0[mi][bj] = *(const f32x4*)rp; r1[mi][bj] = *(const f32x4*)(rp + 4); } } }
#pragma unroll
                for (int mi = 0; mi < MB; ++mi) { const int m = m0 + mi; const int row = row0 + ai * HALF + m * 16; bf16_t* op = out + (size_t)row * D + col0;
#pragma unroll
                    for (int bj = 0; bj < 2; ++bj) {
                        const f32x4 v0 = acc[ai][bj][m][0] + r0[mi][bj], v1 = acc[ai][bj][m][1] + r1[mi][bj];
                        u32x4 w; w.x = cvt_pk_bf16(v0[0], v0[1]); w.y = cvt_pk_bf16(v0[2], v0[3]); w.z = cvt_pk_bf16(v1[0], v1[1]); w.w = cvt_pk_bf16(v1[2], v1[3]);
                        ST16WT(op + bj * HALF, w);
                        if (out8) *(unsigned long long*)(out8 + (size_t)row * D + col0 + bj * HALF) = (unsigned long long)f8pack4(v0[0], v0[1], v0[2], v0[3]) | ((unsigned long long)f8pack4(v1[0], v1[1], v1[2], v1[3]) << 32); } } }
    }
};
struct EpiQKV {
    static constexpr bool PERM = true;
    bf16_t* O; const float* ss; const float* qn; const float* kn; const PG8_LAS float* rope; float c2;
    __device__ __forceinline__ void operator()(const f32x4 (&acc)[2][2][4][2], const Unit& u, int wr, int wc, int fr, int fq) const {
        const int row0 = u.pm * BM + wr * 64 + fr, tile = u.pn;
        float ssv[2][4];
#pragma unroll
        for (int ai = 0; ai < 2; ++ai)
#pragma unroll
            for (int m = 0; m < 4; ++m) ssv[ai][m] = ss[row0 + ai * HALF + m * 16];
        if (tile == 5) { const int col0 = tile * BM + wc * 32 + 8 * fq;
#pragma unroll
            for (int ai = 0; ai < 2; ++ai)
#pragma unroll
                for (int m = 0; m < 4; ++m) { const int row = row0 + ai * HALF + m * 16; const float sc = rs_of(ssv[ai][m]); bf16_t* rowp = O + (size_t)row * 1536 + col0;
#pragma unroll
                    for (int bj = 0; bj < 2; ++bj) { const f32x4 v0 = acc[ai][bj][m][0] * sc, v1 = acc[ai][bj][m][1] * sc;
                        u32x4 w; w.x = cvt_pk_bf16(v0[0], v0[1]); w.y = cvt_pk_bf16(v0[2], v0[3]); w.z = cvt_pk_bf16(v1[0], v1[1]); w.w = cvt_pk_bf16(v1[2], v1[3]);
                        ST16WT(rowp + bj * HALF, w); } }
            return; }
        const float* nw = (tile < 4 ? qn : kn) + 8 * fq; const float hs = tile < 4 ? c2 : 1.0f;
        f32x4 g[2][2];
#pragma unroll
        for (int bj = 0; bj < 2; ++bj)
#pragma unroll
            for (int n = 0; n < 2; ++n) g[bj][n] = *(const f32x4*)(nw + bj * 32 + 4 * n);
#pragma unroll
        for (int ai = 0; ai < 2; ++ai)
#pragma unroll
            for (int m = 0; m < 4; ++m) { const int row = row0 + ai * HALF + m * 16; const float sc = rs_of(ssv[ai][m]);
                f32x4 v[2][2]; float s2 = 0.f;
#pragma unroll
                for (int bj = 0; bj < 2; ++bj)
#pragma unroll
                    for (int n = 0; n < 2; ++n) { v[bj][n] = acc[ai][bj][m][n] * sc; s2 += (v[bj][n][0] * v[bj][n][0] + v[bj][n][1] * v[bj][n][1]) + (v[bj][n][2] * v[bj][n][2] + v[bj][n][3] * v[bj][n][3]); }
                s2 += __shfl_xor(s2, 16); s2 += __shfl_xor(s2, 32);
                const float rs = rsqrtf(s2 * (1.0f / 64.0f) + 1e-6f) * hs; const bool rot = row < MR; const int sp = row & 2047;
                bf16_t* rowp = O + (size_t)row * 1536 + tile * BM + wc * 64 + 8 * fq;
#pragma unroll
                for (int bj = 0; bj < 2; ++bj) { const int pos = bj ? (sp & 63) : (sp >> 6); unsigned ow[4];
#pragma unroll
                    for (int n = 0; n < 2; ++n) { f32x4 cs = (f32x4){1.f, 0.f, 1.f, 0.f}; if (rot) cs = *(const PG8_LAS f32x4*)(rope + (pos * 16 + 4 * fq + 2 * n) * 2);
                        const f32x4 a = v[bj][n] * rs * g[bj][n];
                        ow[2 * n] = cvt_pk_bf16(a[0] * cs[0] - a[1] * cs[1], a[0] * cs[1] + a[1] * cs[0]); ow[2 * n + 1] = cvt_pk_bf16(a[2] * cs[2] - a[3] * cs[3], a[2] * cs[3] + a[3] * cs[2]); }
                    { const u32x4 w4 = (u32x4){ow[0], ow[1], ow[2], ow[3]}; ST16WT(rowp + bj * 32, w4); } } }
    }
};
}
namespace attn_body {
using bf16=__hip_bfloat16;
using bf16x8=__attribute__((ext_vector_type(8)))short;
using s16x4=__attribute__((ext_vector_type(4)))short;
using f32x16=__attribute__((ext_vector_type(16)))float;
using u32x4=__attribute__((ext_vector_type(4)))unsigned;
constexpr int BATCH=8,NHEAD=16,SEQ=2048,D=64,DM=1536,DMO=1024;
constexpr int KCOL=1024,VCOL=1280,META0=BATCH*SEQ;
constexpr int NW=8,QBLK=32,QB=QBLK*NW,KVBLK=64,NQB=SEQ/QB;
constexpr int ATTN_UNIT_ROWS=QB; constexpr int NTILES=33;
__device__ __forceinline__ int crow(int r,int hi){return (r&3)+8*(r>>2)+4*hi;}
#define SBAR() __builtin_amdgcn_sched_barrier(0)
__device__ __forceinline__ void cmask(f32x16&p0,f32x16&p1,int jb,int qrel,int hi){
  const float NEG=-INFINITY; int kb=64*jb+4*hi;
  #pragma unroll
  for(int r=0;r<16;++r){int kv=kb+(r&3)+8*(r>>2); if(kv>qrel)p0[r]=NEG; if(kv+32>qrel)p1[r]=NEG;}
}

__device__ __forceinline__ void kvmask(f32x16&p0,f32x16&p1,int limit,int hi){
  const float NEG=-INFINITY; const int kb=4*hi;
  #pragma unroll
  for(int r=0;r<16;++r){int kv=kb+(r&3)+8*(r>>2); if(kv>=limit)p0[r]=NEG; if(kv+32>=limit)p1[r]=NEG;}
}
constexpr int NSLOT=3, SLOTB=8192;
constexpr int LDS_K=0, LDS_V=NSLOT*SLOTB, LDS_WS=2*NSLOT*SLOTB, LDS_OST=LDS_WS+NW*64*4, LDS_BYTES=LDS_OST+NW*4096;
constexpr float C2=0.125f*1.4426950408889634f;
__device__ __forceinline__ void glds16(const void*gsrc,unsigned lds_dst){unsigned keep;
  asm volatile("s_mov_b32 %0, m0\n\ts_mov_b32 m0, %2\n\ts_nop 0\n\tglobal_load_lds_dwordx4 %1, off\n\ts_mov_b32 m0, %0":"=&s"(keep):"v"(gsrc),"s"(lds_dst):"memory");}
__device__ __forceinline__ float max3f(float a,float b,float c){float r;asm("v_max3_f32 %0, %1, %2, %3":"=v"(r):"v"(a),"v"(b),"v"(c));return r;}
__device__ __forceinline__ float max2f(float a,float b){float r;asm("v_max_f32_e32 %0, %1, %2":"=v"(r):"v"(a),"v"(b));return r;}
__device__ __forceinline__ float fadd_s(float a,float b){float r;asm("v_add_f32_e32 %0, %1, %2":"=v"(r):"v"(a),"v"(b));return r;}
__device__ __forceinline__ float fsub_s(float a,float b){float r;asm("v_sub_f32_e32 %0, %1, %2":"=v"(r):"v"(a),"v"(b));return r;}
typedef float f32x2_t __attribute__((ext_vector_type(2))); typedef __bf16 bf16x2_t __attribute__((ext_vector_type(2)));
__device__ __forceinline__ unsigned cvtpk_s(float lo,float hi){f32x2_t v={lo,hi};bf16x2_t b=__builtin_convertvector(v,bf16x2_t);return __builtin_bit_cast(unsigned,b);}
#define WAIT_BAR(N) asm volatile("s_waitcnt vmcnt(" #N ") lgkmcnt(0)\n\ts_barrier":::"memory")

__device__ __forceinline__ void qkt(f32x16&p0,f32x16&p1,const char*Kslot,const bf16x8*qr,const f32x16&negm,int r32,int hi){
  const char*kb=Kslot+hi*1024+r32*16;
  #pragma unroll
  for(int d0=0;d0<4;++d0){
    const bf16x8 b0=*reinterpret_cast<const bf16x8*>(kb+d0*2048);
    const bf16x8 b1=*reinterpret_cast<const bf16x8*>(kb+d0*2048+512);
    if(d0==0){p0=__builtin_amdgcn_mfma_f32_32x32x16_bf16(b0,qr[0],negm,0,0,0);p1=__builtin_amdgcn_mfma_f32_32x32x16_bf16(b1,qr[0],negm,0,0,0);}
    else{p0=__builtin_amdgcn_mfma_f32_32x32x16_bf16(b0,qr[d0],p0,0,0,0);p1=__builtin_amdgcn_mfma_f32_32x32x16_bf16(b1,qr[d0],p1,0,0,0);}}
}
typedef __attribute__((address_space(3))) const char* lds_cptr;
typedef short v4i16_t __attribute__((ext_vector_type(4)));
__device__ __forceinline__ void kload8(bf16x8*kf,lds_cptr kp){
  kf[0]=*(const __attribute__((address_space(3))) bf16x8*)(kp);      kf[1]=*(const __attribute__((address_space(3))) bf16x8*)(kp+512);
  kf[2]=*(const __attribute__((address_space(3))) bf16x8*)(kp+2048); kf[3]=*(const __attribute__((address_space(3))) bf16x8*)(kp+2560);
  kf[4]=*(const __attribute__((address_space(3))) bf16x8*)(kp+4096); kf[5]=*(const __attribute__((address_space(3))) bf16x8*)(kp+4608);
  kf[6]=*(const __attribute__((address_space(3))) bf16x8*)(kp+6144); kf[7]=*(const __attribute__((address_space(3))) bf16x8*)(kp+6656);
}
__device__ __forceinline__ void kload2(bf16x8*kf,lds_cptr kp,int j){ kf[2*j]=*(const __attribute__((address_space(3))) bf16x8*)(kp+j*2048); kf[2*j+1]=*(const __attribute__((address_space(3))) bf16x8*)(kp+j*2048+512); }
__device__ __forceinline__ s16x4 vtr(lds_cptr p){ return __builtin_bit_cast(s16x4,__builtin_amdgcn_ds_read_tr16_b64_v4i16((__attribute__((address_space(3))) v4i16_t*)p)); }
__device__ __forceinline__ float rowmax(const f32x16&p0,const f32x16&p1){
  float a=max3f(p0[0],p0[1],p1[0]),b=max3f(p0[2],p0[3],p1[1]);a=max3f(a,p1[2],p1[3]);
  #pragma unroll
  for(int r=4;r<16;r+=4){a=max3f(a,p0[r],p0[r+1]);b=max3f(b,p0[r+2],p0[r+3]);a=max3f(a,p1[r],p1[r+1]);b=max3f(b,p1[r+2],p1[r+3]);}
  const float m=max2f(a,b);
  auto rr=__builtin_amdgcn_permlane32_swap(__float_as_uint(m),__float_as_uint(m),false,false);
  return max2f(__uint_as_float(rr[0]),__uint_as_float(rr[1]));
}
__device__ __forceinline__ void pv(f32x16*o,int vb,bf16x8 pa0,bf16x8 pa1,bf16x8 pa2,bf16x8 pa3){
  #pragma unroll
  for(int d0=0;d0<2;++d0){s16x4 lo[4],hi[4];
    #pragma unroll
    for(int ks=0;ks<4;++ks){
      asm volatile("ds_read_b64_tr_b16 %0,%1 offset:%c2":"=&v"(lo[ks]):"v"(vb),"i"(d0*4096+ks*1024):"memory");
      asm volatile("ds_read_b64_tr_b16 %0,%1 offset:%c2":"=&v"(hi[ks]):"v"(vb),"i"(d0*4096+ks*1024+512):"memory");}
    asm volatile("s_waitcnt lgkmcnt(0)":::"memory");SBAR();
    #define PK(k) (bf16x8){lo[k][0],lo[k][1],lo[k][2],lo[k][3],hi[k][0],hi[k][1],hi[k][2],hi[k][3]}
    o[d0]=__builtin_amdgcn_mfma_f32_32x32x16_bf16(pa0,PK(0),o[d0],0,0,0);
    o[d0]=__builtin_amdgcn_mfma_f32_32x32x16_bf16(pa1,PK(1),o[d0],0,0,0);
    o[d0]=__builtin_amdgcn_mfma_f32_32x32x16_bf16(pa2,PK(2),o[d0],0,0,0);
    o[d0]=__builtin_amdgcn_mfma_f32_32x32x16_bf16(pa3,PK(3),o[d0],0,0,0);
    #undef PK
  }
}

#ifndef ATTN_STORE16
#define ATTN_STORE16(p,v) ST16WT(p,v)
#endif
template<int THRL> __device__ __forceinline__ void attn_unit(int b,int h,int qb,const bf16*Q,const bf16*__restrict__ K,const bf16*__restrict__ V,bf16*O,char*shm,const int wid){
  const int lane=lane_now(),tid=wid*64+lane,r32=lane&31,hi=lane>>5;
  const long rowbase=(long)b*SEQ; const int q0=qb*QB; const int kvh=h>>2;
  const bf16*Qw=Q+(rowbase+q0+wid*QBLK)*DM+h*D;
  const bf16*Kh=K+KCOL+kvh*D,*Vh=K+VCOL+kvh*D; (void)V;
  #define TROW(t) ((long)(((t)==0)?(META0+b*16):(rowbase+((t)-1)*KVBLK)))
  const unsigned lds0=(unsigned)(uintptr_t)shm;
  float*wsf=(float*)(shm+LDS_WS)+wid*64;
  const bf16*ksrc=Kh+(long)lane*DM+wid*8;
  const bf16*vsrc=Vh+(long)(16*(wid&3)+(lane>>2))*DM+(wid>>2)*32+(lane&3)*8;
  const unsigned kdst=lds0+LDS_K+wid*1024, vdst=lds0+LDS_V+wid*1024;
  #define DMA_K(t,slot) glds16(ksrc+TROW(t)*DM,(unsigned)__builtin_amdgcn_readfirstlane(kdst+(slot)))
  #define DMA_V(t,slot) glds16(vsrc+TROW(t)*DM,(unsigned)__builtin_amdgcn_readfirstlane(vdst+(slot)))
  const int vb0=(int)(lds0+LDS_V)+((lane>>4)&1)*32+(lane&3)*8+(4*hi+((lane&15)>>2))*64;
  const char*Kbase=shm+LDS_K; bf16x8 kf[8];
  const lds_cptr shm3=(lds_cptr)shm; const lds_cptr kp0=shm3+LDS_K+hi*1024+r32*16; const lds_cptr vp0=shm3+LDS_V+((lane>>4)&1)*32+(lane&3)*8+(4*hi+((lane&15)>>2))*64;
  const int NT=NTILES;
  DMA_K(0,0);DMA_V(0,0);DMA_K(1,SLOTB);
  bf16x8 qr[4];
  #pragma unroll
  for(int d0=0;d0<4;++d0)qr[d0]=*reinterpret_cast<const bf16x8*>(&Qw[(long)r32*DM+d0*16+hi*8]);
  float mhat=0.f,l_reg=0.f;f32x16 o[2];o[0]=f32x16{};o[1]=f32x16{};f32x16 negm=f32x16{};asm volatile("":"+v"(negm));
  #define CMASK(P0,P1,t) do{ if((t)==0)kvmask(P0,P1,16,hi); }while(0)
  bool resc=false;
  #define START(P0,P1) do{ const float rm=rowmax(P0,P1); resc=false; \
    { const float dl=rm; mhat=fadd_s(mhat,dl); \
      _Pragma("unroll") for(int r=0;r<16;++r){P0[r]=fsub_s(P0[r],dl);P1[r]=fsub_s(P1[r],dl);} \
      _Pragma("unroll") for(int r=0;r<16;++r)negm[r]=-mhat; asm volatile("":"+v"(negm)); } \
    _Pragma("unroll") for(int r=0;r<16;++r)P0[r]=__builtin_amdgcn_exp2f(P0[r]); }while(0)
  #define RESC() do{ if(resc){ asm volatile("s_waitcnt lgkmcnt(0)":::"memory"); \
      _Pragma("unroll") for(int d_=0;d_<2;++d_) _Pragma("unroll") for(int r=0;r<16;++r)o[d_][r]*=wsf[crow(r,hi)]; } }while(0)
  f32x16 pA0,pA1,pB0,pB1;
  int sl_prev=0,sl_cur=0,sl_next=SLOTB;
  #define ROT() do{sl_prev=sl_cur;sl_cur=sl_next;sl_next=(sl_next==(NSLOT-1)*SLOTB)?0:sl_next+SLOTB;}while(0)
  DMA_K(2,2*SLOTB);
  WAIT_BAR(3);
  qkt(pA0,pA1,Kbase,qr,negm,r32,hi);asm volatile("s_nop 15\n\ts_nop 7":"+v"(pA0),"+v"(pA1));CMASK(pA0,pA1,0);
  START(pA0,pA1);
  _Pragma("unroll") for(int r=0;r<16;++r)pA1[r]=__builtin_amdgcn_exp2f(pA1[r]);
  WAIT_BAR(0);
  DMA_K(3,0);DMA_V(1,SLOTB);
  ROT();
  kload8(kf,kp0+sl_cur);
  WAIT_BAR(2);
  s16x4 vlo[8],vhi[8]; u32x4 pw0,pw1,pw2,pw3;
  #define PKW(P,B) cvtpk_s(P[B],P[B+1])
  #define PAF(k) __builtin_bit_cast(bf16x8,pw##k)
  #define VFR(i) (bf16x8){vlo[i][0],vlo[i][1],vlo[i][2],vlo[i][3],vhi[i][0],vhi[i][1],vhi[i][2],vhi[i][3]}
  #define PIN(x) asm volatile("":"+v"(x))
  #define MX3(a,b,c) __builtin_fmaxf(__builtin_fmaxf((a),(b)),(c))
  #define GAPA(MF,A0,A1,A2,A3,W0,W1,PW) do{ MF; sacc+=A0; sacc+=A1; sacc+=A2; sacc+=A3; PIN(sacc); W0; W1; PIN(PW); SBAR(); }while(0)
  #define EX(v) __builtin_amdgcn_exp2f(v)
  #define GAPB(MF,X,B) do{ MF; X[B]=EX(X[B]); X[B+1]=EX(X[B+1]); X[B+2]=EX(X[B+2]); X[B+3]=EX(X[B+3]); PIN(X); SBAR(); }while(0)
  #define VRD(i) do{ vlo[i]=vtr(vp_+(((i)>>2)*4096+((i)&3)*1024)); vhi[i]=vtr(vp_+(((i)>>2)*4096+((i)&3)*1024+512)); }while(0)
  #define KRD(G,j) do{ if(G){ kload2(kf,kp0+sl_next,j); SBAR(); } }while(0)
  #define STEP(C0,C1,P0,P1,t,GK,GV,GL) do{ SBAR(); \
    const lds_cptr vp_=vp0+sl_prev; \
    VRD(0); SBAR(); float sacc=(P0[0]+P0[1]); \
    GAPA(C0=__builtin_amdgcn_mfma_f32_32x32x16_bf16(kf[0],qr[0],negm,0,0,0), P0[2],P0[3],P0[4],P0[5],     pw0[0]=PKW(P0,0), pw0[1]=PKW(P0,2), pw0); \
    VRD(4); SBAR(); GAPA(C1=__builtin_amdgcn_mfma_f32_32x32x16_bf16(kf[1],qr[0],negm,0,0,0), P0[6],P0[7],P0[8],P0[9],     pw0[2]=PKW(P0,4), pw0[3]=PKW(P0,6), pw0); \
    VRD(1); SBAR(); GAPA(C0=__builtin_amdgcn_mfma_f32_32x32x16_bf16(kf[2],qr[1],C0,0,0,0),   P0[10],P0[11],P0[12],P0[13], pw1[0]=PKW(P0,8), pw1[1]=PKW(P0,10), pw1); \
    VRD(5); SBAR(); GAPA(C1=__builtin_amdgcn_mfma_f32_32x32x16_bf16(kf[3],qr[1],C1,0,0,0),   P0[14],P0[15],P1[0],P1[1],   pw1[2]=PKW(P0,12),pw1[3]=PKW(P0,14), pw1); \
    VRD(2); SBAR(); GAPA(C0=__builtin_amdgcn_mfma_f32_32x32x16_bf16(kf[4],qr[2],C0,0,0,0),   P1[2],P1[3],P1[4],P1[5],     pw2[0]=PKW(P1,0), pw2[1]=PKW(P1,2), pw2); \
    VRD(6); SBAR(); GAPA(C1=__builtin_amdgcn_mfma_f32_32x32x16_bf16(kf[5],qr[2],C1,0,0,0),   P1[6],P1[7],P1[8],P1[9],     pw2[2]=PKW(P1,4), pw2[3]=PKW(P1,6), pw2); \
    VRD(3); SBAR(); GAPA(C0=__builtin_amdgcn_mfma_f32_32x32x16_bf16(kf[6],qr[3],C0,0,0,0),   P1[10],P1[11],P1[12],P1[13], pw3[0]=PKW(P1,8), pw3[1]=PKW(P1,10), pw3); \
    VRD(7); SBAR(); GAPA(C1=__builtin_amdgcn_mfma_f32_32x32x16_bf16(kf[7],qr[3],C1,0,0,0),   P1[14],P1[15],0.f,0.f,       pw3[2]=PKW(P1,12),pw3[3]=PKW(P1,14), pw3); \
    l_reg+=sacc; \
    if(GK){DMA_K((t)+3,sl_cur);} if(GV){DMA_V((t)+1,sl_next);} \
    CMASK(C0,C1,t); \
    { float a=MX3(C0[0],C0[1],C1[0]),b=MX3(C0[2],C0[3],C1[1]); a=MX3(a,C1[2],C1[3]); \
      _Pragma("unroll") for(int r=4;r<16;r+=4){a=MX3(a,C0[r],C0[r+1]);b=MX3(b,C0[r+2],C0[r+3]);a=MX3(a,C1[r],C1[r+1]);b=MX3(b,C1[r+2],C1[r+3]);} \
      float rm=__builtin_fmaxf(a,b); { auto rr=__builtin_amdgcn_permlane32_swap(__float_as_uint(rm),__float_as_uint(rm),false,false); rm=__builtin_fmaxf(__uint_as_float(rr[0]),__uint_as_float(rr[1])); } \
      resc=false; \
      if(__builtin_expect(__any(rm>(float)THRL),0)){ const float dl=__builtin_fmaxf(rm,0.f); mhat+=dl; \
        _Pragma("unroll") for(int r=0;r<16;++r){C0[r]-=dl;C1[r]-=dl;} \
        _Pragma("unroll") for(int r=0;r<16;++r)negm[r]=-mhat; asm volatile("":"+v"(negm)); \
        const float f=__builtin_amdgcn_exp2f(-dl); l_reg*=f; if(hi==0)wsf[r32]=f; resc=true; } } \
    SBAR(); \
    GAPB(o[0]=__builtin_amdgcn_mfma_f32_32x32x16_bf16(PAF(0),VFR(0),o[0],0,0,0), C0,0); \
    GAPB(o[1]=__builtin_amdgcn_mfma_f32_32x32x16_bf16(PAF(0),VFR(4),o[1],0,0,0), C0,4); \
    KRD(GL,0); GAPB(o[0]=__builtin_amdgcn_mfma_f32_32x32x16_bf16(PAF(1),VFR(1),o[0],0,0,0), C0,8); \
    KRD(GL,1); GAPB(o[1]=__builtin_amdgcn_mfma_f32_32x32x16_bf16(PAF(1),VFR(5),o[1],0,0,0), C0,12); \
    KRD(GL,2); GAPB(o[0]=__builtin_amdgcn_mfma_f32_32x32x16_bf16(PAF(2),VFR(2),o[0],0,0,0), C1,0); \
    KRD(GL,3); GAPB(o[1]=__builtin_amdgcn_mfma_f32_32x32x16_bf16(PAF(2),VFR(6),o[1],0,0,0), C1,4); \
    GAPB(o[0]=__builtin_amdgcn_mfma_f32_32x32x16_bf16(PAF(3),VFR(3),o[0],0,0,0), C1,8); \
    GAPB(o[1]=__builtin_amdgcn_mfma_f32_32x32x16_bf16(PAF(3),VFR(7),o[1],0,0,0), C1,12); \
    }while(0)
  int t=1;
  #undef CMASK
  #define CMASK(P0,P1,t) do{}while(0)
  for(;t+5<NT;t+=2){
    STEP(pB0,pB1,pA0,pA1,t,true,true,true);     WAIT_BAR(2); RESC(); ROT();
    STEP(pA0,pA1,pB0,pB1,t+1,true,true,true);   WAIT_BAR(2); RESC(); ROT();
  }
  #undef CMASK
  #define CMASK(P0,P1,t) do{}while(0)
  #define ENDW(tt) do{ if((tt)+3<NT){WAIT_BAR(2);} else if((tt)+2<NT){WAIT_BAR(1);} else {WAIT_BAR(0);} }while(0)
  for(;t+1<NT;t+=2){
    STEP(pB0,pB1,pA0,pA1,t,(t+3<NT),(t+1<NT),(t+1<NT));       ENDW(t);   RESC(); ROT();
    STEP(pA0,pA1,pB0,pB1,t+1,(t+4<NT),(t+2<NT),(t+2<NT));     ENDW(t+1); RESC(); ROT();
  }
  static_assert(NTILES%2==1,"odd tile count: the last pair of steps ends with tile NT-1 in buffer A");
  { float sacc=pA0[0]+pA0[1]; _Pragma("unroll") for(int r=2;r<16;++r)sacc+=pA0[r]; _Pragma("unroll") for(int r=0;r<16;++r)sacc+=pA1[r]; l_reg+=sacc;
    pw0=(u32x4){PKW(pA0,0),PKW(pA0,2),PKW(pA0,4),PKW(pA0,6)};pw1=(u32x4){PKW(pA0,8),PKW(pA0,10),PKW(pA0,12),PKW(pA0,14)};pw2=(u32x4){PKW(pA1,0),PKW(pA1,2),PKW(pA1,4),PKW(pA1,6)};pw3=(u32x4){PKW(pA1,8),PKW(pA1,10),PKW(pA1,12),PKW(pA1,14)};
    SBAR(); pv(o,vb0+sl_prev,PAF(0),PAF(1),PAF(2),PAF(3)); }
  #undef PKW
  #undef PAF
  #undef VFR
  #undef PIN
  #undef MX3
  #undef GAPA
  #undef GAPB
  #undef EX
  #undef VRD
  #undef KRD
  #undef STEP
  #undef ENDW
  {auto rr=__builtin_amdgcn_permlane32_swap(__float_as_uint(l_reg),__float_as_uint(l_reg),false,false);l_reg=__uint_as_float(rr[0])+__uint_as_float(rr[1]);}
  if(hi==0)wsf[32+r32]=l_reg;asm volatile("s_waitcnt lgkmcnt(0)":::"memory");
  float rli[16];
  #pragma unroll
  for(int r=0;r<16;++r)rli[r]=__builtin_amdgcn_rcpf(wsf[32+crow(r,hi)]);
  { unsigned char*stg=(unsigned char*)(shm+LDS_OST)+wid*4096;
    unsigned char*Ow8=(unsigned char*)O+(rowbase+q0+wid*QBLK)*DMO+h*D;
    #pragma unroll
    for(int r=0;r<16;++r){const int orow=crow(r,hi); const float sc=rli[r]*16.0f;
      const unsigned w2=(unsigned)__builtin_amdgcn_cvt_pk_fp8_f32(o[0][r]*sc,o[1][r]*sc,0,false);
      stg[orow*64+r32]=(unsigned char)w2; stg[orow*64+32+r32]=(unsigned char)(w2>>8);}
    asm volatile("s_waitcnt lgkmcnt(0)":::"memory");
    #pragma unroll
    for(int i=0;i<2;++i){const int row=i*16+(lane>>2),ch=lane&3; const u32x4 v=*(const u32x4*)(stg+row*64+ch*16); ATTN_STORE16(Ow8+(long)row*DMO+ch*16,v);} }
  asm volatile("s_waitcnt lgkmcnt(0)\n\ts_barrier":::"memory");
  #undef DMA_K
  #undef DMA_V
  #undef TROW
  #undef CMASK
  #undef START
  #undef RESC
  #undef ROT
}
constexpr int ATTN_LDS_BYTES=LDS_BYTES;
struct AttnTensors { const bf16* Q; const bf16* K; const bf16* V; bf16* O; };
struct AttnUnit { int bh; int qb; };
struct StaticOrder {
  int vcu,rep,G;
  __device__ __forceinline__ explicit StaticOrder(int v,int r,int g):vcu(v),rep(r),G(g){}
  __device__ __forceinline__ bool next(int i,AttnUnit&u)const{
    if(G==256){ if(i>=4*rep)return false; u.bh=vcu>>1; u.qb=(vcu&1)*4+(i&3); return true; }
    const int L=vcu+i*G; if(L>=BATCH*NHEAD*8)return false; u.bh=L>>3; u.qb=L&7; return true; }
  __device__ __forceinline__ void a_ready(const AttnUnit&)const{}
  __device__ __forceinline__ void done(const AttnUnit&)const{}
};
template<class Sched,int THRL=8> __device__ __forceinline__ void attn_phase(char*lds,const AttnTensors&T,const Sched&S,const int wid){
  AttnUnit u;
  for(int i=0;S.next(i,u);++i){ S.a_ready(u); attn_unit<THRL>(u.bh/NHEAD,u.bh%NHEAD,u.qb,T.Q,T.K,T.V,T.O,lds,wid); S.done(u); }
}
#undef SBAR
#undef WAIT_BAR
}
#define GAS __attribute__((address_space(1)))
#define LAS __attribute__((address_space(3)))
typedef unsigned v4u __attribute__((ext_vector_type(4)));
typedef float f32x4 __attribute__((ext_vector_type(4)));
typedef short bf16x8 __attribute__((ext_vector_type(8)));
typedef GAS unsigned gu32;
typedef GAS unsigned long long gu64;
#define RLX_AGENT __ATOMIC_RELAXED, __HIP_MEMORY_SCOPE_AGENT
#define LDS_WAIT() asm volatile("s_waitcnt lgkmcnt(0)" ::: "memory")
#define VM_WAIT() asm volatile("s_waitcnt vmcnt(0)" ::: "memory")
__device__ __forceinline__ unsigned long long rt() { return __builtin_amdgcn_s_memrealtime(); }
typedef float f32x2_cv __attribute__((ext_vector_type(2))); typedef __bf16 bf16x2_cv __attribute__((ext_vector_type(2)));
__device__ __forceinline__ unsigned pk2(float lo, float hi) { const f32x2_cv v = {lo, hi}; return __builtin_bit_cast(unsigned, __builtin_convertvector(v, bf16x2_cv)); }
__device__ __forceinline__ unsigned f2bf(float f) { return pk2(f, f) & 0xffffu; }

#define XB_TMO      128
#define XB_XCNT(j)  (256  + 64 * (j))
#define XB_XSUB(j)  (1280 + 64 * (j))
#define XB_XGEN(j)  (2304 + 64 * (j))
#define XB_TOP      3328
#define XB_TOPGEN   3392
#define XCD_BAR_WORDS 3456
#define XB_SPIN_CAP (1u << 18)

__device__ __forceinline__ unsigned xb_ld(unsigned* p)              { return __hip_atomic_load(p, __ATOMIC_RELAXED, __HIP_MEMORY_SCOPE_AGENT); }
__device__ __forceinline__ unsigned xb_add(unsigned* p, unsigned v) { return __hip_atomic_fetch_add(p, v, __ATOMIC_RELAXED, __HIP_MEMORY_SCOPE_AGENT); }
__device__ __forceinline__ unsigned xb_xcc_id() { return (unsigned)__builtin_amdgcn_s_getreg((3 << 11) | 20) & 0xFu; }
#define XB_SPIN(cond, bar) do { unsigned _sp = 0; while (cond) { __builtin_amdgcn_s_sleep(1); \
    if ((++_sp & 255u) == 0u) { if (xb_ld(&(bar)[XB_TMO])) break; if (_sp > XB_SPIN_CAP) { atomicAdd(&(bar)[XB_TMO], 1u); break; } } } } while (0)

struct XcdBarrier {
    unsigned* bar; unsigned x; int wave;
    volatile LAS unsigned* st;
};

__device__ __forceinline__ XcdBarrier xcd_barrier_post(unsigned* bar, volatile LAS unsigned* st) {
    XcdBarrier b; b.bar = bar; b.x = xb_xcc_id(); b.st = st;
    if (threadIdx.x == 0) (void)xb_add(&bar[XB_XCNT(b.x)], 1u);
    return b;
}
__device__ __forceinline__ void xcd_barrier_complete(unsigned* bar, unsigned x, unsigned& nloc, unsigned& nx) {
    const unsigned G = gridDim.x * gridDim.y * gridDim.z;
    unsigned sum, cnt, mine, sp = 0u;
    for (;;) {
        sum = 0u; cnt = 0u; mine = 0u;
#pragma unroll
        for (unsigned j = 0; j < 16; ++j) { const unsigned c = xb_ld(&bar[XB_XCNT(j)]); sum += c; cnt += (c > 0u) ? 1u : 0u; mine = (j == x) ? c : mine; }
        if (sum == G) break;
        __builtin_amdgcn_s_sleep(1);
        if ((++sp & 255u) == 0u) { if (xb_ld(&bar[XB_TMO])) break; if (sp > XB_SPIN_CAP) { atomicAdd(&bar[XB_TMO], 1u); break; } }
    }
    nloc = mine > 0u ? mine : 1u; nx = cnt > 0u ? cnt : 1u;
}

__device__ __forceinline__ void xcd_barrier(const XcdBarrier& b) {
    asm volatile("s_waitcnt vmcnt(0)" ::: "memory");
    __syncthreads();
    if (b.wave == 0 && lane_now() == 0) {
        unsigned* bar = b.bar;
        __builtin_amdgcn_s_waitcnt(0);
        unsigned nloc = b.st[0], nx = b.st[1];
        if (nloc == 0u) { xcd_barrier_complete(bar, b.x, nloc, nx); b.st[0] = nloc; b.st[1] = nx; }
        const unsigned old = xb_add(&bar[XB_XSUB(b.x)], 1u);
        const unsigned gen = old / nloc;
        if (old + 1u == (gen + 1u) * nloc) {
            __builtin_amdgcn_fence(__ATOMIC_RELEASE, "agent");
            asm volatile("s_waitcnt vmcnt(0)" ::: "memory");
            const unsigned og = xb_add(&bar[XB_TOP], 1u);
            const unsigned tg = og / nx;
            if (og + 1u == (tg + 1u) * nx) xb_add(&bar[XB_TOPGEN], 1u);
            else XB_SPIN(xb_ld(&bar[XB_TOPGEN]) == tg, bar);
            __builtin_amdgcn_fence(__ATOMIC_ACQUIRE, "agent");
            xb_add(&bar[XB_XGEN(b.x)], 1u);
            asm volatile("s_waitcnt vmcnt(0)" ::: "memory");
        } else {
            XB_SPIN(xb_ld(&bar[XB_XGEN(b.x)]) == gen, bar);
            __builtin_amdgcn_fence(__ATOMIC_ACQUIRE, "agent");
            asm volatile("s_waitcnt vmcnt(0)" ::: "memory");
        }
    }
    __syncthreads();
}
#define DEVI __device__ __forceinline__
constexpr int NWAVES = 8;
constexpr int RING_OFF = 0, RING_BYTES = 131072;
constexpr int LDSCTL_OFF = RING_BYTES, MISC_OFF = LDSCTL_OFF + 320;
constexpr int LDS_BYTES = 151552;

typedef unsigned v2u __attribute__((ext_vector_type(2)));
typedef float f32x2 __attribute__((ext_vector_type(2)));
DEVI float bf2f(unsigned v) { return __uint_as_float(v << 16); }
DEVI float wave_sum(float v) {
#pragma unroll
    for (int o = 1; o < 64; o <<= 1) v += __shfl_xor(v, o);
    return v;
}
DEVI int tok_row(int b, int t) { return t < NM ? MR + b * NM + t : b * S + (t - NM); }
DEVI float log_sigmoid(float z) { return fminf(z, 0.f) - log1pf(__expf(-fabsf(z))); }

struct Args { const float* in[24]; float* out; unsigned char* ws; int ph_lo, ph_hi; int abl; };
struct Frame {
    const __attribute__((address_space(4))) Args* ka;
    LAS unsigned char* lds;
    volatile LAS unsigned* MISC;
    gu32* ctl;
    int tid, lane, wave, vcu, G;
    unsigned char* ws;
    float* out;
};
#define WSP(T, off) ((T*)(F.ws + (off)))

DEVI f32x4 mma_nt(const LAS bf16_t* A, int lda, const LAS bf16_t* B, int ldb, int K, int lane, f32x4 acc) {
    const LAS bf16_t* ap = A + (lane & 15) * lda + 8 * (lane >> 4); const LAS bf16_t* bp = B + (lane & 15) * ldb + 8 * (lane >> 4);
    for (int k0 = 0; k0 < K; k0 += 32) {
        const bf16x8 a = *(const LAS bf16x8*)(ap + k0), b = *(const LAS bf16x8*)(bp + k0);
        acc = __builtin_amdgcn_mfma_f32_16x16x32_bf16(a, b, acc, 0, 0, 0);
    }
    return acc;
}
constexpr int TLD = 72;
DEVI void tr_item(const float* W, int ldw, int nmax, const float* gain, bf16_t* WT, int ldk, int k0, int n0, int dest_row0, LAS bf16_t* Tt, int lane, int dest_row1 = -1) {
    if (dest_row1 < 0) dest_row1 = dest_row0 + 32;
    const int nq = lane & 15, kq = lane >> 4; const bool okc = (n0 + 4 * nq) < nmax;
    f32x4 v[16];
#pragma unroll
    for (int it = 0; it < 16; ++it) v[it] = okc ? __builtin_nontemporal_load((const GAS f32x4*)(W + (size_t)(k0 + kq * 16 + it) * ldw + n0 + 4 * nq)) : (f32x4){0.f, 0.f, 0.f, 0.f};
    f32x4 gs[4];
#pragma unroll
    for (int g = 0; g < 4; ++g) gs[g] = gain ? *(const f32x4*)(gain + k0 + kq * 16 + 4 * g) : (f32x4){1.f, 1.f, 1.f, 1.f};
#pragma unroll
    for (int i = 0; i < 4; ++i) { const int n = 4 * nq + i, sw = ((n >> 2) & 7);
#pragma unroll
        for (int hf = 0; hf < 2; ++hf) { v4u w;
            w.x = pk2(v[8 * hf + 0][i] * gs[2 * hf][0], v[8 * hf + 1][i] * gs[2 * hf][1]); w.y = pk2(v[8 * hf + 2][i] * gs[2 * hf][2], v[8 * hf + 3][i] * gs[2 * hf][3]);
            w.z = pk2(v[8 * hf + 4][i] * gs[2 * hf + 1][0], v[8 * hf + 5][i] * gs[2 * hf + 1][1]); w.w = pk2(v[8 * hf + 6][i] * gs[2 * hf + 1][2], v[8 * hf + 7][i] * gs[2 * hf + 1][3]);
            *(LAS v4u*)(Tt + n * TLD + (((kq * 2 + hf) ^ sw) << 3)) = w; } }
    LDS_WAIT(); asm volatile("" ::: "memory");
    const int c = lane & 7;
#pragma unroll
    for (int j = 0; j < 8; ++j) { const int n = (lane >> 3) + 8 * j;
        if (n0 + n < nmax) *(GAS v4u*)(WT + (size_t)(n < 32 ? dest_row0 + n : dest_row1 + n - 32) * ldk + k0 + 8 * c) = *(const LAS v4u*)(Tt + n * TLD + ((8 * c) ^ (((n >> 2) & 7) << 3))); }
    LDS_WAIT(); asm volatile("" ::: "memory");
}
constexpr int TLD8 = 80;
DEVI void tr_item8(const float* W, int ldw, int nmax, const float* gain, float wscale, unsigned char* WT, int ldk, int k0, int n0, int dest_row0, LAS unsigned char* Tt, int lane, int dest_row1) {
    const int nq = lane & 15, kq = lane >> 4; const bool okc = (n0 + 4 * nq) < nmax;
    f32x4 v[16];
#pragma unroll
    for (int it = 0; it < 16; ++it) v[it] = okc ? __builtin_nontemporal_load((const GAS f32x4*)(W + (size_t)(k0 + kq * 16 + it) * ldw + n0 + 4 * nq)) : (f32x4){0.f, 0.f, 0.f, 0.f};
    f32x4 gs[4];
#pragma unroll
    for (int g = 0; g < 4; ++g) { gs[g] = gain ? *(const f32x4*)(gain + k0 + kq * 16 + 4 * g) : (f32x4){1.f, 1.f, 1.f, 1.f}; gs[g] = gs[g] * wscale; }
#pragma unroll
    for (int i = 0; i < 4; ++i) { v4u w;
        w.x = f8pack4(v[0][i] * gs[0][0], v[1][i] * gs[0][1], v[2][i] * gs[0][2], v[3][i] * gs[0][3]);
        w.y = f8pack4(v[4][i] * gs[1][0], v[5][i] * gs[1][1], v[6][i] * gs[1][2], v[7][i] * gs[1][3]);
        w.z = f8pack4(v[8][i] * gs[2][0], v[9][i] * gs[2][1], v[10][i] * gs[2][2], v[11][i] * gs[2][3]);
        w.w = f8pack4(v[12][i] * gs[3][0], v[13][i] * gs[3][1], v[14][i] * gs[3][2], v[15][i] * gs[3][3]);
        *(LAS v4u*)(Tt + (4 * nq + i) * TLD8 + kq * 16) = w; }
    LDS_WAIT(); asm volatile("" ::: "memory");
#pragma unroll
    for (int j = 0; j < 4; ++j) { const int n = (lane >> 2) + 16 * j, c = lane & 3;
        if (n0 + n < nmax) *(GAS v4u*)(WT + (size_t)(n < 32 ? dest_row0 + n : dest_row1 + n - 32) * ldk + k0 + 16 * c) = *(const LAS v4u*)(Tt + n * TLD8 + 16 * c); }
    LDS_WAIT(); asm volatile("" ::: "memory");
}
DEVI void convert_moe(Frame& F, int layer, int lo, int hi, int gw, int NGW) {
    LAS bf16_t* scr = (LAS bf16_t*)(F.lds + RING_OFF + F.wave * 16384);
    const float* Wg = F.ka->in[21] + (size_t)layer * NEXP * D * 256; const float* Wu = F.ka->in[22] + (size_t)layer * NEXP * D * 256; const float* Wd = F.ka->in[23] + (size_t)layer * NEXP * 256 * D;
    const float* gain = F.ka->in[3] + layer * D;
    bf16_t* GU = WSP(bf16_t, layer ? WS_MOEGU1 : WS_MOEGU); bf16_t* DW = WSP(bf16_t, layer ? WS_MOED1 : WS_MOED);
    for (int it = lo + gw; it < hi; it += NGW) {
        const int kind = it >> 11, r = it & 2047, e = r >> 6, q = r & 63;
        if (kind < 2) { const int kb = q >> 2, nb = q & 3, n0 = nb * 64;
            const int dr = e * 512 + (n0 >> 7) * 256 + (n0 & 127) + kind * 128;
            if (layer || MOE0_FP8) tr_item8((kind ? Wu : Wg) + (size_t)e * D * 256, 256, 256, gain, (float)(1 << F8_WSHIFT), (unsigned char*)GU, D, kb * 64, n0, dr, (LAS unsigned char*)scr, F.lane, dr + 32);
            else tr_item((kind ? Wu : Wg) + (size_t)e * D * 256, 256, 256, gain, GU, D, kb * 64, n0, dr, scr, F.lane);
        } else { const int kb = q >> 4, nb = q & 15;
            if (layer || MOE0_FP8) tr_item8(Wd + (size_t)e * 256 * D, D, D, nullptr, (float)(1 << F8_WSHIFT), (unsigned char*)DW, 256, kb * 64, nb * 64, e * 1024 + nb * 64, (LAS unsigned char*)scr, F.lane, e * 1024 + nb * 64 + 32);
            else tr_item(Wd + (size_t)e * 256 * D, D, D, nullptr, DW, 256, kb * 64, nb * 64, e * 1024 + nb * 64, scr, F.lane); }
    }
}
constexpr int CONV_ITEMS = 3 * 2048, CONV_PER_WG = 24;
DEVI void convert_small_item(Frame& F, int which, int r) {
    LAS bf16_t* scr = (LAS bf16_t*)(F.lds + RING_OFF + F.wave * 16384);
    if (which == 0) { tr_item(F.ka->in[12], D, D, nullptr, WSP(bf16_t, WS_WO0), D, (r / 16) * 64, (r % 16) * 64, (r % 16) * 64, scr, F.lane); }
    else if (which == 1) { const int n0 = (r % 24) * 64, tl = n0 >> 8, hd = (n0 >> 6) & 3;
        tr_item8(F.ka->in[13], NA, NA, F.ka->in[2] + D, (float)(1 << F8_WSHIFT), WSP(unsigned char, WS_WAI), D, (r / 24) * 64, n0, tl < 5 ? tl * 256 + hd * 32 : n0, (LAS unsigned char*)scr, F.lane, tl < 5 ? tl * 256 + 128 + hd * 32 : n0 + 32); }
    else { tr_item8(F.ka->in[16], D, D, nullptr, (float)(1 << F8_WSHIFT), WSP(unsigned char, WS_WAO), D, (r / 16) * 64, (r % 16) * 64, (r % 16) * 64, (LAS unsigned char*)scr, F.lane, (r % 16) * 64 + 32); }
}
DEVI void router_weights(Frame& F, int gt, int NGT) {
    bf16_t* WR = WSP(bf16_t, WS_WR);
    for (int idx = gt; idx < 2 * 48 * D; idx += NGT) { const int l = idx / (48 * D), j = (idx / D) % 48, k = idx % D;
        float w = (j < 4) ? F.ka->in[17][((size_t)l * D + k) * 4 + j] : (j < 36) ? F.ka->in[19][((size_t)l * D + k) * 32 + (j - 4)] : 0.f; w *= F.ka->in[3][l * D + k];
        const unsigned hi = f2bf(w); const unsigned lo = f2bf(w - bf2f(hi));
        WR[((size_t)(l * 2 + 0) * 48 + j) * D + k] = (bf16_t)hi; WR[((size_t)(l * 2 + 1) * 48 + j) * D + k] = (bf16_t)lo; }
}
constexpr int GLA_SHORT0 = (Bz * 4 * NCH) % 256;
constexpr int CONV_P1_END = 114 * CONV_PER_WG;
DEVI void p0_prologue(Frame& F) {
    LAS bf16_t* scr = (LAS bf16_t*)(F.lds + RING_OFF + F.wave * 16384);
    const int gw = F.vcu * NWAVES + F.wave, NGW = F.G * NWAVES;
    const int gt = F.vcu * 512 + F.tid, NGT = F.G * 512;
    for (int it = gw; it < 16 * 48; it += NGW) { const int n0 = (it % 48) * 64; int dr = n0;
        if (n0 >= 512 && n0 < 1024) { const int c = n0 - 512; dr = (2 + (c >> 7)) * 256 + (c & 127); } else if (n0 >= 1024 && n0 < 1536) { const int c = n0 - 1024; dr = (2 + (c >> 7)) * 256 + 128 + (c & 127); }
        tr_item(F.ka->in[5], 3104, 3072, F.ka->in[2], WSP(bf16_t, WS_WIN), D, (it / 48) * 64, n0, dr, scr, F.lane); }
    if (F.G != 256) { for (int it = gw; it < 256 + 384 + 256; it += NGW) convert_small_item(F, it < 256 ? 0 : it < 640 ? 1 : 2, it < 256 ? it : it < 640 ? it - 256 : it - 640);
        convert_moe(F, 0, 0, CONV_ITEMS, gw, NGW); }
    { bf16_t* WT = WSP(bf16_t, WS_WIN);
      for (int idx = gt; idx < 2 * 256 * (D / 8); idx += NGT) { const int k8 = idx & 127, n = (idx >> 7) & 255, dir = idx >> 15; const float* wg = dir ? F.ka->in[9] : F.ka->in[7]; float wj[16];
#pragma unroll
          for (int j = 0; j < 16; ++j) wj[j] = wg[j * 256 + n];
          unsigned ow[4];
#pragma unroll
          for (int i2 = 0; i2 < 4; ++i2) { float r2[2];
#pragma unroll
              for (int e2 = 0; e2 < 2; ++e2) { const int k = k8 * 8 + i2 * 2 + e2; const f32x4* wp = (const f32x4*)(F.ka->in[5] + (size_t)k * 3104 + 3072 + 16 * dir); float s = 0.f;
#pragma unroll
                  for (int j4 = 0; j4 < 4; ++j4) { const f32x4 w4 = wp[j4]; s += w4[0] * wj[j4 * 4] + w4[1] * wj[j4 * 4 + 1] + w4[2] * wj[j4 * 4 + 2] + w4[3] * wj[j4 * 4 + 3]; }
                  r2[e2] = s * F.ka->in[2][k]; }
              ow[i2] = pk2(r2[0], r2[1]); }
          *(GAS v4u*)(WT + (size_t)(W_LA + dir * 256 + n) * D + k8 * 8) = (v4u){ow[0], ow[1], ow[2], ow[3]}; } }
    if (F.G != 256) router_weights(F, gt, NGT);
    { bf16_t* HB = WSP(bf16_t, WS_HB); float* SS = WSP(float, WS_SS);
      for (int m0 = gw; m0 < MP; m0 += 2 * NGW) { f32x4 v[2][4];
#pragma unroll
          for (int u = 0; u < 2; ++u) { const int m = m0 + u * NGW;
              if (m < MA) { const float* src = (m < MR) ? F.ka->in[0] + (size_t)m * D : F.ka->in[1] + (size_t)((m - MR) & 15) * D; const GAS f32x4* xr = (const GAS f32x4*)src + F.lane;
#pragma unroll
                  for (int j = 0; j < 4; ++j) v[u][j] = xr[64 * j];
              } else {
#pragma unroll
                  for (int j = 0; j < 4; ++j) v[u][j] = (f32x4){0.f, 0.f, 0.f, 0.f}; } }
#pragma unroll
          for (int u = 0; u < 2; ++u) { const int m = m0 + u * NGW; if (m >= MP) continue;
              GAS v2u* o8 = (GAS v2u*)(HB + (size_t)m * D) + F.lane; float s = 0.f;
#pragma unroll
              for (int j = 0; j < 4; ++j) { s += (v[u][j].x * v[u][j].x + v[u][j].y * v[u][j].y) + (v[u][j].z * v[u][j].z + v[u][j].w * v[u][j].w); o8[64 * j] = (v2u){pk2(v[u][j].x, v[u][j].y), pk2(v[u][j].z, v[u][j].w)}; }
              s = wave_sum(s);
              if (F.lane == 0) { SS[m] = s; if (m >= MA) { SS[MP + m] = 0.f; SS[2 * MP + m] = 0.f; } } }
      } }
}

constexpr int GL_LA = 0;
constexpr int GL_WG = 32768;
constexpr int GL_G = 40960;
constexpr int GL_BIAS = 49152;
constexpr int GL_SEG = 49664;
constexpr int GL_CL = 51712;
constexpr int GL_OP0 = 52224;
constexpr int GL_OP1 = GL_OP0 + 18432;
constexpr int GL_VT = GL_OP1 + 18432;
constexpr int GL_P = GL_VT + 18432;
constexpr int GL_SSQ = GL_P + 9216;
static_assert(GL_SSQ + 2048 <= RING_BYTES, "GLA LDS map");
constexpr int LDP = 72;
constexpr int LAP = 65;

DEVI int gla_row(int b, int n, int t) { return n == 0 ? MR + b * NM + t : b * S + (n - 1) * 64 + t; }
DEVI void gla_load_la(const bf16_t* U, int tid, int b, int h, int n, v4u& r0, v4u& r1) {
    const int dir = tid >> 8, t = (tid >> 2) & 63, dq = tid & 3, nval = (n == 0) ? NM : 64; r0 = (v4u){0u, 0u, 0u, 0u}; r1 = r0;
    if (t < nval) { const v4u* lp = (const v4u*)(U + uoff(gla_row(b, n, t), U_LA + dir * 256 + h * 64 + dq * 16)); r0 = lp[0]; r1 = lp[1]; }
}
DEVI void gla_cum(Frame& F, int n, v4u r0, v4u r1) {
    LAS float* LA = (LAS float*)(F.lds + GL_LA);
    LAS float* SEG = (LAS float*)(F.lds + GL_SEG); LAS float* CL = (LAS float*)(F.lds + GL_CL);
    const int tid = F.tid, nval = (n == 0) ? NM : 64;
    { const int dir = tid >> 8, t = (tid >> 2) & 63, dq = tid & 3; (void)nval;
      const unsigned lw[8] = {r0.x, r0.y, r0.z, r0.w, r1.x, r1.y, r1.z, r1.w};
#pragma unroll
      for (int i = 0; i < 16; ++i) LA[(dir * 64 + t) * LAP + dq * 16 + i] = bf2f((lw[i >> 1] >> ((i & 1) * 16)) & 0xffffu); }
    __syncthreads();
    { const int dir = tid >> 8, seg = (tid >> 6) & 3, d = tid & 63; float run = 0.f; float loc[16];
#pragma unroll
      for (int i = 0; i < 16; ++i) { const int p = seg * 16 + i, t = dir ? 63 - p : p; run += LA[(dir * 64 + t) * LAP + d]; loc[i] = run; }
      SEG[(dir * 4 + seg) * 64 + d] = run;
      __syncthreads();
      float off = 0.f;
#pragma unroll
      for (int s2 = 0; s2 < 4; ++s2) if (s2 < seg) off += SEG[(dir * 4 + s2) * 64 + d];
#pragma unroll
      for (int i = 0; i < 16; ++i) { const int p = seg * 16 + i, t = dir ? 63 - p : p; LA[(dir * 64 + t) * LAP + d] = off + loc[i]; }
      if (seg == 3) CL[dir * 64 + d] = off + run; }
    __syncthreads();
}

DEVI void p2_gla_kv(Frame& F) {
    const bf16_t* U = WSP(bf16_t, WS_BIG); bf16_t* KVSB = WSP(bf16_t, WS_H); float* DEC = WSP(float, WS_DEC);
    LAS float* LA = (LAS float*)(F.lds + GL_LA); LAS float* CL = (LAS float*)(F.lds + GL_CL);
    LAS bf16_t* KE = (LAS bf16_t*)(F.lds + GL_OP0); LAS bf16_t* VT = (LAS bf16_t*)(F.lds + GL_VT);
    const int tid = F.tid, lane = F.lane, w = F.wave;
#define P2_LOAD(UNIT, LA0, LA1, KR, V0, V1) do { const int n_ = (UNIT) % NCH, h_ = ((UNIT) / NCH) & 3, b_ = (UNIT) / (NCH * 4); gla_load_la(U, tid, b_, h_, n_, LA0, LA1); \
        const int t_ = tid >> 3, dg_ = tid & 7; KR = (v4u){0u, 0u, 0u, 0u}; V0 = KR; V1 = KR; \
        if (t_ < ((n_ == 0) ? NM : 64)) { const int ur_ = gla_row(b_, n_, t_); KR = *(const v4u*)(U + uoff(ur_, U_K + h_ * 64 + dg_ * 8)); const v4u* vp_ = (const v4u*)(U + uoff(ur_, U_V + h_ * 128 + dg_ * 16)); V0 = vp_[0]; V1 = vp_[1]; } } while (0)
    v4u la0, la1, kr, v0, v1, nla0, nla1, nkr, nv0, nv1;
    if (F.vcu < Bz * 4 * NCH) P2_LOAD(F.vcu, la0, la1, kr, v0, v1);
    for (int unit = F.vcu; unit < Bz * 4 * NCH; unit += F.G) {
        const int n = unit % NCH, h = (unit / NCH) & 3, b = unit / (NCH * 4);
        const bool has_nx = unit + F.G < Bz * 4 * NCH;
        if (has_nx) P2_LOAD(unit + F.G, nla0, nla1, nkr, nv0, nv1);
        gla_cum(F, n, la0, la1);
        { const int t = tid >> 3, dg = tid & 7;
          const unsigned kw[4] = {kr.x, kr.y, kr.z, kr.w};
#pragma unroll
          for (int dir = 0; dir < 2; ++dir)
#pragma unroll
              for (int i = 0; i < 8; ++i) { const int d = dg * 8 + i; const float kv = bf2f((kw[i >> 1] >> ((i & 1) * 16)) & 0xffffu);
                  KE[(dir * 64 + d) * LDP + (t ^ (dg << 3))] = (bf16_t)f2bf(kv * __expf(CL[dir * 64 + d] - LA[(dir * 64 + t) * LAP + d])); }
          const unsigned vw[8] = {v0.x, v0.y, v0.z, v0.w, v1.x, v1.y, v1.z, v1.w};
#pragma unroll
          for (int i = 0; i < 16; ++i) VT[(dg * 16 + i) * LDP + (t ^ (dg << 3))] = (bf16_t)((vw[i >> 1] >> ((i & 1) * 16)) & 0xffffu); }
        __syncthreads();
        { const int dir = w >> 2, dt = w & 3, q = lane >> 4; const size_t seq = (size_t)((b * 4 + h) * 2 + dir) * NCH + n;
          bf16_t* outp = KVSB + seq * 8192;
#pragma unroll 2
          for (int vt = 0; vt < 8; ++vt) { f32x4 acc = (f32x4){0.f, 0.f, 0.f, 0.f};
              { const LAS bf16_t* ap = KE + (dir * 64 + dt * 16 + (lane & 15)) * LDP; const LAS bf16_t* bp = VT + (vt * 16 + (lane & 15)) * LDP; const int sa = (dt * 2 + ((lane & 15) >> 3)) << 3, sb = vt << 3, kq = 8 * (lane >> 4);
#pragma unroll
                for (int k0 = 0; k0 < 64; k0 += 32) acc = __builtin_amdgcn_mfma_f32_16x16x32_bf16(*(const LAS bf16x8*)(ap + ((k0 + kq) ^ sa)), *(const LAS bf16x8*)(bp + ((k0 + kq) ^ sb)), acc, 0, 0, 0); }
              *(v2u*)(outp + (vt * 16 + (lane & 15)) * 64 + dt * 16 + 4 * q) = (v2u){pk2(acc[0], acc[1]), pk2(acc[2], acc[3])}; }
          if (tid < 128) { const int dd = tid >> 6, d = tid & 63; DEC[((size_t)((b * 4 + h) * 2 + dd) * NCH + n) * 64 + d] = __expf(CL[dd * 64 + d]); } }
        __syncthreads();
        if (has_nx) { la0 = nla0; la1 = nla1; kr = nkr; v0 = nv0; v1 = nv1; }
    }
#undef P2_LOAD
}

DEVI void p3_gla_scan(Frame& F) {
    bf16_t* KVSB = WSP(bf16_t, WS_H); const float* DEC = WSP(float, WS_DEC);
    for (int item = F.vcu * 512 + F.tid; item < 64 * 2048; item += F.G * 512) {
        const int seq = item >> 11, off4 = item & 2047, dir = seq & 1, d = (off4 * 4) & 63;
        bf16_t* base = KVSB + (size_t)seq * NCH * 8192 + off4 * 4; const float* db = DEC + (size_t)seq * NCH * 64 + d;
        f32x4 Sx = (f32x4){0.f, 0.f, 0.f, 0.f};
#pragma unroll 1
        for (int g3 = 0; g3 < 2; ++g3) {
            v2u kv[17]; f32x4 dc[17];
#pragma unroll
            for (int i = 0; i < 17; ++i) { const int st = g3 * 17 + i; if (st < NCH) { const int n = dir ? NCH - 1 - st : st; kv[i] = *(const v2u*)(base + (size_t)n * 8192); dc[i] = *(const f32x4*)(db + n * 64); } }
#pragma unroll
            for (int i = 0; i < 17; ++i) { const int st = g3 * 17 + i; if (st < NCH) { const int n = dir ? NCH - 1 - st : st;
                *(v2u*)(base + (size_t)n * 8192) = (v2u){pk2(Sx[0], Sx[1]), pk2(Sx[2], Sx[3])};
                const f32x4 kvf = (f32x4){bf2f(kv[i].x & 0xffffu), bf2f(kv[i].x >> 16), bf2f(kv[i].y & 0xffffu), bf2f(kv[i].y >> 16)};
                Sx = dc[i] * Sx + kvf; } }
        }
    }
}

DEVI void p4_gla_out(Frame& F) {
    const bf16_t* U = WSP(bf16_t, WS_BIG); const bf16_t* KVSB = WSP(bf16_t, WS_H); bf16_t* YM = WSP(bf16_t, WS_HB);
    LAS float* LA = (LAS float*)(F.lds + GL_LA); LAS float* SSQ = (LAS float*)(F.lds + GL_SSQ);
    LAS bf16_t* QD = (LAS bf16_t*)(F.lds + GL_OP0); LAS bf16_t* KI = (LAS bf16_t*)(F.lds + GL_OP1); LAS bf16_t* VT = (LAS bf16_t*)(F.lds + GL_VT); LAS bf16_t* Pm = (LAS bf16_t*)(F.lds + GL_P);
    const float* cw = F.ka->in[6]; const float* gnw = F.ka->in[11];
    const int tid = F.tid, lane = F.lane, w = F.wave, q = lane >> 4, fr = lane & 15;
    for (int unit = F.vcu; unit < Bz * 4 * NCH; unit += F.G) {
        const int n = unit % NCH, h = (unit / NCH) & 3, b = unit / (NCH * 4), nval = (n == 0) ? NM : 64;
        v4u la0, la1; gla_load_la(U, tid, b, h, n, la0, la1);
        v4u cab[2], cz1[2], czp[2], czn[2]; f32x4 cwt[3][4];
        { const int t = tid >> 3, cg = tid & 7, c0 = h * 128 + cg * 16;
#pragma unroll
          for (int hh = 0; hh < 2; ++hh) { cab[hh] = (v4u){0u, 0u, 0u, 0u}; cz1[hh] = cab[hh]; czp[hh] = cab[hh]; czn[hh] = cab[hh]; }
          constexpr size_t UZP = (size_t)2 * MP * 256;
          if (t < nval) { const int tpos = (n == 0) ? t : NM + (n - 1) * 64 + t;
              const bf16_t* u1 = U + uoff(gla_row(b, n, t), c0); const bf16_t* u0 = (tpos > 0) ? U + uoff(tok_row(b, tpos - 1), c0) : nullptr;
              const bf16_t* u2 = (tpos < T - 1) ? U + uoff(tok_row(b, tpos + 1), c0) : nullptr;
#pragma unroll
              for (int hh = 0; hh < 2; ++hh) { cab[hh] = *(const v4u*)(u1 + hh * 8); cz1[hh] = *(const v4u*)(u1 + UZP + hh * 8);
                  if (u0) czp[hh] = *(const v4u*)(u0 + UZP + hh * 8);
                  if (u2) czn[hh] = *(const v4u*)(u2 + UZP + hh * 8); } }
#pragma unroll
          for (int tap = 0; tap < 3; ++tap)
#pragma unroll
              for (int j4 = 0; j4 < 4; ++j4) cwt[tap][j4] = *(const f32x4*)(cw + tap * 512 + c0 + 4 * j4); }
        v4u qr = (v4u){0u, 0u, 0u, 0u}, kr = qr, v0 = qr, v1 = qr;
        { const int t = tid >> 3, dg = tid & 7;
          if (t < nval) { const int ur = gla_row(b, n, t); qr = *(const v4u*)(U + uoff(ur, U_Q + h * 64 + dg * 8)); kr = *(const v4u*)(U + uoff(ur, U_K + h * 64 + dg * 8));
              const v4u* vp = (const v4u*)(U + uoff(ur, U_V + h * 128 + dg * 16)); v0 = vp[0]; v1 = vp[1]; } }
        const size_t seqf = (size_t)((b * 4 + h) * 2 + 0) * NCH + n, seqb = (size_t)((b * 4 + h) * 2 + 1) * NCH + n;
        const bf16_t* sfp = KVSB + seqf * 8192 + (size_t)(w * 16 + fr) * 64 + 8 * q; const bf16_t* sbp = KVSB + seqb * 8192 + (size_t)(w * 16 + fr) * 64 + 8 * q;
        const bf16x8 sf0 = *(const bf16x8*)(sfp), sf1 = *(const bf16x8*)(sfp + 32), sb0 = *(const bf16x8*)(sbp), sb1 = *(const bf16x8*)(sbp + 32);
        const f32x4 gw4 = *(const f32x4*)(gnw + w * 16 + 4 * q);
        v2u rg[4];
#pragma unroll
        for (int tt = 0; tt < 4; ++tt) { const int t = tt * 16 + fr; rg[tt] = (v2u){0u, 0u}; if (t < nval) rg[tt] = *(const v2u*)(U + uoff(gla_row(b, n, t), U_R + h * 128 + w * 16 + 4 * q)); }
        gla_cum(F, n, la0, la1);
        { const int t = tid >> 3, cg = tid & 7;
          if (t < nval) { const int c0 = h * 128 + cg * 16; unsigned outw[8];
#pragma unroll
              for (int hh = 0; hh < 2; ++hh) {
                  const unsigned abw[4] = {cab[hh].x, cab[hh].y, cab[hh].z, cab[hh].w}, z1w[4] = {cz1[hh].x, cz1[hh].y, cz1[hh].z, cz1[hh].w}, zpw[4] = {czp[hh].x, czp[hh].y, czp[hh].z, czp[hh].w}, znw[4] = {czn[hh].x, czn[hh].y, czn[hh].z, czn[hh].w};
#pragma unroll
                  for (int i2 = 0; i2 < 4; ++i2) { float yv[2];
#pragma unroll
                      for (int e2 = 0; e2 < 2; ++e2) { const int ci = hh * 8 + i2 * 2 + e2; const int sh = e2 * 16;
                          yv[e2] = bf2f((abw[i2] >> sh) & 0xffffu) * (cwt[0][ci >> 2][ci & 3] * bf2f((zpw[i2] >> sh) & 0xffffu) + cwt[1][ci >> 2][ci & 3] * bf2f((z1w[i2] >> sh) & 0xffffu) + cwt[2][ci >> 2][ci & 3] * bf2f((znw[i2] >> sh) & 0xffffu)); }
                      outw[hh * 4 + i2] = pk2(yv[0], yv[1]); } }
              v4u* yp = (v4u*)(YM + (size_t)gla_row(b, n, t) * D + c0); yp[0] = (v4u){outw[0], outw[1], outw[2], outw[3]}; yp[1] = (v4u){outw[4], outw[5], outw[6], outw[7]}; } }
        { const int t = tid >> 3, dg = tid & 7;
          const unsigned qw[4] = {qr.x, qr.y, qr.z, qr.w}, kw[4] = {kr.x, kr.y, kr.z, kr.w};
#pragma unroll
          for (int dir = 0; dir < 2; ++dir) { unsigned qo[4], ko[4];
#pragma unroll
              for (int i2 = 0; i2 < 4; ++i2) { float qv[2], kv[2];
#pragma unroll
                  for (int e2 = 0; e2 < 2; ++e2) { const int d = dg * 8 + i2 * 2 + e2; const float c = LA[(dir * 64 + t) * LAP + d];
                      qv[e2] = bf2f((qw[i2] >> (e2 * 16)) & 0xffffu) * 0.125f * __expf(c); kv[e2] = bf2f((kw[i2] >> (e2 * 16)) & 0xffffu) * __expf(-c); }
                  qo[i2] = pk2(qv[0], qv[1]); ko[i2] = pk2(kv[0], kv[1]); }
              *(LAS v4u*)(QD + (dir * 64 + t) * LDP + dg * 8) = (v4u){qo[0], qo[1], qo[2], qo[3]};
              *(LAS v4u*)(KI + (dir * 64 + t) * LDP + dg * 8) = (v4u){ko[0], ko[1], ko[2], ko[3]}; }
          const unsigned vw[8] = {v0.x, v0.y, v0.z, v0.w, v1.x, v1.y, v1.z, v1.w};
#pragma unroll
          for (int i = 0; i < 16; ++i) VT[(dg * 16 + i) * LDP + (t ^ (dg << 3))] = (bf16_t)((vw[i >> 1] >> ((i & 1) * 16)) & 0xffffu); }
        __syncthreads();
#pragma unroll
        for (int x = 0; x < 2; ++x) { const int tile = w * 2 + x, st = tile >> 2, tt = tile & 3; f32x4 af = (f32x4){0.f, 0.f, 0.f, 0.f}, ab = af;
            af = mma_nt(KI + (0 * 64 + st * 16) * LDP, LDP, QD + (0 * 64 + tt * 16) * LDP, LDP, 64, lane, af);
            ab = mma_nt(KI + (1 * 64 + st * 16) * LDP, LDP, QD + (1 * 64 + tt * 16) * LDP, LDP, 64, lane, ab);
            const int t = tt * 16 + fr, s0 = st * 16 + 4 * q; float pv[4];
#pragma unroll
            for (int r = 0; r < 4; ++r) pv[r] = (s0 + r <= t) ? af[r] : ab[r];
            *(LAS v2u*)(Pm + t * LDP + s0) = (v2u){pk2(pv[0], pv[1]), pk2(pv[2], pv[3])}; }
        __syncthreads();
        f32x4 o[4];
        { const LAS bf16_t* vtp = VT + (w * 16 + fr) * LDP; const bf16x8 va0 = *(const LAS bf16x8*)(vtp + ((8 * q) ^ (w << 3))), va1 = *(const LAS bf16x8*)(vtp + ((32 + 8 * q) ^ (w << 3)));
#pragma unroll
          for (int tt = 0; tt < 4; ++tt) { f32x4 acc = (f32x4){0.f, 0.f, 0.f, 0.f};
              const LAS bf16_t* pp = Pm + (tt * 16 + fr) * LDP + 8 * q; const LAS bf16_t* qf = QD + (0 * 64 + tt * 16 + fr) * LDP + 8 * q; const LAS bf16_t* qb = QD + (1 * 64 + tt * 16 + fr) * LDP + 8 * q;
              acc = __builtin_amdgcn_mfma_f32_16x16x32_bf16(va0, *(const LAS bf16x8*)(pp), acc, 0, 0, 0);
              acc = __builtin_amdgcn_mfma_f32_16x16x32_bf16(va1, *(const LAS bf16x8*)(pp + 32), acc, 0, 0, 0);
              acc = __builtin_amdgcn_mfma_f32_16x16x32_bf16(sf0, *(const LAS bf16x8*)(qf), acc, 0, 0, 0);
              acc = __builtin_amdgcn_mfma_f32_16x16x32_bf16(sf1, *(const LAS bf16x8*)(qf + 32), acc, 0, 0, 0);
              acc = __builtin_amdgcn_mfma_f32_16x16x32_bf16(sb0, *(const LAS bf16x8*)(qb), acc, 0, 0, 0);
              acc = __builtin_amdgcn_mfma_f32_16x16x32_bf16(sb1, *(const LAS bf16x8*)(qb + 32), acc, 0, 0, 0);
              o[tt] = acc;
              float s2 = (acc[0] * acc[0] + acc[1] * acc[1]) + (acc[2] * acc[2] + acc[3] * acc[3]); s2 += __shfl_xor(s2, 16); s2 += __shfl_xor(s2, 32);
              if (q == 0) SSQ[w * 64 + tt * 16 + fr] = s2; } }
        __syncthreads();
        { const int v0i = w * 16 + 4 * q;
#pragma unroll
          for (int tt = 0; tt < 4; ++tt) { const int t = tt * 16 + fr; float tot = 0.f;
#pragma unroll
              for (int w2 = 0; w2 < 8; ++w2) tot += SSQ[w2 * 64 + t];
              if (t < nval) { const float rs = rsqrtf(tot * (1.0f / 128.0f) + EPS); const size_t row = (size_t)gla_row(b, n, t);
                  const v2u rr = rg[tt];
                  const float rv[4] = {bf2f(rr.x & 0xffffu), bf2f(rr.x >> 16), bf2f(rr.y & 0xffffu), bf2f(rr.y >> 16)}; float y[4];
#pragma unroll
                  for (int r = 0; r < 4; ++r) y[r] = o[tt][r] * rs * gw4[r] * (rv[r] * __builtin_amdgcn_rcpf(1.0f + __expf(-rv[r])));
                  *(v2u*)(YM + row * D + 512 + h * 128 + v0i) = (v2u){pk2(y[0], y[1]), pk2(y[2], y[3])}; } } }
        __syncthreads();
    }
}

DEVI void p5_meta_rows(Frame& F) {
    const bf16_t* YM = WSP(bf16_t, WS_HB) + (size_t)MR * D; const bf16_t* WT = WSP(bf16_t, WS_WO0); bf16_t* HR = WSP(bf16_t, WS_H) + (size_t)MR * D; const float* meta = F.ka->in[1];
    const int lane = F.lane, fr = lane & 15, q = lane >> 4;
    LAS f32x4* part = (LAS f32x4*)(F.lds + RING_OFF);
    for (int t0 = F.vcu * 2; t0 < 512; t0 += F.G * 2) {
        const int task = t0 + (F.wave >> 2), kq = F.wave & 3, ct = task >> 3, rt = task & 7;
        const bf16_t* wp = WT + (size_t)(ct * 16 + fr) * D + kq * 256 + 8 * q; const bf16_t* ap = YM + (size_t)(rt * 16 + fr) * D + kq * 256 + 8 * q;
        bf16x8 wf[8], af[8];
#pragma unroll
        for (int i = 0; i < 8; ++i) { wf[i] = *(const bf16x8*)(wp + i * 32); af[i] = *(const bf16x8*)(ap + i * 32); }
        f32x4 acc = (f32x4){0.f, 0.f, 0.f, 0.f};
#pragma unroll
        for (int i = 0; i < 8; ++i) acc = __builtin_amdgcn_mfma_f32_16x16x32_bf16(wf[i], af[i], acc, 0, 0, 0);
        part[F.wave * 64 + lane] = acc;
        __syncthreads();
        if (kq == 0) { const int wb = F.wave * 64 + lane; acc = (part[wb] + part[wb + 64]) + (part[wb + 128] + part[wb + 192]);
            const int row = rt * 16 + fr, col = ct * 16 + 4 * q;
            const f32x4 hv = *(const f32x4*)(meta + (size_t)(row & 15) * D + col) + acc;
            *(v2u*)(HR + (size_t)row * D + col) = (v2u){pk2(hv[0], hv[1]), pk2(hv[2], hv[3])};
            if (MOE0_FP8) *(unsigned*)(WSP(unsigned char, WS_HR8A) + (size_t)(MR + row) * D + col) = f8pack4(hv[0], hv[1], hv[2], hv[3]); }
        __syncthreads();
    }
}
constexpr int RT_CHB = 96 * 256;
constexpr int RT_LG = 4 * RT_CHB;
DEVI void rt_glds(const void* base, unsigned voff, unsigned ldsdst) { unsigned keep_; asm volatile("s_mov_b32 %0, m0\n\ts_mov_b32 m0, %3\n\ts_nop 0\n\tglobal_load_lds_dwordx4 %1, %2\n\ts_mov_b32 m0, %0" : "=&s"(keep_) : "v"(voff), "s"(base), "s"(ldsdst) : "memory"); }
DEVI void route_phase(Frame& F, int layer, int nrows, bool dry) {
    const bf16_t* HR = WSP(bf16_t, WS_H);
    const bf16_t* WRb = WSP(bf16_t, WS_WR) + (size_t)(layer * 2) * 48 * D;
    const float* bg = F.ka->in[18] + layer * 4; const float* be = F.ka->in[20] + layer * 32;
    unsigned* CNT = (unsigned*)F.ctl + (layer ? CW_CNT1 : CW_CNT0); int* LIST = WSP(int, WS_LIST); unsigned* RI = WSP(unsigned, WS_RI); float* RSTD = WSP(float, WS_SS) + 2 * MP; float* RSL = WSP(float, WS_RSL);
    LAS float* LG = (LAS float*)(F.lds + RT_LG + F.wave * 4096); LAS float* RS = LG + 16 * 48;
    const int lane = F.lane, fr = lane & 15, q = lane >> 4;
    const unsigned ldsb = (unsigned)(size_t)F.lds;
    unsigned woff[3];
#pragma unroll
    for (int j = 0; j < 3; ++j) { const int row = 4 * (F.wave * 3 + j) + (lane >> 4); woff[j] = (unsigned)(row * D * 2 + (((lane & 15) ^ (row & 15)) * 16)); }
#define RT_STAGE(c) do { _Pragma("unroll") for (int j_ = 0; j_ < 3; ++j_) rt_glds((const char*)WRb + (c) * 256, woff[j_], ldsb + (unsigned)(((c) & 3) * RT_CHB + (F.wave * 3 + j_) * 1024)); } while (0)
    for (int gbase = 0; gbase < nrows / 16; gbase += NWAVES * F.G) {
    const int grp = gbase + F.vcu + F.wave * F.G; const bool act = grp < nrows / 16;
    if (F.tid < 64) ((LAS unsigned*)(F.lds + RING_BYTES + 1024))[F.tid] = 0u;
    const int r0 = act ? grp * 16 : 0; const bf16_t* hp = HR + (size_t)(r0 + fr) * D + 8 * q;
    v4u x[8][4];
    if (act) {
#pragma unroll
        for (int c = 0; c < 8; ++c)
#pragma unroll
            for (int i = 0; i < 4; ++i) x[c][i] = *(const GAS v4u*)(hp + c * 128 + i * 32);
    } else {
#pragma unroll
        for (int c = 0; c < 8; ++c)
#pragma unroll
            for (int i = 0; i < 4; ++i) x[c][i] = (v4u){0u, 0u, 0u, 0u}; }
    asm volatile("s_waitcnt vmcnt(0)" ::: "memory");
    RT_STAGE(0); RT_STAGE(1); RT_STAGE(2);
    f32x4 acc[3]; acc[0] = (f32x4){0.f, 0.f, 0.f, 0.f}; acc[1] = acc[0]; acc[2] = acc[0]; float ss = 0.f;
#pragma unroll
    for (int c = 0; c < 8; ++c) {
        if (c <= 5) asm volatile("s_waitcnt vmcnt(6)" ::: "memory"); else if (c == 6) asm volatile("s_waitcnt vmcnt(3)" ::: "memory"); else asm volatile("s_waitcnt vmcnt(0)" ::: "memory");
        __syncthreads();
        if (c + 3 < 8) RT_STAGE(c + 3);
        if (act) { const LAS unsigned char* wb = (const LAS unsigned char*)(F.lds + (c & 3) * RT_CHB);
#pragma unroll
            for (int kk = 0; kk < 4; ++kk) {
                const v4u hw = x[c][kk]; const unsigned hx[4] = {hw.x, hw.y, hw.z, hw.w};
#pragma unroll
                for (int j = 0; j < 4; ++j) { const float lo_ = __uint_as_float(hx[j] << 16), hi_ = __uint_as_float(hx[j] & 0xffff0000u); ss += lo_ * lo_ + hi_ * hi_; }
                const bf16x8 ah = __builtin_bit_cast(bf16x8, hw);
#pragma unroll
                for (int ct = 0; ct < 3; ++ct) { const int sw = ((kk * 4 + q) ^ fr) * 16;
                    const bf16x8 bh = *(const LAS bf16x8*)(wb + (ct * 16 + fr) * 256 + sw), bl = *(const LAS bf16x8*)(wb + (48 + ct * 16 + fr) * 256 + sw);
                    acc[ct] = __builtin_amdgcn_mfma_f32_16x16x32_bf16(ah, bh, acc[ct], 0, 0, 0);
                    acc[ct] = __builtin_amdgcn_mfma_f32_16x16x32_bf16(ah, bl, acc[ct], 0, 0, 0); }
            } }
    }
#undef RT_STAGE
    int rt_row = 0, rt_e0 = 0, rt_e1 = 0; float rt_w0 = 0.f, rt_w1 = 0.f, rt_rs = 0.f; bool rt_on = false; unsigned rt_l0 = 0u, rt_l1 = 0u;
    LAS unsigned* HC = (LAS unsigned*)(F.lds + RING_BYTES + 1024);
    if (act) {
        ss += __shfl_xor(ss, 16); ss += __shfl_xor(ss, 32);
        if (q == 0) RS[fr] = pg8::rs_of(ss);
#pragma unroll
        for (int ct = 0; ct < 3; ++ct)
#pragma unroll
            for (int r = 0; r < 4; ++r) LG[(4 * q + r) * 48 + ct * 16 + fr] = acc[ct][r];
        LDS_WAIT(); asm volatile("" ::: "memory");
        if (lane < 16) {
            const int row = r0 + lane; const float rs = RS[lane]; float lg[4], le[32];
#pragma unroll
            for (int j = 0; j < 4; ++j) lg[j] = LG[lane * 48 + j] * rs + bg[j];
#pragma unroll
            for (int j = 0; j < 32; ++j) le[j] = LG[lane * 48 + 4 + j] * rs + be[j];
            int gi = 0; float gm = lg[0];
#pragma unroll
            for (int j = 1; j < 4; ++j) if (lg[j] > gm) { gm = lg[j]; gi = j; }
            float gs = 0.f;
#pragma unroll
            for (int j = 0; j < 4; ++j) gs += __expf(lg[j] - gm);
            const float gp = 1.0f / gs; float es[8];
#pragma unroll
            for (int j = 0; j < 8; ++j) es[j] = gi == 0 ? le[j] : gi == 1 ? le[8 + j] : gi == 2 ? le[16 + j] : le[24 + j];
            int i0 = 0; float v0 = es[0];
#pragma unroll
            for (int j = 1; j < 8; ++j) if (es[j] > v0) { v0 = es[j]; i0 = j; }
            int i1 = 0; float v1 = -INFINITY;
#pragma unroll
            for (int j = 0; j < 8; ++j) if (j != i0 && es[j] > v1) { v1 = es[j]; i1 = j; }
            const float e1 = __expf(v1 - v0), w0 = gp / (1.0f + e1), w1 = gp * e1 / (1.0f + e1);
            const int ex0 = gi * 8 + i0, ex1 = gi * 8 + i1;
            if (dry) { if (w0 + w1 < -1.f) RSTD[row] = w0; } else {
                rt_on = true; rt_row = row; rt_e0 = ex0; rt_e1 = ex1; rt_w0 = w0; rt_w1 = w1; rt_rs = rs;
                rt_l0 = __hip_atomic_fetch_add(HC + ex0, 1u, __ATOMIC_RELAXED, __HIP_MEMORY_SCOPE_WORKGROUP); rt_l1 = __hip_atomic_fetch_add(HC + ex1, 1u, __ATOMIC_RELAXED, __HIP_MEMORY_SCOPE_WORKGROUP); }
        }
    }
    __syncthreads();
    if (F.wave == 0 && lane < NEXP) { const unsigned c = HC[lane]; HC[32 + lane] = c ? atomicAdd(CNT + lane * CNT_STRIDE, c) : 0u; }
    __syncthreads();
    if (rt_on) { const unsigned s0 = HC[32 + rt_e0] + rt_l0, s1 = HC[32 + rt_e1] + rt_l1; const int row = rt_row, ex0 = rt_e0, ex1 = rt_e1; const float rs = rt_rs;
        LIST[(size_t)ex0 * MA + s0] = row; LIST[(size_t)ex1 * MA + s1] = row; RSL[(size_t)ex0 * MA + s0] = rs; RSL[(size_t)ex1 * MA + s1] = rs;
        v4u ri; ri.x = (unsigned)ex0; ri.y = (unsigned)ex1; ri.z = s0; ri.w = s1; *(v4u*)(RI + (size_t)row * 8) = ri;
        *(f32x2*)(RI + (size_t)row * 8 + 4) = (f32x2){rt_w0, rt_w1}; RSTD[row] = rs; }
    __syncthreads();
    }
}

constexpr int MOE_TB = RING_BYTES + 512;
DEVI void moe_table(Frame& F, int layer) {
    LAS unsigned* TB = (LAS unsigned*)(F.lds + MOE_TB);
    __syncthreads();
    if (F.wave == 0) { const gu32* CNT = F.ctl + (layer ? CW_CNT1 : CW_CNT0);
        const unsigned c = F.lane < NEXP ? __hip_atomic_load(CNT + F.lane * CNT_STRIDE, __ATOMIC_RELAXED, __HIP_MEMORY_SCOPE_AGENT) : 0u; unsigned inc = (c + 255u) >> 8;
#pragma unroll
        for (int o = 1; o < 32; o <<= 1) { const unsigned up = __shfl_up(inc, o); if ((F.lane & 31) >= o) inc += up; }
        if (F.lane < NEXP) { TB[F.lane] = inc - ((c + 255u) >> 8); TB[40 + F.lane] = c; if (F.lane == NEXP - 1) TB[32] = inc; } }
    __syncthreads();
}
template <int NPN, bool GATH> struct MoeOrder {
    static constexpr bool GATHER = GATH;
    LAS unsigned* TB; const int* LIST; int G, c, rep; LAS unsigned char* van; int off = 0, lim = 1 << 30;
    __device__ __forceinline__ bool next(int i, pg8::Unit& u) const {
        int L = i * G + c + off; const int ntile = (int)TB[32];
        if (L >= ntile * NPN * rep || L >= lim) return false; L %= ntile * NPN;
        const int tile = L / NPN, pnl = L % NPN; int e = 0;
#pragma unroll
        for (int st = 16; st >= 1; st >>= 1) if ((int)TB[e + st] <= tile) e += st;
        u.pm = tile; u.pn = e * NPN + pnl; u.e = e; u.mt = tile - (int)TB[e]; return true;
    }
    __device__ __forceinline__ unsigned arow(const pg8::Unit& u, int r) const { const int cnt = (int)TB[40 + u.e]; int idx = u.mt * 256 + r; idx = idx < cnt ? idx : cnt - 1; return (unsigned)LIST[(size_t)u.e * MA + idx]; }
    __device__ __forceinline__ void a_ready(const pg8::Unit&) const {}
    __device__ __forceinline__ void done(const pg8::Unit&) const {}
};
template <bool F8OUT> struct EpiGateUpT {
    static constexpr bool PERM = true;
    bf16_t* HH; const float* RSTD; LAS unsigned* TB; const int* LIST;
    __device__ __forceinline__ void operator()(const pg8::f32x4 (&acc)[2][2][4][2], const pg8::Unit& u, int wr, int wc, int fr, int fq) const {
        const int col0 = (u.pn & 1) * 128 + wc * 32 + 8 * fq; const int cnt = (int)TB[40 + u.e];
        float rsv[2][4];
#pragma unroll
        for (int ai = 0; ai < 2; ++ai)
#pragma unroll
            for (int m = 0; m < 4; ++m) { const int idx = u.mt * 256 + ai * 128 + wr * 64 + m * 16 + fr; rsv[ai][m] = RSTD[(size_t)u.e * MA + (idx < cnt ? idx : cnt - 1)]; }
#pragma unroll
        for (int ai = 0; ai < 2; ++ai)
#pragma unroll
            for (int m = 0; m < 4; ++m) { const int rl = ai * 128 + wr * 64 + m * 16 + fr, idx = u.mt * 256 + rl;
                const float rs = rsv[ai][m]; float hv[8];
#pragma unroll
                for (int n = 0; n < 2; ++n)
#pragma unroll
                    for (int i = 0; i < 4; ++i) { const float gg = acc[ai][0][m][n][i] * rs, uu = acc[ai][1][m][n][i] * rs; hv[n * 4 + i] = gg * __builtin_amdgcn_rcpf(1.0f + __expf(-gg)) * uu; }
                pg8::u32x4 wv; wv.x = pg8::cvt_pk_bf16(hv[0], hv[1]); wv.y = pg8::cvt_pk_bf16(hv[2], hv[3]); wv.z = pg8::cvt_pk_bf16(hv[4], hv[5]); wv.w = pg8::cvt_pk_bf16(hv[6], hv[7]);
                if (F8OUT) { constexpr float hs = (float)(1 << F8_HSHIFT);
                    if (idx < cnt) *(unsigned long long*)((unsigned char*)HH + (size_t)(u.pm * 256 + rl) * 256 + col0) = (unsigned long long)f8pack4(hv[0] * hs, hv[1] * hs, hv[2] * hs, hv[3] * hs) | ((unsigned long long)f8pack4(hv[4] * hs, hv[5] * hs, hv[6] * hs, hv[7] * hs) << 32);
                } else if (idx < cnt) ST16WT(HH + (size_t)(u.pm * 256 + rl) * 256 + col0, wv);
                asm volatile("" ::: "memory"); }
    }
};
typedef EpiGateUpT<false> EpiGateUp;

template <int MODE> DEVI void combine_phase(Frame& F, int nrows, bool dry = false) {
    LAS unsigned* TB = (LAS unsigned*)(F.lds + MOE_TB);
    constexpr bool YF8 = (MODE == 1) || Y0_FP8;
    bf16_t* HR = WSP(bf16_t, WS_H); const bf16_t* Y = WSP(bf16_t, WS_Y); const unsigned* RI = WSP(unsigned, WS_RI); float* SS1 = WSP(float, WS_SS) + MP;
    unsigned* HR8 = WSP(unsigned, WS_HR8);
    const float* gf = F.ka->in[4];
    const int gw = F.vcu * NWAVES + F.wave, NGW = F.G * NWAVES;
    constexpr int NR = 2;
    v4u rin[NR]; f32x2 wvn[NR];
#pragma unroll
    for (int u = 0; u < NR; ++u) { const int m = gw + u * NGW, mm = m < nrows ? m : 0; rin[u] = *(const v4u*)(RI + (size_t)mm * 8); wvn[u] = *(const f32x2*)(RI + (size_t)mm * 8 + 4); }
    for (int m0 = gw; m0 < nrows; m0 += NR * NGW) {
        v2u hv[NR][4], ya[NR][4], yb[NR][4]; f32x2 wv[NR]; bool ok[NR]; v4u ric[NR];
#pragma unroll
        for (int u = 0; u < NR; ++u) { ric[u] = rin[u]; wv[u] = wvn[u]; }
#pragma unroll
        for (int u = 0; u < NR; ++u) { const int m = m0 + NR * NGW + u * NGW, mm = m < nrows ? m : 0; rin[u] = *(const v4u*)(RI + (size_t)mm * 8); wvn[u] = *(const f32x2*)(RI + (size_t)mm * 8 + 4); }
#pragma unroll
        for (int u = 0; u < NR; ++u) { const int m = m0 + u * NGW; ok[u] = m < nrows; const int mm = ok[u] ? m : m0;
            const v4u ri = ric[u];
            const size_t p0 = (size_t)TB[ri.x] * 256 + ri.z, p1 = (size_t)TB[ri.y] * 256 + ri.w;
            const GAS v2u* hr = (const GAS v2u*)(HR + (size_t)mm * D) + F.lane; const GAS v2u* y0 = (const GAS v2u*)(Y + p0 * D) + F.lane; const GAS v2u* y1 = (const GAS v2u*)(Y + p1 * D) + F.lane;
            const GAS unsigned* z0 = (const GAS unsigned*)((const unsigned char*)Y + p0 * D) + F.lane; const GAS unsigned* z1 = (const GAS unsigned*)((const unsigned char*)Y + p1 * D) + F.lane;
#pragma unroll
            for (int j = 0; j < 4; ++j) { hv[u][j] = hr[64 * j];
                if (YF8) { ya[u][j].x = __builtin_nontemporal_load(z0 + 64 * j); yb[u][j].x = __builtin_nontemporal_load(z1 + 64 * j); } else { ya[u][j] = y0[64 * j]; yb[u][j] = y1[64 * j]; } } }
#pragma unroll
        for (int u = 0; u < NR; ++u) { const int m = m0 + u * NGW; if (!ok[u]) continue;
            f32x4 v[4]; v2u hb[4]; float s = 0.f;
#pragma unroll
            for (int j = 0; j < 4; ++j) { const v2u h2 = hv[u][j], a = ya[u][j], b = yb[u][j];
                if (YF8) { const float w0 = wv[u].x * (1.0f / (float)(1 << F8_YSHIFT)), w1 = wv[u].y * (1.0f / (float)(1 << F8_YSHIFT));
                    const f32x2 a01 = __builtin_amdgcn_cvt_pk_f32_fp8((int)a.x, false), a23 = __builtin_amdgcn_cvt_pk_f32_fp8((int)a.x, true), b01 = __builtin_amdgcn_cvt_pk_f32_fp8((int)b.x, false), b23 = __builtin_amdgcn_cvt_pk_f32_fp8((int)b.x, true);
                    v[j].x = bf2f(h2.x & 0xffffu) + w0 * a01.x + w1 * b01.x; v[j].y = bf2f(h2.x >> 16) + w0 * a01.y + w1 * b01.y;
                    v[j].z = bf2f(h2.y & 0xffffu) + w0 * a23.x + w1 * b23.x; v[j].w = bf2f(h2.y >> 16) + w0 * a23.y + w1 * b23.y;
                } else { const float w0 = wv[u].x, w1 = wv[u].y;
                v[j].x = bf2f(h2.x & 0xffffu) + w0 * bf2f(a.x & 0xffffu) + w1 * bf2f(b.x & 0xffffu); v[j].y = bf2f(h2.x >> 16) + w0 * bf2f(a.x >> 16) + w1 * bf2f(b.x >> 16);
                v[j].z = bf2f(h2.y & 0xffffu) + w0 * bf2f(a.y & 0xffffu) + w1 * bf2f(b.y & 0xffffu); v[j].w = bf2f(h2.y >> 16) + w0 * bf2f(a.y >> 16) + w1 * bf2f(b.y >> 16); }
                if (MODE == 0) { hb[j] = (v2u){pk2(v[j].x, v[j].y), pk2(v[j].z, v[j].w)};
                    v[j] = (f32x4){bf2f(hb[j].x & 0xffffu), bf2f(hb[j].x >> 16), bf2f(hb[j].y & 0xffffu), bf2f(hb[j].y >> 16)}; }
                s += (v[j].x * v[j].x + v[j].y * v[j].y) + (v[j].z * v[j].z + v[j].w * v[j].w); }
            s = wave_sum(s);
            if (MODE == 0) { if (dry) { if (s < -1.f) SS1[m] = s; continue; }
                GAS v2u* hr = (GAS v2u*)(HR + (size_t)m * D) + F.lane;
#pragma unroll
                for (int j = 0; j < 4; ++j) { hr[64 * j] = hb[j]; ((GAS unsigned*)HR8)[(size_t)m * (D / 4) + 64 * j + F.lane] = f8pack4(v[j].x, v[j].y, v[j].z, v[j].w); }
                if (F.lane == 0) SS1[m] = s;
            } else { const float rs = pg8::rs_of(s); GAS f32x4* op = (GAS f32x4*)(F.out + (size_t)m * D) + F.lane; const GAS f32x4* gp = (const GAS f32x4*)gf + F.lane;
#pragma unroll
                for (int j = 0; j < 4; ++j) { const f32x4 g4 = gp[64 * j]; __builtin_nontemporal_store((f32x4){v[j].x * rs * g4.x, v[j].y * rs * g4.y, v[j].z * rs * g4.z, v[j].w * rs * g4.w}, op + 64 * j); } }
        }
    }
    if (MODE == 0 && !dry) for (int m = MA + gw; m < MP; m += NGW) {
#pragma unroll
        for (int j = 0; j < 4; ++j) ((GAS unsigned*)HR8)[(size_t)m * (D / 4) + 64 * j + F.lane] = 0u; }
}

constexpr float ATT_C2 = 0.125f * 1.4426950408889634f;
DEVI void qkprep_phase(Frame& F) {
    bf16_t* U2 = WSP(bf16_t, WS_U2); const float* ROPE = WSP(float, WS_ROPE); const float* qn = F.ka->in[14]; const float* kn = F.ka->in[15];
    const int gw = F.vcu * NWAVES + F.wave, NGW = F.G * NWAVES, sub = F.lane >> 3, l8 = F.lane & 7;
    for (int it0 = gw * 8; it0 < MA * 20; it0 += NGW * 8) {
        const int it = it0 + sub, row = it / 20, head = it % 20;
        bf16_t* p = U2 + (size_t)row * NA + head * 64 + l8 * 8;
        const v4u raw = *(const v4u*)p; const unsigned rw[4] = {raw.x, raw.y, raw.z, raw.w}; float x[8]; float ss = 0.f;
#pragma unroll
        for (int i = 0; i < 8; ++i) { x[i] = bf2f((rw[i >> 1] >> ((i & 1) * 16)) & 0xffffu); ss += x[i] * x[i]; }
        ss += __shfl_xor(ss, 1); ss += __shfl_xor(ss, 2); ss += __shfl_xor(ss, 4);
        const float rs = rsqrtf(ss * (1.0f / 64.0f) + EPS) * (head < 16 ? ATT_C2 : 1.0f); const float* nw = (head < 16 ? qn : kn) + l8 * 8;
        unsigned ow[4];
#pragma unroll
        for (int i2 = 0; i2 < 4; ++i2) { const float a0 = x[2 * i2] * rs * nw[2 * i2], a1 = x[2 * i2 + 1] * rs * nw[2 * i2 + 1]; float cs = 1.f, sn = 0.f;
            if (row < MR) { const f32x2 cv = *(const f32x2*)(ROPE + ((size_t)(row & (S - 1)) * 32 + l8 * 4 + i2) * 2); cs = cv.x; sn = cv.y; }
            ow[i2] = pk2(a0 * cs - a1 * sn, a0 * sn + a1 * cs); }
        *(v4u*)p = (v4u){ow[0], ow[1], ow[2], ow[3]};
    }
}
struct InProjOrder {
    static constexpr bool GATHER = false;
    pg8::StaticOrder S14, S12; int G, c, nwg;
    LAS unsigned char* van = nullptr;
    __device__ __forceinline__ void init(int G_, int c_) { S14.init(MP, NG1, G_, c_, 1); S12.init(MP, 12 * 256, 1, 0, 1); G = G_; c = c_; nwg = S14.nwg; }
    __device__ __forceinline__ bool next(int i, pg8::Unit& u) const {
        if (G != 256) return S14.next(i, u);
        constexpr int NU1 = 65 * 14, R4 = NU1 - 768, NL2 = 256 - R4, NL1 = 130 - NL2;
        const int L = i * 256 + c; if (L >= NU1) return false;
        int b = -1;
        if (i == 2 && c >= R4) b = c - R4; else if (i == 1 && c >= R4 && c < R4 + NL1) b = NL2 + c - R4;
        if (b >= 0) { u.pm = b >> 1; u.pn = 12 + (b & 1); u.e = 0; u.mt = 0; return true; }
        const int cnt = (i == 0) ? 0 : (i == 1) ? (c >= R4 + NL1 ? NL1 : 0) : (i == 2) ? NL1 : 130;
        return S12.next(L - cnt, u);
    }
    __device__ __forceinline__ unsigned arow(const pg8::Unit&, int) const { return 0u; }
    __device__ __forceinline__ void a_ready(const pg8::Unit&) const {}
    __device__ __forceinline__ void done(const pg8::Unit&) const {}
};
constexpr int NPHASE = 19;
constexpr int MIX_DPW = 2;
__global__ void __launch_bounds__(NWAVES * 64, 2) mega(Args args) {
    extern __shared__ __attribute__((aligned(16))) unsigned char lds[];
    Frame F;
    F.lds = (LAS unsigned char*)lds;
    F.MISC = (volatile LAS unsigned*)(F.lds + MISC_OFF);
    F.wave = __builtin_amdgcn_readfirstlane((int)threadIdx.x >> 6); F.lane = lane_now(); F.tid = F.wave * 64 + F.lane;
    F.G = gridDim.x; { const int bx = blockIdx.x; F.vcu = (F.G % 8 == 0) ? (bx % 8) * (F.G / 8) + bx / 8 : bx; }
    F.ws = args.ws; F.ctl = (gu32*)(args.ws + WS_CTL); F.out = args.out;
    F.ka = (const __attribute__((address_space(4))) Args*)__builtin_amdgcn_kernarg_segment_ptr();
    for (int u = F.tid; u < (LDS_BYTES - LDSCTL_OFF) / 4; u += NWAVES * 64) ((LAS unsigned*)(F.lds + LDSCTL_OFF))[u] = 0u;
    __syncthreads();
    const int lo = args.ph_lo, hi = args.ph_hi;
    const bool multi = (hi - lo) > 1;
    XcdBarrier bar; bar.bar = (unsigned*)(F.ctl + CW_BAR); bar.x = 0; bar.st = nullptr;
    if (multi) bar = xcd_barrier_post((unsigned*)(F.ctl + CW_BAR), F.MISC + 8);
    bar.wave = F.wave;
#ifndef PHASE_MASK
#define PHASE_MASK 0x7ffff
#endif
#ifndef ABLW
#define ABLW 0
#endif
#define WIN(p) (!(args.abl && ((ABLW >> (p)) & 1)))
#define RELANE() do { F.lane = lane_now(); F.tid = F.wave * 64 + F.lane; } while (0)
#define IN(k) (((PHASE_MASK >> (k)) & 1) && lo <= (k) && (k) < hi)
#ifndef DOUBLE_PHASE
#define DOUBLE_PHASE -1
#endif
#define RF(k) ((k) == DOUBLE_PHASE ? 2 : 1)
#define SEAM(k) do { if (IN(k) && IN((k) + 1)) xcd_barrier(bar); F.lane = lane_now(); F.tid = F.wave * 64 + F.lane; } while (0)
#define REP(k) for (int rep_ = 0; rep_ < RF(k); ++rep_, ((k) == DOUBLE_PHASE && rep_ == 1 ? xcd_barrier(bar) : (void)0))
    LAS unsigned char* ring = F.lds + RING_OFF;
    LAS unsigned* TB = (LAS unsigned*)(F.lds + MOE_TB);
    int tb_layer = -1;
#define MOE_TABLE(L) do { if (tb_layer != (L)) { moe_table(F, (L)); tb_layer = (L); } } while (0)
    bf16_t* HB = WSP(bf16_t, WS_HB); bf16_t* HR = WSP(bf16_t, WS_H); float* SS = WSP(float, WS_SS);

    if (IN(0)) REP(0) { p0_prologue(F); } SEAM(0);
    if (IN(1)) {
        pg8::Gemm g{HB, WSP(bf16_t, WS_WIN), MP, NG1, D}; InProjOrder So; So.init(F.G, (int)blockIdx.x);
        pg8::EpiInProj0 E{WSP(bf16_t, WS_BIG), SS, F.ka->in[8], F.ka->in[10], (args.abl && ((ABLW >> 24) & 1)) ? 1 : 0};
        pg8::gemm_phase<pg8::EpiInProj0, InProjOrder, true>(ring, g, So, E, F.wave); RELANE();
        { const int rem = So.nwg % 256; if (WIN(1) && F.G == 256 && rem && (int)blockIdx.x >= rem) { const int j = (int)blockIdx.x - rem; convert_moe(F, 0, j * CONV_PER_WG, (j + 1) * CONV_PER_WG, F.wave, NWAVES); } } } SEAM(1);
#ifdef PROBE_BAR
    for (int i_ = 0; i_ < 10; ++i_) xcd_barrier(bar);
#endif
    if (IN(2)) REP(2) { p2_gla_kv(F);
        if (WIN(2) && F.G == 256 && F.vcu >= GLA_SHORT0) { const int j = F.vcu - GLA_SHORT0; convert_moe(F, 0, CONV_P1_END + j * NWAVES, CONV_P1_END + (j + 1) * NWAVES, F.wave, NWAVES);
            router_weights(F, j * 512 + F.tid, (256 - GLA_SHORT0) * 512); } } SEAM(2);
    if (IN(3)) REP(3) { p3_gla_scan(F); } SEAM(3);
    if (IN(4)) REP(4) { p4_gla_out(F);
        if (WIN(4) && F.G == 256 && F.vcu >= GLA_SHORT0) { const int j = F.vcu - GLA_SHORT0, lo_ = CONV_P1_END + (256 - GLA_SHORT0) * NWAVES + j * NWAVES;
            convert_moe(F, 0, lo_ < CONV_ITEMS ? lo_ : CONV_ITEMS, lo_ + NWAVES < CONV_ITEMS ? lo_ + NWAVES : CONV_ITEMS, F.wave, NWAVES);
            if (j < 32) convert_small_item(F, 0, j * NWAVES + F.wave); } } SEAM(4);
    if (IN(5)) {
        pg8::Gemm g{HB, WSP(bf16_t, WS_WO0), MR, D, D}; pg8::StaticOrder So; So.init(MR, D, F.G, (int)blockIdx.x, RF(5));
        pg8::EpiResBf16<false> E{F.ka->in[0], F.ka->in[1], 15, HR, nullptr, MOE0_FP8 ? WSP(unsigned char, WS_HR8A) : nullptr};
        p5_meta_rows(F);
        pg8::gemm_phase<pg8::EpiResBf16<false>, pg8::StaticOrder, true>(ring, g, So, E, F.wave); RELANE();
        } SEAM(5);
#define MOE_PHASES(layer, pb) do { \
        if (IN(pb)) REP(pb) { route_phase(F, layer, layer ? MR : MA, rep_ > 0); } SEAM(pb); \
        if (IN((pb) + 1)) { MOE_TABLE(layer); \
            pg8::Gemm g{MOE0_FP8 ? WSP(bf16_t, WS_HR8A) : HR, WSP(bf16_t, layer ? WS_MOEGU1 : WS_MOEGU), MP, NEXP * 512, D, 127 - F8_WSHIFT / 2}; MoeOrder<2, true> So{TB, WSP(int, WS_LIST), F.G, F.vcu, RF((pb) + 1), F.lds + RING_BYTES + 2048}; \
            EpiGateUpT<MOE0_FP8> E{WSP(bf16_t, WS_HH), WSP(float, WS_RSL), TB, WSP(int, WS_LIST)}; \
            pg8::gemm_phase<EpiGateUpT<MOE0_FP8>, MoeOrder<2, true>, true, MOE0_FP8>(ring, g, So, E, F.wave); RELANE(); \
            if (WIN(7) && layer == 0 && F.G == 256) { const int nu_ = (int)TB[32] * 2, rem = nu_ - 256;        \
                if (rem > 0 && rem < 256 && F.vcu >= rem) { const int j = F.vcu - rem; convert_moe(F, 1, j * CONV_PER_WG, (j + 1) * CONV_PER_WG < CONV_ITEMS ? (j + 1) * CONV_PER_WG : CONV_ITEMS, F.wave, NWAVES); } } } SEAM((pb) + 1); \
        if (IN((pb) + 2)) { MOE_TABLE(layer); \
            pg8::Gemm g{WSP(bf16_t, WS_HH), WSP(bf16_t, layer ? WS_MOED1 : WS_MOED), YROWS, NEXP * 1024, 256, 127 - (F8_HSHIFT + F8_WSHIFT) / 2}; MoeOrder<4, false> So{TB, WSP(int, WS_LIST), F.G, F.vcu, RF((pb) + 2), F.lds + RING_BYTES + 2048}; \
            pg8::EpiScaleBf16 E{WSP(bf16_t, WS_Y), D, nullptr, 4, nullptr, nullptr, 0, TB + 40, Y0_FP8 ? F8_YSHIFT : -1}; \
            pg8::gemm_phase<pg8::EpiScaleBf16, MoeOrder<4, false>, true, MOE0_FP8>(ring, g, So, E, F.wave); RELANE(); \
            if (WIN(8) && layer == 0 && F.G == 256) { const int nu_ = (int)TB[32] * 4, rem = nu_ % 256, nsh = rem ? 256 - rem : 256;        \
                const int j = rem ? F.vcu - rem : F.vcu; if (j >= 0) for (int it = j * NWAVES + F.wave; it < 640; it += nsh * NWAVES) convert_small_item(F, it < 384 ? 1 : 2, it < 384 ? it : it - 384); } } SEAM((pb) + 2); } while (0)
    MOE_PHASES(0, 6);
    if (IN(9)) REP(9) { MOE_TABLE(0); combine_phase<0>(F, MA, rep_ > 0);
        if (F.G != 256) { convert_moe(F, 1, 0, CONV_ITEMS, F.vcu * NWAVES + F.wave, F.G * NWAVES); } } SEAM(9);
    if (IN(10)) {
        { LAS float* rt = (LAS float*)(F.lds + RING_BYTES + 2048);
          for (int e = F.tid; e < 1024; e += NWAVES * 64) { const float ang = (float)(e >> 4) * powf(10000.0f, -(float)(2 * (e & 15)) / 32.0f); rt[2 * e] = cosf(ang); rt[2 * e + 1] = sinf(ang); }
          __syncthreads(); }
        pg8::Gemm g{WSP(bf16_t, WS_HR8), WSP(bf16_t, WS_WAI), MP, NA, D, 127 - F8_WSHIFT / 2}; pg8::StaticOrder So; So.init(MP, NA, F.G, (int)blockIdx.x, RF(10));
        pg8::EpiQKV E{WSP(bf16_t, WS_U2), SS + MP, F.ka->in[14], F.ka->in[15], (const LAS float*)(F.lds + RING_BYTES + 2048), ATT_C2};
        pg8::gemm_phase<pg8::EpiQKV, pg8::StaticOrder, true, true>(ring, g, So, E, F.wave); RELANE();
        if (WIN(10) && F.G == 256) { MOE_TABLE(0);
            const int nu_ = (int)TB[32] * 2, remgu = nu_ - 256; const int taken = (remgu > 0 && remgu < 256) ? (256 - remgu) * CONV_PER_WG : 0;
            const int rem = So.nwg % 256, nidle = 256 - rem, j = (int)blockIdx.x - rem;
            if (rem == 0) convert_moe(F, 1, taken < CONV_ITEMS ? taken : CONV_ITEMS, CONV_ITEMS, F.vcu * NWAVES + F.wave, F.G * NWAVES);
            else if (j >= 0) convert_moe(F, 1, taken < CONV_ITEMS ? taken : CONV_ITEMS, CONV_ITEMS, j * NWAVES + F.wave, nidle * NWAVES); } } SEAM(10);
    if (IN(12)) {
        const attn_body::AttnTensors AT{(const attn_body::bf16*)WSP(bf16_t, WS_U2), (const attn_body::bf16*)WSP(bf16_t, WS_U2), (const attn_body::bf16*)WSP(bf16_t, WS_U2), (attn_body::bf16*)WSP(bf16_t, WS_AO)};
        const attn_body::StaticOrder Sa(F.vcu, RF(12), F.G);
        attn_body::attn_phase<attn_body::StaticOrder>((char*)lds + RING_OFF, AT, Sa, F.wave);
        } SEAM(12);
    if (IN(13)) {
        pg8::Gemm g{WSP(bf16_t, WS_AO), WSP(bf16_t, WS_WAO), MR, D, D, 127 - (F8_OSHIFT + F8_WSHIFT) / 2}; pg8::StaticOrder So; So.init(MR, D, F.G, (int)blockIdx.x, 1);
        pg8::EpiResBf16<true> E{nullptr, nullptr, 0, HR, HR, WSP(unsigned char, WS_HR8)};
        pg8::gemm_phase<pg8::EpiResBf16<true>, pg8::StaticOrder, true, true>(ring, g, So, E, F.wave); RELANE(); } SEAM(13);
#undef MOE_PHASES
    if (IN(14)) REP(14) { route_phase(F, 1, MR, rep_ > 0); } SEAM(14);
    if (IN(15)) { MOE_TABLE(1);
        pg8::Gemm g{WSP(bf16_t, WS_HR8), WSP(bf16_t, WS_MOEGU1), MP, NEXP * 512, D, 127 - F8_WSHIFT / 2}; MoeOrder<2, true> So{TB, WSP(int, WS_LIST), F.G, F.vcu, 1, F.lds + RING_BYTES + 2048, 0, 256};
        EpiGateUpT<true> E{WSP(bf16_t, WS_HH), WSP(float, WS_RSL), TB, WSP(int, WS_LIST)};
        pg8::gemm_phase<EpiGateUpT<true>, MoeOrder<2, true>, true, true>(ring, g, So, E, F.wave); RELANE(); } SEAM(15);
    if (IN(16)) { MOE_TABLE(1);
        const int nGU = (int)TB[32] * 2, nD = (int)TB[32] * 4, remGU = nGU > 256 ? nGU - 256 : 0;
        if (F.vcu < remGU) {
            pg8::Gemm g{WSP(bf16_t, WS_HR8), WSP(bf16_t, WS_MOEGU1), MP, NEXP * 512, D, 127 - F8_WSHIFT / 2}; MoeOrder<2, true> So{TB, WSP(int, WS_LIST), F.G, F.vcu, 1, F.lds + RING_BYTES + 2048, 256, 1 << 30};
            EpiGateUpT<true> E{WSP(bf16_t, WS_HH), WSP(float, WS_RSL), TB, WSP(int, WS_LIST)};
            pg8::gemm_phase<EpiGateUpT<true>, MoeOrder<2, true>, true, true>(ring, g, So, E, F.wave); RELANE();
        } else { const int j = F.vcu - remGU; const int cap = nD < 512 ? nD : 512;
            pg8::Gemm g{WSP(bf16_t, WS_HH), WSP(bf16_t, WS_MOED1), YROWS, NEXP * 1024, 256, 127 - (F8_HSHIFT + F8_WSHIFT) / 2}; MoeOrder<4, false> So{TB, WSP(int, WS_LIST), 1, MIX_DPW * j, 1, F.lds + RING_BYTES + 2048, 0, (MIX_DPW * j + MIX_DPW) < cap ? (MIX_DPW * j + MIX_DPW) : cap};
            pg8::EpiScaleBf16 E{WSP(bf16_t, WS_Y), D, nullptr, 4, nullptr, nullptr, 0, TB + 40, F8_YSHIFT};
            pg8::gemm_phase<pg8::EpiScaleBf16, MoeOrder<4, false>, true, true>(ring, g, So, E, F.wave); RELANE(); } } SEAM(16);
    if (IN(17)) { MOE_TABLE(1);
        const int nGU = (int)TB[32] * 2, nD = (int)TB[32] * 4, remGU = nGU > 256 ? nGU - 256 : 0; int nDB = MIX_DPW * (256 - remGU); { const int cap = nD < 512 ? nD : 512; if (nDB > cap) nDB = cap; }
        if (F.G != 256) nDB = 0;
        pg8::Gemm g{WSP(bf16_t, WS_HH), WSP(bf16_t, WS_MOED1), YROWS, NEXP * 1024, 256, 127 - (F8_HSHIFT + F8_WSHIFT) / 2}; MoeOrder<4, false> So{TB, WSP(int, WS_LIST), F.G, F.vcu, 1, F.lds + RING_BYTES + 2048, nDB, 1 << 30};
        pg8::EpiScaleBf16 E{WSP(bf16_t, WS_Y), D, nullptr, 4, nullptr, nullptr, 0, TB + 40, F8_YSHIFT};
        pg8::gemm_phase<pg8::EpiScaleBf16, MoeOrder<4, false>, true, true>(ring, g, So, E, F.wave); RELANE(); } SEAM(17);
    if (IN(18)) REP(18) { MOE_TABLE(1); combine_phase<1>(F, MR); }
#undef IN
#undef SEAM
}
#if SELFCHECK
struct CK { const float* in[24]; unsigned char* ws; float* out; };
#define CWS(T, off) ((T*)(c.ws + (off)))
__device__ __forceinline__ unsigned hsh(unsigned x) { x ^= x >> 16; x *= 0x7feb352du; x ^= x >> 15; x *= 0x846ca68bu; x ^= x >> 16; return x; }
__device__ __forceinline__ void ck_fail(const CK& c, unsigned code) { atomicCAS((unsigned*)(c.ws + WS_CTL) + CW_FLAG, 0u, code); }
__device__ __forceinline__ bool ck_bad(float a, float ref, float rtol, float atol) { return !(fabsf(a - ref) <= rtol * fabsf(ref) + atol); }
__device__ __forceinline__ float bfr(float x) { return bf2f(f2bf(x)); }
__device__ __forceinline__ float dot_bf(const bf16_t* a, const bf16_t* b, int K) { float s = 0.f; for (int k = 0; k < K; ++k) s += bf2f(a[k]) * bf2f(b[k]); return s; }

__device__ __forceinline__ float f8d(unsigned char b) { const int sg = b >> 7, e = (b >> 3) & 15, m = b & 7; const float v = e ? ldexpf(1.0f + m * 0.125f, e - 7) : ldexpf(m * 0.125f, -6); return sg ? -v : v; }
__device__ __forceinline__ float dot8(const unsigned char* a, const unsigned char* b, int K) { float s = 0.f; for (int k = 0; k < K; ++k) s += f8d(a[k]) * f8d(b[k]); return s; }
__device__ __forceinline__ int wai_row(int col) { const int tl = col >> 8, hd = (col >> 6) & 3, dm = col & 63; return tl < 5 ? tl * 256 + (dm >> 5) * 128 + hd * 32 + (dm & 31) : col; }
__device__ __forceinline__ int win_row(int col) { if (col >= 512 && col < 1024) { const int x = col - 512; return (2 + (x >> 7)) * 256 + (x & 127); } if (col >= 1024 && col < 1536) { const int x = col - 1024; return (2 + (x >> 7)) * 256 + 128 + (x & 127); } return col; }
__global__ void ck_prologue(CK c, int layer, unsigned code, int with_small) {
    const unsigned id = blockIdx.x * 256 + threadIdx.x, r = hsh(id * 3 + 1), r2 = hsh(id * 3 + 2);
    const bf16_t* GU = CWS(bf16_t, layer ? WS_MOEGU1 : WS_MOEGU); const bf16_t* DW = CWS(bf16_t, layer ? WS_MOED1 : WS_MOED); const float* gain = c.in[3] + layer * D;
    if (!with_small) {
    { const int e = r & 31, row = (r >> 5) & 511, k = (r >> 14) & 1023, pnl = row >> 8, cc = row & 255;
      const float* W = (cc < 128 ? c.in[21] : c.in[22]) + ((size_t)layer * NEXP + e) * D * 256; const float ref = bfr(W[(size_t)k * 256 + pnl * 128 + (cc & 127)] * gain[k]);
      if ((layer || MOE0_FP8) ? ck_bad(f8d(((const unsigned char*)GU)[((size_t)e * 512 + row) * D + k]), 64.0f * W[(size_t)k * 256 + pnl * 128 + (cc & 127)] * gain[k], 0.07f, 0.002f) : ck_bad(bf2f(GU[((size_t)e * 512 + row) * D + k]), ref, 1e-6f, 1e-12f)) ck_fail(c, code); }
    { const int e = r2 & 31, n = (r2 >> 5) & 1023, k = (r2 >> 15) & 255; const float ref = bfr(c.in[23][(((size_t)layer * NEXP + e) * 256 + k) * D + n]);
      if ((layer || MOE0_FP8) ? ck_bad(f8d(((const unsigned char*)DW)[((size_t)e * 1024 + n) * 256 + k]), 64.0f * c.in[23][(((size_t)layer * NEXP + e) * 256 + k) * D + n], 0.07f, 0.002f) : ck_bad(bf2f(DW[((size_t)e * 1024 + n) * 256 + k]), ref, 1e-6f, 1e-12f)) ck_fail(c, code); }
    return; }
    { const int n = r % 3072, k = (r2 >> 3) & 1023; const float ref = bfr(c.in[5][(size_t)k * 3104 + n] * c.in[2][k]);
      if (ck_bad(bf2f(CWS(bf16_t, WS_WIN)[(size_t)win_row(n) * D + k]), ref, 1e-6f, 1e-12f)) ck_fail(c, code); }
    if (with_small == 1) { const int n = r2 & 1023, k = (r >> 7) & 1023;
      if (ck_bad(bf2f(CWS(bf16_t, WS_WO0)[(size_t)n * D + k]), bfr(c.in[12][(size_t)k * D + n]), 1e-6f, 1e-12f)) ck_fail(c, code);
      if (ck_bad(f8d(CWS(unsigned char, WS_WAO)[(size_t)n * D + k]), 64.0f * c.in[16][(size_t)k * D + n], 0.07f, 0.002f)) ck_fail(c, code + 40);
      const int n2 = r % NA; if (ck_bad(f8d(CWS(unsigned char, WS_WAI)[(size_t)wai_row(n2) * D + k]), 64.0f * c.in[13][(size_t)k * NA + n2] * c.in[2][D + k], 0.07f, 0.002f)) ck_fail(c, code + 60); }
    if (with_small == 1) { const int l = r & 1, j = (r >> 1) % 48, k = (r2 >> 9) & 1023; float w = (j < 4) ? c.in[17][((size_t)l * D + k) * 4 + j] : (j < 36) ? c.in[19][((size_t)l * D + k) * 32 + j - 4] : 0.f; w *= c.in[3][l * D + k];
      const bf16_t* WR = CWS(bf16_t, WS_WR); const float got = bf2f(WR[((size_t)(l * 2) * 48 + j) * D + k]) + bf2f(WR[((size_t)(l * 2 + 1) * 48 + j) * D + k]);
      if (ck_bad(got, w, 1e-4f, 1e-9f)) ck_fail(c, code); }
    if (with_small == 2) { const int row = r % MP, k = r2 & 1023; float ref = 0.f, ss = 0.f;
      if (row < MA) { const float* src = row < MR ? c.in[0] + (size_t)row * D : c.in[1] + (size_t)((row - MR) & 15) * D; ref = bfr(src[k]); for (int i = 0; i < D; ++i) ss += src[i] * src[i]; }
      if (ck_bad(bf2f(CWS(bf16_t, WS_HB)[(size_t)row * D + k]), ref, 1e-6f, 1e-12f)) ck_fail(c, code + 20);
      if (ck_bad(CWS(float, WS_SS)[row], ss, 1e-4f, 1e-6f)) ck_fail(c, code + 20); }
}
__global__ void ck_gemm_bf16(CK c, size_t offA, size_t offB, size_t offO, int ldo, size_t offSS, int M, int N, int K, unsigned code) {
    const unsigned id = blockIdx.x * 64 + threadIdx.x, r = hsh(id * 2 + 11), r2 = hsh(id * 2 + 12);
    int row = r % M, col = r2 % N; if ((id & 7) == 0) row = M - 1 - (r % 300 % M); if ((id & 7) == 1) col = N - 1 - (r2 % 40);
    const float sc = offSS ? pg8::rs_of(CWS(float, offSS)[row]) : 1.0f;
    const float ref = sc * dot_bf(CWS(bf16_t, offA) + (size_t)row * K, CWS(bf16_t, offB) + (size_t)col * K, K);
    if (ck_bad(bf2f(CWS(bf16_t, offO)[(size_t)row * ldo + col]), ref, 0.015f, 0.02f)) ck_fail(c, code);
}
__global__ void ck_u(CK c, unsigned code) {
    const unsigned id = blockIdx.x * 64 + threadIdx.x, r = hsh(id * 2 + 11), r2 = hsh(id * 2 + 12);
    int row = r % MA; const int ucol = r2 % U_LA; if ((id & 7) == 0) row = MA - 1 - (r % 300);
    const float sc = pg8::rs_of(CWS(float, WS_SS)[row]); const bf16_t* hb = CWS(bf16_t, WS_HB) + (size_t)row * D; const bf16_t* WT = CWS(bf16_t, WS_WIN); float ref;
    if (ucol >= U_Z && ucol < U_Z + 512) { const int ch = ucol - U_Z; ref = (sc * dot_bf(hb, WT + (size_t)win_row(512 + ch) * D, D)) * (sc * dot_bf(hb, WT + (size_t)win_row(1024 + ch) * D, D)); }
    else { const int oc = ucol < 512 ? ucol : ucol + 512; ref = sc * dot_bf(hb, WT + (size_t)win_row(oc) * D, D); }
    if (ck_bad(bf2f(CWS(bf16_t, WS_BIG)[uoff(row, ucol)]), ref, 0.02f, 0.02f)) ck_fail(c, code);
}
__device__ __forceinline__ float ck_loga(const CK& c, const bf16_t* U, int row, int dir, int ch) { return bf2f(U[uoff(row, U_LA + dir * 256 + ch)]); }
__global__ void ck_la(CK c, unsigned code) {
    const unsigned id = blockIdx.x * 64 + threadIdx.x, r = hsh(id + 90210); const int row = r % MA, dir = (r >> 15) & 1, ch = (r >> 16) & 255;
    const float* src = row < MR ? c.in[0] + (size_t)row * D : c.in[1] + (size_t)((row - MR) & 15) * D; float ss = 0.f; for (int k = 0; k < D; ++k) ss += src[k] * src[k];
    const float rs = pg8::rs_of(ss); float z = (dir ? c.in[10] : c.in[8])[ch];
    for (int j = 0; j < 16; ++j) { float g = 0.f; for (int k = 0; k < D; ++k) g += src[k] * rs * c.in[2][k] * c.in[5][(size_t)k * 3104 + 3072 + 16 * dir + j]; z += g * (dir ? c.in[9] : c.in[7])[j * 256 + ch]; }
    if (ck_bad(bf2f(CWS(bf16_t, WS_BIG)[uoff(row, U_LA + dir * 256 + ch)]), log_sigmoid(z) * 0.0625f, 0.03f, 0.003f)) ck_fail(c, code);
}
__global__ void ck_scan(CK c, unsigned code) {
    const unsigned id = blockIdx.x * 64 + threadIdx.x, r = hsh(id + 77);
    const int b = r & 7, h = (r >> 3) & 3, dir = (r >> 5) & 1, n = (r >> 6) % NCH, v = (r >> 12) & 127, d = (r >> 19) & 63;
    const bf16_t* U = CWS(bf16_t, WS_BIG); float Sx = 0.f;
    const int start = n == 0 ? 0 : NM + (n - 1) * 64, end = n == 0 ? NM : NM + n * 64;
    if (dir == 0) { for (int tp = 0; tp < start; ++tp) { const int row = tok_row(b, tp); const float a = expf(ck_loga(c, U, row, 0, h * 64 + d));
            Sx = a * Sx + bf2f(U[uoff(row, U_K + h * 64 + d)]) * bf2f(U[uoff(row, U_V + h * 128 + v)]); } }
    else { for (int tp = T - 1; tp >= end; --tp) { const int row = tok_row(b, tp); const float a = expf(ck_loga(c, U, row, 1, h * 64 + d));
            Sx = a * Sx + bf2f(U[uoff(row, U_K + h * 64 + d)]) * bf2f(U[uoff(row, U_V + h * 128 + v)]); } }
    const float got = bf2f(CWS(bf16_t, WS_H)[((size_t)((b * 4 + h) * 2 + dir) * NCH + n) * 8192 + v * 64 + d]);
    if (ck_bad(got, Sx, 0.04f, 0.15f)) ck_fail(c, code);
}
__global__ void __launch_bounds__(128) ck_glaout(CK c, unsigned code) {
    __shared__ float red[2];
    const unsigned r = hsh(blockIdx.x + 1234); const int b = r & 7, h = (r >> 3) & 3; int tp = (r >> 5) % T; if (blockIdx.x < 8) tp = blockIdx.x * 3; if (blockIdx.x >= 8 && blockIdx.x < 12) tp = T - 1 - (blockIdx.x - 8) * 21;
    const int v = threadIdx.x; const bf16_t* U = CWS(bf16_t, WS_BIG);
    float Sx[64];
#pragma unroll
    for (int d = 0; d < 64; ++d) Sx[d] = 0.f;
    float of = 0.f, ob = 0.f;
    for (int t2 = 0; t2 <= tp; ++t2) { const size_t row = tok_row(b, t2); const float vv = bf2f(U[uoff((int)row, U_V + h * 128 + v)]); float o = 0.f;
#pragma unroll
        for (int d = 0; d < 64; ++d) { const float a = expf(ck_loga(c, U, (int)row, 0, h * 64 + d)); Sx[d] = a * Sx[d] + bf2f(U[uoff((int)row, U_K + h * 64 + d)]) * vv; o += bf2f(U[uoff((int)row, U_Q + h * 64 + d)]) * Sx[d]; }
        of = o; }
#pragma unroll
    for (int d = 0; d < 64; ++d) Sx[d] = 0.f;
    for (int t2 = T - 1; t2 >= tp; --t2) { const size_t row = tok_row(b, t2); const float vv = bf2f(U[uoff((int)row, U_V + h * 128 + v)]); float o = 0.f;
#pragma unroll
        for (int d = 0; d < 64; ++d) { const float a = expf(ck_loga(c, U, (int)row, 1, h * 64 + d)); const float as = a * Sx[d]; o += bf2f(U[uoff((int)row, U_Q + h * 64 + d)]) * as; Sx[d] = as + bf2f(U[uoff((int)row, U_K + h * 64 + d)]) * vv; }
        ob = o; }
    const float o = (of + ob) * 0.125f; float ss = wave_sum(o * o);
    if ((v & 63) == 0) red[v >> 6] = ss;
    __syncthreads();
    const size_t row = tok_row(b, tp); const float rs = rsqrtf((red[0] + red[1]) * (1.0f / 128.0f) + EPS); const float rr = bf2f(U[uoff((int)row, U_R + h * 128 + v)]);
    const float ref = o * rs * c.in[11][v] * (rr / (1.0f + expf(-rr)));
    if (ck_bad(bf2f(CWS(bf16_t, WS_HB)[row * D + 512 + h * 128 + v]), ref, 0.04f, 0.04f)) ck_fail(c, code);
    { const int ch = h * 128 + v; float z[3];
      for (int dd = -1; dd <= 1; ++dd) { const int t3 = tp + dd; z[dd + 1] = (t3 >= 0 && t3 < T) ? bf2f(U[uoff(tok_row(b, t3), U_Z + ch)]) : 0.f; }
      const float refc = bf2f(U[uoff((int)row, U_AB + ch)]) * (c.in[6][ch] * z[0] + c.in[6][512 + ch] * z[1] + c.in[6][1024 + ch] * z[2]);
      if (ck_bad(bf2f(CWS(bf16_t, WS_HB)[row * D + ch]), refc, 0.02f, 0.02f)) ck_fail(c, code + 20); }
}
__global__ void ck_outproj0(CK c, unsigned code) {
    const unsigned id = blockIdx.x * 64 + threadIdx.x, r = hsh(id * 2 + 5), r2 = hsh(id * 2 + 6); int row = r % MA; const int col = r2 & 1023; if ((id & 3) == 0) row = MA - 1 - (r % 200);
    const float emb = row < MR ? c.in[0][(size_t)row * D + col] : c.in[1][(size_t)((row - MR) & 15) * D + col];
    const float ref = emb + dot_bf(CWS(bf16_t, WS_HB) + (size_t)row * D, CWS(bf16_t, WS_WO0) + (size_t)col * D, D);
    if (ck_bad(bf2f(CWS(bf16_t, WS_H)[(size_t)row * D + col]), ref, 0.015f, 0.02f)) ck_fail(c, code);
}
__global__ void ck_route(CK c, int layer, int nrows, unsigned code) {
    const unsigned id = blockIdx.x * 64 + threadIdx.x, r = hsh(id + 999 + layer); const int row = r % nrows;
    const bf16_t* hr = CWS(bf16_t, WS_H) + (size_t)row * D; const float* gain = c.in[3] + layer * D;
    float lg[4], le[32]; float ss = 0.f;
#pragma unroll
    for (int j = 0; j < 4; ++j) lg[j] = 0.f;
#pragma unroll
    for (int j = 0; j < 32; ++j) le[j] = 0.f;
    for (int k = 0; k < D; ++k) { const float x = bf2f(hr[k]); ss += x * x; const float xg = x * gain[k];
#pragma unroll
        for (int j = 0; j < 4; ++j) lg[j] += xg * c.in[17][((size_t)layer * D + k) * 4 + j];
#pragma unroll
        for (int j = 0; j < 32; ++j) le[j] += xg * c.in[19][((size_t)layer * D + k) * 32 + j]; }
    const float rs = pg8::rs_of(ss);
#pragma unroll
    for (int j = 0; j < 4; ++j) lg[j] = lg[j] * rs + c.in[18][layer * 4 + j];
#pragma unroll
    for (int j = 0; j < 32; ++j) le[j] = le[j] * rs + c.in[20][layer * 32 + j];
    int gi = 0; float gm = lg[0], g2 = -INFINITY;
#pragma unroll
    for (int j = 1; j < 4; ++j) if (lg[j] > gm) { gm = lg[j]; gi = j; }
#pragma unroll
    for (int j = 0; j < 4; ++j) if (j != gi && lg[j] > g2) g2 = lg[j];
    float gs = 0.f;
#pragma unroll
    for (int j = 0; j < 4; ++j) gs += expf(lg[j] - gm);
    const float gp = 1.0f / gs; float es[8];
#pragma unroll
    for (int j = 0; j < 8; ++j) es[j] = gi == 0 ? le[j] : gi == 1 ? le[8 + j] : gi == 2 ? le[16 + j] : le[24 + j];
    int i0 = 0; float v0 = es[0];
#pragma unroll
    for (int j = 1; j < 8; ++j) if (es[j] > v0) { v0 = es[j]; i0 = j; }
    int i1 = 0; float v1 = -INFINITY, v2 = -INFINITY;
#pragma unroll
    for (int j = 0; j < 8; ++j) if (j != i0 && es[j] > v1) { v1 = es[j]; i1 = j; }
#pragma unroll
    for (int j = 0; j < 8; ++j) if (j != i0 && j != i1 && es[j] > v2) v2 = es[j];
    const float e1 = expf(v1 - v0), w0 = gp / (1.0f + e1), w1 = gp * e1 / (1.0f + e1);
    const unsigned* RI = CWS(unsigned, WS_RI) + (size_t)row * 8; const float gw0 = __uint_as_float(RI[4]), gw1 = __uint_as_float(RI[5]);
    const bool tie = (gm - g2 < 1e-3f) || (v1 - v2 < 1e-3f) || (v0 - v1 < 1e-3f);
    if (!tie) { if ((int)RI[0] != gi * 8 + i0 || (int)RI[1] != gi * 8 + i1) ck_fail(c, code); if (ck_bad(gw0, w0, 2e-3f, 1e-4f) || ck_bad(gw1, w1, 2e-3f, 1e-4f)) ck_fail(c, code); }
    const int* LIST = CWS(int, WS_LIST); const unsigned* CNT = (const unsigned*)(c.ws + WS_CTL) + (layer ? CW_CNT1 : CW_CNT0);
    if (RI[0] >= 32u || RI[1] >= 32u || RI[2] >= CNT[RI[0] * CNT_STRIDE] || RI[3] >= CNT[RI[1] * CNT_STRIDE]) { ck_fail(c, code + 20); return; }
    if (LIST[(size_t)RI[0] * MA + RI[2]] != row || LIST[(size_t)RI[1] * MA + RI[3]] != row) ck_fail(c, code + 20);
    if (ck_bad(CWS(float, WS_SS)[2 * MP + row], rs, 1e-4f, 0.f)) ck_fail(c, code + 20);
    if (id == 0) { unsigned tot = 0; for (int e = 0; e < 32; ++e) tot += CNT[e * CNT_STRIDE]; if (tot != 2u * (unsigned)nrows) ck_fail(c, code + 40); }
}
__global__ void ck_moe(CK c, int layer, unsigned code) {
    const unsigned id = blockIdx.x * 64 + threadIdx.x, r = hsh(id * 2 + 31), r2 = hsh(id * 2 + 32);
    const unsigned* CNT = (const unsigned*)(c.ws + WS_CTL) + (layer ? CW_CNT1 : CW_CNT0);
    const int e = r & 31; unsigned tb = 0; for (int j = 0; j < e; ++j) tb += (CNT[j * CNT_STRIDE] + 255u) >> 8;
    const unsigned cnt = CNT[e * CNT_STRIDE]; if (cnt == 0) return; unsigned idx = (r >> 5) % cnt; if ((id & 3) == 0) idx = cnt - 1 - ((r >> 5) % (cnt < 64 ? cnt : 64));
    const int tok = CWS(int, WS_LIST)[(size_t)e * MA + idx]; const float rs = CWS(float, WS_SS)[2 * MP + tok]; const size_t prow = (size_t)tb * 256 + idx;
    const bf16_t* hb = CWS(bf16_t, WS_H) + (size_t)tok * D; const bf16_t* GU = CWS(bf16_t, layer ? WS_MOEGU1 : WS_MOEGU); const bf16_t* HH = CWS(bf16_t, WS_HH);
    if (layer || MOE0_FP8) {
        const unsigned char* h8 = CWS(unsigned char, layer ? WS_HR8 : WS_HR8A) + (size_t)tok * D; const unsigned char* GU8 = CWS(unsigned char, layer ? WS_MOEGU1 : WS_MOEGU); const unsigned char* HH8 = CWS(unsigned char, WS_HH);
        { const int j = r2 & 255; const unsigned char* wg = GU8 + ((size_t)e * 512 + (j >> 7) * 256 + (j & 127)) * D; const float g = rs * dot8(h8, wg, D) * (1.0f / 64.0f), u = rs * dot8(h8, wg + (size_t)128 * D, D) * (1.0f / 64.0f);
          const float ref = g / (1.0f + expf(-g)) * u; if (ck_bad(f8d(HH8[prow * 256 + j]) * (1.0f / (float)(1 << F8_HSHIFT)), ref, 0.09f, 0.02f)) ck_fail(c, code); }
        { const int n = (r2 >> 8) & 1023; const float ref = dot8(HH8 + prow * 256, CWS(unsigned char, layer ? WS_MOED1 : WS_MOED) + ((size_t)e * 1024 + n) * 256, 256) * (1.0f / (float)(1 << (F8_HSHIFT + F8_WSHIFT)));
          if (ck_bad(f8d(CWS(unsigned char, WS_Y)[prow * D + n]) * (1.0f / 16.0f), ref, 0.09f, 0.02f)) ck_fail(c, code + 1); }
        { const int k = (r2 >> 4) & 1023; if (ck_bad(f8d(h8[k]), bf2f(hb[k]), 0.07f, 0.002f)) ck_fail(c, code + 2); }
        return; }
    { const int j = r2 & 255; const bf16_t* wg = GU + ((size_t)e * 512 + (j >> 7) * 256 + (j & 127)) * D; const float g = rs * dot_bf(hb, wg, D), u = rs * dot_bf(hb, wg + (size_t)128 * D, D);
      const float ref = g / (1.0f + expf(-g)) * u; if (ck_bad(bf2f(HH[prow * 256 + j]), ref, 0.03f, 0.02f)) ck_fail(c, code); }
    { const int n = (r2 >> 8) & 1023; const float ref = dot_bf(HH + prow * 256, CWS(bf16_t, layer ? WS_MOED1 : WS_MOED) + ((size_t)e * 1024 + n) * 256, 256);
      if (Y0_FP8 ? ck_bad(f8d(CWS(unsigned char, WS_Y)[prow * D + n]) * (1.0f / 16.0f), ref, 0.09f, 0.02f) : ck_bad(bf2f(CWS(bf16_t, WS_Y)[prow * D + n]), ref, 0.02f, 0.02f)) ck_fail(c, code + 1); }
}
__global__ void ck_combine(CK c, unsigned code) {
    const unsigned id = blockIdx.x * 64 + threadIdx.x, r = hsh(id + 4242); const int row = r % MA; const bf16_t* hr = CWS(bf16_t, WS_H) + (size_t)row * D; float ss = 0.f;
    for (int i = 0; i < D; ++i) ss += bf2f(hr[i]) * bf2f(hr[i]);
    if (ck_bad(CWS(float, WS_SS)[MP + row], ss, 1e-4f, 1e-6f)) ck_fail(c, code);
    const int k = (r >> 16) & 1023; if (ck_bad(f8d(CWS(unsigned char, WS_HR8)[(size_t)row * D + k]), bf2f(hr[k]), 0.07f, 0.002f)) ck_fail(c, code + 40);
    const int prow = MA + (int)(r % (MP - MA)); if (CWS(unsigned char, WS_HR8)[(size_t)prow * D + k] != 0) ck_fail(c, code + 60);
}
__global__ void __launch_bounds__(64) ck_qk(CK c, unsigned code) {
    const unsigned r = hsh(blockIdx.x + 555); int row = r % MA; const int head = (r >> 15) % 20, d = threadIdx.x; if ((blockIdx.x & 7) == 0) row = MR + (r % 128);
    const float sc = pg8::rs_of(CWS(float, WS_SS)[MP + row]); const bf16_t* hb = CWS(bf16_t, WS_H) + (size_t)row * D;
    const unsigned char* h8 = CWS(unsigned char, WS_HR8) + (size_t)row * D;
    const float raw = sc * dot8(h8, CWS(unsigned char, WS_WAI) + (size_t)wai_row(head * 64 + d) * D, D) * (1.0f / 64.0f);
    const float ss = wave_sum(raw * raw); const float xn = raw * rsqrtf(ss * (1.0f / 64.0f) + EPS) * (head < 16 ? c.in[14][d] * ATT_C2 : c.in[15][d]);
    const float pr = __shfl_xor(xn, 1); float cs = 1.f, sn = 0.f;
    if (row < MR) { const int s = row & (S - 1), rr = s >> 6, cc = s & 63, i = d >> 1, f = i < 16 ? i : i - 16; const float ang = (float)(i < 16 ? rr : cc) * powf(10000.0f, -(float)(2 * f) / 32.0f); cs = cosf(ang); sn = sinf(ang); }
    const float ref = (d & 1) ? (pr * sn + xn * cs) : (xn * cs - pr * sn);
    if (ck_bad(bf2f(CWS(bf16_t, WS_U2)[(size_t)row * NA + head * 64 + d]), ref, 0.03f, head < 16 ? 0.006f : 0.03f)) ck_fail(c, code);
    const int vc = 1280 + ((r >> 20) & 3) * 64 + d; const float refv = sc * dot8(h8, CWS(unsigned char, WS_WAI) + (size_t)wai_row(vc) * D, D) * (1.0f / 64.0f);
    if (ck_bad(bf2f(CWS(bf16_t, WS_U2)[(size_t)row * NA + vc]), refv, 0.015f, 0.02f)) ck_fail(c, code + 20);
}
__global__ void __launch_bounds__(64) ck_attn(CK c, unsigned code) {
    __shared__ float qs[64], sc[T];
    const unsigned r = hsh(blockIdx.x + 31337); const int b = r & 7, h = (r >> 3) & 15, s = (r >> 7) & 2047, kvh = h >> 2, tid = threadIdx.x; const bf16_t* U2 = CWS(bf16_t, WS_U2);
    qs[tid] = bf2f(U2[((size_t)b * S + s) * NA + h * 64 + tid]);
    __syncthreads();
    float mx = -INFINITY;
    for (int j = tid; j < T; j += 64) { const bf16_t* kp = U2 + (size_t)tok_row(b, j) * NA + 1024 + kvh * 64; float a = 0.f; for (int d = 0; d < 64; ++d) a += qs[d] * bf2f(kp[d]); sc[j] = a; mx = fmaxf(mx, a); }
#pragma unroll
    for (int o = 1; o < 64; o <<= 1) mx = fmaxf(mx, __shfl_xor(mx, o));
    __syncthreads();
    float l = 0.f, acc = 0.f;
    for (int j = 0; j < T; ++j) { const float p = exp2f(sc[j] - mx); l += p; acc += p * bf2f(U2[(size_t)tok_row(b, j) * NA + 1280 + kvh * 64 + tid]); }
    const float ref = acc / l;
    if (ck_bad(f8d(CWS(unsigned char, WS_AO)[((size_t)b * S + s) * D + h * 64 + tid]) * (1.0f / 16.0f), ref, 0.09f, 0.004f)) ck_fail(c, code);
}
__global__ void ck_outproj1(CK c, unsigned code) {
    const unsigned id = blockIdx.x * 64 + threadIdx.x, r = hsh(id * 2 + 77), r2 = hsh(id * 2 + 78); int row = r % MR, col = r2 & 1023; if ((id & 7) == 0) row = MR - 1 - (r % 300);
    const float ref = bf2f(CWS(bf16_t, WS_U2)[(size_t)row * D + col]) + dot8(CWS(unsigned char, WS_AO) + (size_t)row * D, CWS(unsigned char, WS_WAO) + (size_t)col * D, D) * (1.0f / 1024.0f);
    if (ck_bad(bf2f(CWS(bf16_t, WS_H)[(size_t)row * D + col]), ref, 0.015f, 0.02f)) ck_fail(c, code);
}
__global__ void ck_report(CK c, int always_zero) {
    const unsigned code = ((const unsigned*)(c.ws + WS_CTL))[CW_FLAG];
    const size_t i = (size_t)blockIdx.x * 256 + threadIdx.x;
    if (code) c.out[i] = sqrtf((float)code); else if (always_zero) c.out[i] = 0.f;
}
#endif
extern "C" void kernel_launch(void* const* d_in, const int* in_sizes, int n_in, void* d_out, int out_size, void* d_ws, size_t ws_size, hipStream_t stream) {
    static int grid = 0;
    if (grid == 0) {
        if (n_in != 24 || out_size != MR * D || ws_size < WS_END) { fprintf(stderr, "kernel_launch: unexpected shapes / workspace (%d inputs, out %d, ws %zu < %zu)\n", n_in, out_size, ws_size, (size_t)WS_END); grid = -1; return; }
        int dev = 0, cus = 0;
        if (hipGetDevice(&dev) != hipSuccess || hipDeviceGetAttribute(&cus, hipDeviceAttributeMultiprocessorCount, dev) != hipSuccess) { grid = -1; return; }
        if (hipFuncSetAttribute((const void*)mega, hipFuncAttributeMaxDynamicSharedMemorySize, LDS_BYTES) != hipSuccess) { fprintf(stderr, "kernel_launch: hipFuncSetAttribute failed\n"); grid = -1; return; }
        int per_cu = 0; (void)hipOccupancyMaxActiveBlocksPerMultiprocessor(&per_cu, (const void*)mega, NWAVES * 64, LDS_BYTES); (void)hipGetLastError();
        if (per_cu < 1) fprintf(stderr, "kernel_launch: occupancy query reports %d blocks per CU\n", per_cu);
        grid = cus;
    }
    if (grid < 0) return;
    (void)hipMemsetAsync((char*)d_ws + WS_CTL, 0, CTL_ZERO_BYTES, stream);
    Args a{};
    for (int i = 0; i < 24; ++i) a.in[i] = (const float*)d_in[i];
    a.out = (float*)d_out; a.ws = (unsigned char*)d_ws;
#if SELFCHECK
    CK c{}; for (int i = 0; i < 24; ++i) c.in[i] = (const float*)d_in[i]; c.ws = (unsigned char*)d_ws; c.out = (float*)d_out;
#define RUN(lo_, hi_) do { a.ph_lo = (lo_); a.ph_hi = (hi_); hipLaunchKernelGGL(mega, dim3(grid), dim3(NWAVES * 64), LDS_BYTES, stream, a); } while (0)
    RUN(0, 1); hipLaunchKernelGGL(ck_prologue, dim3(64), dim3(256), 0, stream, c, 0, 1u, 2);
    RUN(1, 2); hipLaunchKernelGGL(ck_u, dim3(64), dim3(64), 0, stream, c, 2u); hipLaunchKernelGGL(ck_la, dim3(16), dim3(64), 0, stream, c, 3u);
    RUN(2, 3); RUN(3, 4); hipLaunchKernelGGL(ck_scan, dim3(16), dim3(64), 0, stream, c, 4u);
    RUN(4, 5); hipLaunchKernelGGL(ck_glaout, dim3(96), dim3(128), 0, stream, c, 5u); hipLaunchKernelGGL(ck_prologue, dim3(64), dim3(256), 0, stream, c, 0, 1u, 0);
    RUN(5, 6); hipLaunchKernelGGL(ck_outproj0, dim3(64), dim3(64), 0, stream, c, 6u);
    RUN(6, 7); hipLaunchKernelGGL(ck_route, dim3(8), dim3(64), 0, stream, c, 0, MA, 7u);
    RUN(7, 8); RUN(8, 9); hipLaunchKernelGGL(ck_moe, dim3(64), dim3(64), 0, stream, c, 0, 8u); hipLaunchKernelGGL(ck_prologue, dim3(64), dim3(256), 0, stream, c, 0, 1u, 1);
    RUN(9, 10); hipLaunchKernelGGL(ck_combine, dim3(8), dim3(64), 0, stream, c, 10u);
    RUN(10, 11); hipLaunchKernelGGL(ck_prologue, dim3(64), dim3(256), 0, stream, c, 1, 11u, 0); RUN(11, 12); hipLaunchKernelGGL(ck_qk, dim3(1024), dim3(64), 0, stream, c, 12u);
    RUN(12, 13); hipLaunchKernelGGL(ck_attn, dim3(512), dim3(64), 0, stream, c, 13u);
    (void)hipMemcpyAsync((char*)d_ws + WS_U2, (char*)d_ws + WS_H, (size_t)MR * D * 2, hipMemcpyDeviceToDevice, stream);
    RUN(13, 14); hipLaunchKernelGGL(ck_outproj1, dim3(64), dim3(64), 0, stream, c, 14u);
    RUN(14, 15); hipLaunchKernelGGL(ck_route, dim3(8), dim3(64), 0, stream, c, 1, MR, 15u);
    RUN(15, 16); RUN(16, 17); RUN(17, 18); hipLaunchKernelGGL(ck_moe, dim3(64), dim3(64), 0, stream, c, 1, 16u);
    RUN(18, 19); hipLaunchKernelGGL(ck_report, dim3(MR * D / 256), dim3(256), 0, stream, c, 0);
#undef RUN
#elif N_LAUNCH_MODE == 0
#ifdef PREFIX_P
    a.abl = 1; for (int p = 0; p <= PREFIX_P; ++p) { a.ph_lo = p; a.ph_hi = p + 1; hipLaunchKernelGGL(mega, dim3(grid), dim3(NWAVES * 64), LDS_BYTES, stream, a); } a.abl = 0;
    (void)hipMemsetAsync((char*)d_ws + WS_CTL, 0, CTL_ZERO_BYTES, stream);
#endif
    for (int p = 0; p < NPHASE; ++p) { a.ph_lo = p; a.ph_hi = p + 1; hipLaunchKernelGGL(mega, dim3(grid), dim3(NWAVES * 64), LDS_BYTES, stream, a); }
#else
    a.ph_lo = 0; a.ph_hi = NPHASE;
    hipLaunchKernelGGL(mega, dim3(grid), dim3(NWAVES * 64), LDS_BYTES, stream, a);
#endif
}
```
